# Optimizing an MI355X kernel written in HIP

```python
import jax
import jax.numpy as jnp
from jax import lax
import numpy as np

D_MODEL = 2048
BATCH = 4
SEQ = 4096
DEPTH = 2

N_MIXERS = 4
GROUP_WIDTH = D_MODEL // N_MIXERS
MIX_WIDTH = N_MIXERS * GROUP_WIDTH
HEAD_DIM = 128
N_HEADS = GROUP_WIDTH // HEAD_DIM
LRU_BLOCKS = N_HEADS
LRU_BLOCK_WIDTH = GROUP_WIDTH // LRU_BLOCKS
LRU_CONV_WIDTH = 4
LRU_C = 8.0
MLSTM_CHUNK = 64
DILATED_PATTERNS = ((128, 1), (512, 4), (2048, 16))
DIL_BLOCK = 128
SB_BLOCK = 128
D_FF = ((8 * D_MODEL // 3 + 127) // 128) * 128
RMS_EPS = 1e-6
NEG_BIG = -1e30

IN_SIZES = (
    GROUP_WIDTH, GROUP_WIDTH,
    GROUP_WIDTH, GROUP_WIDTH, GROUP_WIDTH, GROUP_WIDTH, N_HEADS, N_HEADS,
    GROUP_WIDTH, GROUP_WIDTH, GROUP_WIDTH,
    GROUP_WIDTH, GROUP_WIDTH, GROUP_WIDTH,
)
D_IN = sum(IN_SIZES)

kernel_name = 'hybrid_parallel_groups_rglru_mlstm_dilated_stickbreaking'


def _split_points():
    pts, acc = [], 0
    for s in IN_SIZES[:-1]:
        acc += s
        pts.append(acc)
    return pts


def alibi_slopes():
    return jnp.asarray(2.0 ** (-8.0 * np.arange(1, N_HEADS + 1) / N_HEADS), dtype=jnp.float32)


def rmsnorm(x, gain):
    xf = x.astype(jnp.float32)
    y = xf * lax.rsqrt(jnp.mean(xf * xf, axis=-1, keepdims=True) + RMS_EPS)
    return (y * gain.astype(jnp.float32)).astype(x.dtype)


def swiglu(x, w_gate, w_up, w_down):
    return (jax.nn.silu(x @ w_gate) * (x @ w_up)) @ w_down


def rglru_mixer(xr, gate, conv_w, conv_b, w_a, b_a, w_x, b_x, lam):
    bsz, seq, width = xr.shape
    xc = lax.conv_general_dilated(xr, conv_w[:, None, :], window_strides=(1,),
                                  padding=[(LRU_CONV_WIDTH - 1, 0)],
                                  dimension_numbers=('NWC', 'WIO', 'NWC'),
                                  feature_group_count=width) + conv_b
    xg = xc.reshape(bsz, seq, LRU_BLOCKS, LRU_BLOCK_WIDTH)
    r = jax.nn.sigmoid(jnp.einsum('bsnc,ncd->bsnd', xg, w_a).reshape(bsz, seq, width) + b_a)
    i = jax.nn.sigmoid(jnp.einsum('bsnc,ncd->bsnd', xg, w_x).reshape(bsz, seq, width) + b_x)
    log_a = -LRU_C * jax.nn.softplus(-lam.astype(jnp.float32)) * r.astype(jnp.float32)
    a = jnp.exp(log_a)
    u = jnp.sqrt(-jnp.expm1(2.0 * log_a)) * (i * xc).astype(jnp.float32)

    def combine(lhs, rhs):
        a1, b1 = lhs
        a2, b2 = rhs
        return a1 * a2, a2 * b1 + b2

    _, h = lax.associative_scan(combine, (a, u), axis=1)
    return h.astype(xr.dtype) * jax.nn.gelu(gate)


def mlstm_mixer(q, k, v, o_pre, i_pre, f_pre, ig_bias, fg_bias, head_gain):
    bsz, seq, _ = q.shape
    nh, dh, ln = N_HEADS, HEAD_DIM, MLSTM_CHUNK
    nc = seq // ln

    def to_chunks(t):
        return t.astype(jnp.float32).reshape(bsz, nc, ln, nh, dh).transpose(1, 0, 3, 2, 4)

    def gate_chunks(t):
        return t.astype(jnp.float32).reshape(bsz, nc, ln, nh).transpose(1, 0, 3, 2)

    qc = to_chunks(q)
    kc = to_chunks(k) * (dh ** -0.5)
    vc = to_chunks(v)
    igc = gate_chunks(i_pre + ig_bias)
    lfc = jax.nn.log_sigmoid(gate_chunks(f_pre + fg_bias))
    causal = jnp.tril(jnp.ones((ln, ln), dtype=bool))

    def step(carry, inp):
        c_mat, n_vec, m_run = carry
        qt, kt, vt, ig, lf = inp
        b = jnp.cumsum(lf, axis=-1)
        log_d = jnp.where(causal, b[..., :, None] - b[..., None, :] + ig[..., None, :], -jnp.inf)
        inter = b + m_run[..., None]
        m_t = jnp.maximum(inter, log_d.max(axis=-1))
        s = jnp.einsum('bhtd,bhsd->bhts', qt, kt) * jnp.exp(log_d - m_t[..., None])
        w_inter = jnp.exp(inter - m_t)
        num = jnp.einsum('bhts,bhsd->bhtd', s, vt) + w_inter[..., None] * jnp.einsum('bhtk,bhkv->bhtv', qt, c_mat)
        den = s.sum(axis=-1) + w_inter * jnp.einsum('bhtk,bhk->bht', qt, n_vec)
        h = num / jnp.maximum(jnp.abs(den), jnp.exp(-m_t))[..., None]
        b_last = b[..., -1]
        log_w = b_last[..., None] - b + ig
        m_next = jnp.maximum(b_last + m_run, log_w.max(axis=-1))
        w = jnp.exp(log_w - m_next[..., None])
        decay = jnp.exp(b_last + m_run - m_next)
        c_mat = decay[..., None, None] * c_mat + jnp.einsum('bhs,bhsk,bhsv->bhkv', w, kt, vt)
        n_vec = decay[..., None] * n_vec + jnp.einsum('bhs,bhsk->bhk', w, kt)
        return (c_mat, n_vec, m_next), h

    init = (jnp.zeros((bsz, nh, dh, dh), jnp.float32),
            jnp.zeros((bsz, nh, dh), jnp.float32),
            jnp.zeros((bsz, nh), jnp.float32))
    _, hs = lax.scan(step, init, (qc, kc, vc, igc, lfc))
    h = hs.transpose(1, 0, 3, 2, 4).reshape(bsz, seq, nh, dh)
    h = h * lax.rsqrt(jnp.mean(h * h, axis=-1, keepdims=True) + RMS_EPS) * head_gain.astype(jnp.float32).reshape(nh, dh)
    h = h.reshape(bsz, seq, nh * dh) * jax.nn.sigmoid(o_pre.astype(jnp.float32))
    return h.astype(q.dtype)


def dilated_branch(q, k, v, window, dilation, slopes):
    bsz, seq, nh, dh = q.shape
    span = window // dilation
    sub_len = seq // dilation
    nb = -(-sub_len // DIL_BLOCK)
    pad_len = nb * DIL_BLOCK

    def to_sub(t):
        t = t.reshape(bsz, sub_len, dilation, nh, dh).transpose(0, 2, 3, 1, 4)
        t = jnp.pad(t, ((0, 0), (0, 0), (0, 0), (0, pad_len - sub_len), (0, 0)))
        return t.reshape(bsz, dilation, nh, nb, DIL_BLOCK, dh)

    def with_prev(t):
        prev = jnp.pad(t, ((0, 0), (0, 0), (0, 0), (1, 0), (0, 0), (0, 0)))[:, :, :, :-1]
        return jnp.concatenate([prev, t], axis=4)

    qs = to_sub(q)
    ks = with_prev(to_sub(k))
    vs = with_prev(to_sub(v)).astype(jnp.float32)
    scores = jnp.einsum('brhnqd,brhnkd->brhnqk', qs, ks).astype(jnp.float32) * (dh ** -0.5)
    q_pos = jnp.arange(DIL_BLOCK)[:, None] + DIL_BLOCK
    k_pos = jnp.arange(2 * DIL_BLOCK)[None, :]
    dist = q_pos - k_pos
    k_abs = (jnp.arange(nb) * DIL_BLOCK - DIL_BLOCK)[:, None, None] + k_pos[None]
    valid = (dist >= 0) & (dist <= span) & (k_abs >= 0)
    bias = -slopes[:, None, None, None] * (dilation * dist).astype(jnp.float32)
    scores = jnp.where(valid, scores + bias, NEG_BIG)
    m = scores.max(axis=-1)
    p = jnp.exp(scores - m[..., None])
    den = p.sum(axis=-1)
    num = jnp.einsum('brhnqk,brhnkd->brhnqd', p, vs)

    def from_sub(t):
        t = t.reshape((bsz, dilation, nh, pad_len) + t.shape[5:])[:, :, :, :sub_len]
        t = jnp.moveaxis(t, 3, 1)
        return t.reshape((bsz, seq, nh) + t.shape[4:])

    return from_sub(num), from_sub(den), from_sub(m)


def dilated_mixer(q, k, v, q_gain, k_gain):
    bsz, seq, _ = q.shape
    shp = (bsz, seq, N_HEADS, HEAD_DIM)
    qh = rmsnorm(q.reshape(shp), q_gain)
    kh = rmsnorm(k.reshape(shp), k_gain)
    vh = v.reshape(shp)
    slopes = alibi_slopes()
    outs = [dilated_branch(qh, kh, vh, w, d, slopes) for (w, d) in DILATED_PATTERNS]
    nums = jnp.stack([o[0] for o in outs])
    dens = jnp.stack([o[1] for o in outs])
    ms = jnp.stack([o[2] for o in outs])
    wts = jnp.exp(ms - ms.max(axis=0, keepdims=True))
    out = (wts[..., None] * nums).sum(axis=0) / (wts * dens).sum(axis=0)[..., None]
    return out.reshape(bsz, seq, GROUP_WIDTH).astype(q.dtype)


def stick_breaking_mixer(q, k, v):
    bsz, seq, _ = q.shape

    def heads(t):
        return t.reshape(bsz, seq, N_HEADS, HEAD_DIM).transpose(0, 2, 1, 3)

    qh, kh = heads(q), heads(k)
    vh = heads(v).astype(jnp.float32)
    key_pos = jnp.arange(seq)

    def block(n):
        start = n * SB_BLOCK
        qb = lax.dynamic_slice_in_dim(qh, start, SB_BLOCK, axis=2)
        z = jnp.einsum('bhqd,bhkd->bhqk', qb, kh).astype(jnp.float32) * (HEAD_DIM ** -0.5)
        q_pos = start + jnp.arange(SB_BLOCK)
        mask = key_pos[None, :] < q_pos[:, None]
        log_keep = jnp.where(mask, jax.nn.log_sigmoid(-z), 0.0)
        log_keep_after = lax.cumsum(log_keep, axis=3, reverse=True) - log_keep
        weight = jnp.where(mask, jnp.exp(jax.nn.log_sigmoid(z) + log_keep_after), 0.0)
        return jnp.einsum('bhqk,bhkd->bhqd', weight, vh)

    out = lax.map(block, jnp.arange(seq // SB_BLOCK))
    return out.transpose(1, 0, 3, 2, 4).reshape(bsz, seq, GROUP_WIDTH).astype(q.dtype)


def setup_inputs(seed: int = 0) -> dict:
    key = jax.random.key(seed)
    ks = jax.random.split(key, 24)

    def nrm(k, shape, scale):
        return jax.random.normal(k, shape, jnp.float32) * scale

    def gain(k, shape):
        return 1.0 + 0.02 * jax.random.normal(k, shape, jnp.float32)

    nl = DEPTH
    u = jax.random.uniform(ks[13], (nl, GROUP_WIDTH), jnp.float32, 0.9, 0.999)
    a = u ** (1.0 / LRU_C)
    lru_lambda = jnp.log(a) - jnp.log1p(-a)
    fg_bias = jnp.linspace(3.0, 6.0, N_HEADS, dtype=jnp.float32)[None, :] + nrm(ks[15], (nl, N_HEADS), 0.02)
    return {
        'x': nrm(ks[0], (BATCH, SEQ, D_MODEL), 1.0),
        'ffn1_norm': gain(ks[1], (nl, D_MODEL)),
        'ffn1_w_gate': nrm(ks[2], (nl, D_MODEL, D_FF), D_MODEL ** -0.5),
        'ffn1_w_up': nrm(ks[3], (nl, D_MODEL, D_FF), D_MODEL ** -0.5),
        'ffn1_w_down': nrm(ks[4], (nl, D_FF, D_MODEL), D_FF ** -0.5),
        'mix_norm': gain(ks[5], (nl, D_MODEL)),
        'w_in': nrm(ks[6], (nl, D_MODEL, D_IN), D_MODEL ** -0.5),
        'lru_conv_w': nrm(ks[7], (nl, LRU_CONV_WIDTH, GROUP_WIDTH), LRU_CONV_WIDTH ** -0.5),
        'lru_conv_b': nrm(ks[8], (nl, GROUP_WIDTH), 0.02),
        'lru_w_a': nrm(ks[9], (nl, LRU_BLOCKS, LRU_BLOCK_WIDTH, LRU_BLOCK_WIDTH), LRU_BLOCK_WIDTH ** -0.5),
        'lru_b_a': nrm(ks[10], (nl, GROUP_WIDTH), 0.02),
        'lru_w_x': nrm(ks[11], (nl, LRU_BLOCKS, LRU_BLOCK_WIDTH, LRU_BLOCK_WIDTH), LRU_BLOCK_WIDTH ** -0.5),
        'lru_b_x': nrm(ks[12], (nl, GROUP_WIDTH), 0.02),
        'lru_lambda': lru_lambda,
        'mlstm_ig_bias': nrm(ks[14], (nl, N_HEADS), 0.1),
        'mlstm_fg_bias': fg_bias,
        'attn_q_gain': gain(ks[16], (nl, HEAD_DIM)),
        'attn_k_gain': gain(ks[17], (nl, HEAD_DIM)),
        'group_out_gain': gain(ks[18], (nl, MIX_WIDTH)),
        'w_out': nrm(ks[19], (nl, MIX_WIDTH, D_MODEL), MIX_WIDTH ** -0.5),
        'ffn2_norm': gain(ks[20], (nl, D_MODEL)),
        'ffn2_w_gate': nrm(ks[21], (nl, D_MODEL, D_FF), D_MODEL ** -0.5),
        'ffn2_w_up': nrm(ks[22], (nl, D_MODEL, D_FF), D_MODEL ** -0.5),
        'ffn2_w_down': nrm(ks[23], (nl, D_FF, D_MODEL), D_FF ** -0.5),
    }


def reference(x, ffn1_norm, ffn1_w_gate, ffn1_w_up, ffn1_w_down, mix_norm, w_in,
              lru_conv_w, lru_conv_b, lru_w_a, lru_b_a, lru_w_x, lru_b_x, lru_lambda,
              mlstm_ig_bias, mlstm_fg_bias, attn_q_gain, attn_k_gain, group_out_gain, w_out,
              ffn2_norm, ffn2_w_gate, ffn2_w_up, ffn2_w_down):
    split_pts = _split_points()
    for l in range(DEPTH):
        x = x + 0.5 * swiglu(rmsnorm(x, ffn1_norm[l]), ffn1_w_gate[l], ffn1_w_up[l], ffn1_w_down[l])
        h = rmsnorm(x, mix_norm[l])
        (lx, lg, mq, mk, mv, mo, mi, mf, cq, ck, cv, sq, sk, sv) = jnp.split(h @ w_in[l], split_pts, axis=-1)
        g_a, g_b, g_c, g_d = jnp.split(group_out_gain[l], N_MIXERS)
        y_a = rmsnorm(rglru_mixer(lx, lg, lru_conv_w[l], lru_conv_b[l], lru_w_a[l], lru_b_a[l],
                                  lru_w_x[l], lru_b_x[l], lru_lambda[l]), g_a)
        y_b = mlstm_mixer(mq, mk, mv, mo, mi, mf, mlstm_ig_bias[l], mlstm_fg_bias[l], g_b)
        y_c = rmsnorm(dilated_mixer(cq, ck, cv, attn_q_gain[l], attn_k_gain[l]), g_c)
        y_d = rmsnorm(stick_breaking_mixer(sq, sk, sv), g_d)
        mixed = jnp.concatenate([y_a, y_b, y_c, y_d], axis=-1).astype(x.dtype)
        x = x + mixed @ w_out[l]
        x = x + 0.5 * swiglu(rmsnorm(x, ffn2_norm[l]), ffn2_w_gate[l], ffn2_w_up[l], ffn2_w_down[l])
    return x
```

```cpp
#include <hip/hip_runtime.h>
#include <cstdio>
#include <cstdint>
#define LAS __attribute__((address_space(3)))
namespace pg8 {
#define PG8_LAS __attribute__((address_space(3)))
typedef unsigned short bf16_t;
typedef short bf16x8 __attribute__((ext_vector_type(8)));
typedef float f32x4 __attribute__((ext_vector_type(4)));
typedef unsigned u32x4 __attribute__((ext_vector_type(4)));
constexpr int BM = 256, BK = 64, HALF = 128, HTB = HALF * BK * 2  , STAGE_BYTES = 8 * HTB, NXCD = 8, WGM = 4;

__host__ __device__ __forceinline__ int lds_byte(int r, int c) { const int st = (r >> 4) * 2 + (c >> 5), rr = r & 15, cc = c & 31, ob = rr * 64 + cc * 2; return st * 1024 + (ob ^ (((ob >> 9) & 1) << 5)); }
__host__ __device__ __forceinline__ void stage_rc(int b, int& R, int& C) { const int st = b / 1024, sb = b % 1024, swz = sb ^ (((sb >> 9) & 1) << 5); R = (st >> 1) * 16 + swz / 64; C = (st & 1) * 32 + (swz % 64) / 2; }
__host__ __device__ __forceinline__ int perm32(int rho) { const int n = rho >> 4, i = rho & 15; return 8 * (i >> 2) + 4 * n + (i & 3); }

struct Unit { int pm, pn; };
struct Gemm { const bf16_t* A; const bf16_t* Bt; int M, N, K; };

struct StaticOrder {
    int nM, nN, nwg, G, c;
    __host__ __device__ void init(int M, int N, int G_, int c_) { nM = M / BM; nN = N / BM; nwg = nM * nN; G = G_; c = c_; }
    __host__ __device__ bool next(int i, Unit& u) const {
        const long L = (long)i * G + c; if (L >= nwg) return false;
        int wgid = (int)L; { const int q = nwg / NXCD, r = nwg % NXCD, xcd = wgid % NXCD, off = wgid / NXCD; wgid = (xcd < r ? xcd * (q + 1) : r * (q + 1) + (xcd - r) * q) + off; }
        const int nig = WGM * nN, gid = wgid / nig, fm = gid * WGM, gsz = (nM - fm) < WGM ? (nM - fm) : WGM;
        u.pm = fm + ((wgid % nig) % gsz); u.pn = (wgid % nig) / gsz; return true;
    }
    __device__ __forceinline__ void a_ready(const Unit&) const {}
    __device__ __forceinline__ void done(const Unit&) const {}
};

__device__ __forceinline__ unsigned cvt_pk_bf16(float lo, float hi) { unsigned r; asm volatile("v_cvt_pk_bf16_f32 %0, %1, %2" : "=v"(r) : "v"(lo), "v"(hi)); return r; }

typedef float f32x2 __attribute__((ext_vector_type(2)));
constexpr float RMS_EPS_F = 1e-6f, SSQ_FX = 1048576.0f;
struct EpiSwiglu {
    static constexpr bool PERM = true, AFTER_DRAIN = false;
    bf16_t* O; int ldc; const unsigned long long* ssq; float inv_d;
    __device__ __forceinline__ void operator()(const f32x4 (&acc)[2][2][4][2], const Unit& u, int wr, int wc, int fr, int fq) const {
        const int row0 = u.pm * BM + wr * 64 + fr, col0 = u.pn * HALF + wc * 32 + 8 * fq;
#pragma unroll
        for (int ai = 0; ai < 2; ++ai)
#pragma unroll
            for (int m = 0; m < 4; ++m) {
                const int row = row0 + ai * HALF + m * 16;
                const float rs = __builtin_amdgcn_rsqf((float)ssq[row] * inv_d + RMS_EPS_F);
                const f32x2 ce = {-rs * 1.4426950408889634f, -rs * 1.4426950408889634f}, c2 = {rs * rs, rs * rs}, one = {1.0f, 1.0f};
                unsigned wv[4];
#pragma unroll
                for (int n = 0; n < 2; ++n)
#pragma unroll
                    for (int hh = 0; hh < 2; ++hh) {
                        const f32x2 g = {acc[ai][0][m][n][2 * hh], acc[ai][0][m][n][2 * hh + 1]}, up = {acc[ai][1][m][n][2 * hh], acc[ai][1][m][n][2 * hh + 1]};
                        const f32x2 a = g * ce; f32x2 e; e.x = __builtin_amdgcn_exp2f(a.x); e.y = __builtin_amdgcn_exp2f(a.y);
                        const f32x2 d = e + one; f32x2 r; r.x = __builtin_amdgcn_rcpf(d.x); r.y = __builtin_amdgcn_rcpf(d.y);
                        const f32x2 v = ((g * up) * c2) * r;
                        wv[n * 2 + hh] = cvt_pk_bf16(v.x, v.y);
                    }
                u32x4 w; w.x = wv[0]; w.y = wv[1]; w.z = wv[2]; w.w = wv[3];
                *(u32x4*)(O + (size_t)row * ldc + col0) = w;
            }
    }
};
struct EpiResid {
    static constexpr bool PERM = false, AFTER_DRAIN = false;
    const bf16_t* base; float* out; bf16_t* xb; unsigned long long* ssq; int ldc; float alpha;
    __device__ __forceinline__ void operator()(const f32x4 (&acc)[2][2][4][2], const Unit& u, int wr, int wc, int fr, int fq) const {
        typedef unsigned u32x2v __attribute__((ext_vector_type(2)));
        const int row0 = u.pm * BM + wr * 64 + fr, col0 = u.pn * BM + wc * 32 + 4 * fq;
#pragma unroll
        for (int ai = 0; ai < 2; ++ai) {
            u32x2v b4[4][2][2];
#pragma unroll
            for (int m = 0; m < 4; ++m)
#pragma unroll
                for (int bj = 0; bj < 2; ++bj)
#pragma unroll
                    for (int n = 0; n < 2; ++n) b4[m][bj][n] = *(const u32x2v*)(base + (size_t)(row0 + ai * HALF + m * 16) * ldc + col0 + bj * HALF + n * 16);
#pragma unroll
            for (int m = 0; m < 4; ++m) {
                const int row = row0 + ai * HALF + m * 16; const size_t off = (size_t)row * ldc + col0; float s = 0.f;
#pragma unroll
                for (int bj = 0; bj < 2; ++bj)
#pragma unroll
                    for (int n = 0; n < 2; ++n) {
                        const u32x2v bb = b4[m][bj][n];
                        const f32x4 bf = {__builtin_bit_cast(float, bb.x << 16), __builtin_bit_cast(float, bb.x & 0xffff0000u), __builtin_bit_cast(float, bb.y << 16), __builtin_bit_cast(float, bb.y & 0xffff0000u)};
                        const f32x4 o = bf + acc[ai][bj][m][n] * alpha;
                        if (out) *(f32x4*)(out + off + bj * HALF + n * 16) = o;
                        if (xb) { u32x2v w; w.x = cvt_pk_bf16(o[0], o[1]); w.y = cvt_pk_bf16(o[2], o[3]); *(u32x2v*)(xb + off + bj * HALF + n * 16) = w; }
                        s += (o[0] * o[0] + o[1] * o[1]) + (o[2] * o[2] + o[3] * o[3]);
                    }
                if (ssq) { s += __shfl_xor(s, 16); s += __shfl_xor(s, 32); if (fq == 0) atomicAdd(ssq + row, (unsigned long long)(s * SSQ_FX + 0.5f)); }
            }
            asm volatile("" ::: "memory");
        }
    }
};
struct EpiSplit {
    static constexpr bool PERM = true, AFTER_DRAIN = false;
    bf16_t* O; size_t seg_stride; const unsigned long long* ssq; float inv_d;
    __device__ __forceinline__ void operator()(const f32x4 (&acc)[2][2][4][2], const Unit& u, int wr, int wc, int fr, int fq) const {
        const int colt = u.pn * BM, seg = colt >> 9, cin = colt & 511;
        bf16_t* base = O + (size_t)seg * seg_stride;
        const int row0 = u.pm * BM + wr * 64 + fr, col0 = cin + wc * 32 + 8 * fq;
#pragma unroll
        for (int ai = 0; ai < 2; ++ai)
#pragma unroll
            for (int m = 0; m < 4; ++m) {
                const int row = row0 + ai * HALF + m * 16;
                const float rs = __builtin_amdgcn_rsqf((float)ssq[row] * inv_d + RMS_EPS_F);
#pragma unroll
                for (int bj = 0; bj < 2; ++bj) {
                    const f32x4 v0 = acc[ai][bj][m][0] * rs, v1 = acc[ai][bj][m][1] * rs;
                    u32x4 w; w.x = cvt_pk_bf16(v0[0], v0[1]); w.y = cvt_pk_bf16(v0[2], v0[3]); w.z = cvt_pk_bf16(v1[0], v1[1]); w.w = cvt_pk_bf16(v1[2], v1[3]);
                    *(u32x4*)(base + (size_t)row * 512 + col0 + bj * HALF) = w;
                }
            }
    }
};
template <class Epi, class Sched, bool ALIGN_EPI = false, bool SP2 = false>
__device__ __forceinline__ void gemm_phase(PG8_LAS unsigned char* lds, const Gemm g, const Sched& S, const Epi& E, int wid0) {
    int tid_ = (wid0 << 6) | (int)__builtin_amdgcn_mbcnt_hi(~0u, __builtin_amdgcn_mbcnt_lo(~0u, 0u)); asm volatile("" : "+v"(tid_));
    const int tid = tid_, wid = __builtin_amdgcn_readfirstlane(tid >> 6), lane = tid & 63, wr = wid >> 2, wc = wid & 3, fr = lane & 15, fq = lane >> 4;
    const int K = g.K, nt = K / BK;
    unsigned voffA[2], voffB[2];
#pragma unroll
    for (int i = 0; i < 2; ++i) { int R, C; stage_rc(tid * 16 + i * 8192, R, C); const int Rb = Epi::PERM ? ((R & ~31) + perm32(R & 31)) : R;
        voffA[i] = (unsigned)(R * K + C) * 2u; voffB[i] = (unsigned)(Rb * K + C) * 2u; }
    const size_t kstep = (size_t)(BK * 2);
    const size_t hstep = (size_t)HALF * K * 2;
    const size_t tstep = 2 * hstep;
    const unsigned ldsw = (unsigned)wid * 1024u;
    const int aoff = lds_byte(wr * 64 + fr, fq * 8), boff = lds_byte(wc * 32 + fr, fq * 8);
#define PG8_SA(b, h) (((b) * 2 + (h)) * HTB)
#define PG8_SB(b, h) ((4 + (b) * 2 + (h)) * HTB)
#define PG8_STAGE(bufoff, gbase, voff) do { _Pragma("unroll") for (int _i = 0; _i < 2; ++_i) \
        __builtin_amdgcn_global_load_lds((const unsigned*)((const char*)(gbase) + (voff)[_i]), (PG8_LAS unsigned*)(lds + (bufoff) + ldsw + _i * 8192), 16, 0, 0); } while (0)
#define PG8_LDA(dst, b, h) do { _Pragma("unroll") for (int m = 0; m < 4; ++m) _Pragma("unroll") for (int k = 0; k < 2; ++k) dst[m][k] = *(const PG8_LAS bf16x8*)(lds + PG8_SA(b, h) + aoff + m * 2048 + k * 1024); } while (0)
#define PG8_LDB(dst, b, h) do { _Pragma("unroll") for (int n = 0; n < 2; ++n) _Pragma("unroll") for (int k = 0; k < 2; ++k) dst[n][k] = *(const PG8_LAS bf16x8*)(lds + PG8_SB(b, h) + boff + n * 2048 + k * 1024); } while (0)
#define PG8_MMA(ai, bj, At, Bt) do { __builtin_amdgcn_s_setprio(1); _Pragma("unroll") for (int m = 0; m < 4; ++m) _Pragma("unroll") for (int n = 0; n < 2; ++n) _Pragma("unroll") for (int k = 0; k < 2; ++k) \
        acc[ai][bj][m][n] = __builtin_amdgcn_mfma_f32_16x16x32_bf16(Bt[n][k], At[m][k], acc[ai][bj][m][n], 0, 0, 0); __builtin_amdgcn_s_setprio(0); } while (0)
#define PG8_WAIT_V(n) asm volatile("s_waitcnt vmcnt(" #n ")" ::: "memory")
#define PG8_WAIT_L(n) asm volatile("s_waitcnt lgkmcnt(" #n ")" ::: "memory")
#define PG8_BAR __builtin_amdgcn_s_barrier()
#define PG8_SCHED __builtin_amdgcn_sched_barrier(0)
    Unit cur, nxt; int ui = 0;
    if (!S.next(0, cur)) return;
    f32x4 acc[2][2][4][2];
#pragma unroll
    for (int a = 0; a < 2; ++a)
#pragma unroll
        for (int b = 0; b < 2; ++b)
#pragma unroll
            for (int m = 0; m < 4; ++m)
#pragma unroll
                for (int n = 0; n < 2; ++n) acc[a][b][m][n] = (f32x4){0.f, 0.f, 0.f, 0.f};
    bf16x8 At[4][2], B0[2][2], B1[2][2];
    const char* cA = (const char*)g.A + (size_t)cur.pm * tstep; const char* cB = (const char*)g.Bt + (size_t)cur.pn * tstep;
    S.a_ready(cur);
    if constexpr (SP2) {
        PG8_STAGE(PG8_SB(0, 0), cB, voffB); PG8_STAGE(PG8_SB(0, 1), cB + hstep, voffB); PG8_STAGE(PG8_SA(0, 0), cA, voffA); PG8_STAGE(PG8_SA(0, 1), cA + hstep, voffA);
        if (wr == 1) PG8_BAR;
        PG8_WAIT_V(2); PG8_BAR;
        PG8_STAGE(PG8_SB(1, 0), cB + kstep, voffB); PG8_STAGE(PG8_SA(1, 0), cA + kstep, voffA); PG8_STAGE(PG8_SB(1, 1), cB + hstep + kstep, voffB);
        PG8_WAIT_V(6); PG8_BAR;
    } else {
        PG8_STAGE(PG8_SB(0, 0), cB, voffB); PG8_STAGE(PG8_SA(0, 0), cA, voffA); PG8_STAGE(PG8_SB(0, 1), cB + hstep, voffB); PG8_STAGE(PG8_SA(0, 1), cA + hstep, voffA);
        if (wr == 1) PG8_BAR;
        PG8_WAIT_V(4); PG8_BAR;
        PG8_STAGE(PG8_SB(1, 0), cB + kstep, voffB); PG8_STAGE(PG8_SA(1, 0), cA + kstep, voffA); PG8_STAGE(PG8_SB(1, 1), cB + hstep + kstep, voffB);
        PG8_WAIT_V(6); PG8_BAR;
    }
    for (;;) {
        const bool has_next = S.next(ui + 1, nxt);
        const char* nA = has_next ? (const char*)g.A + (size_t)nxt.pm * tstep : cA; const char* nB = has_next ? (const char*)g.Bt + (size_t)nxt.pn * tstep : cB;
        for (int t = 0; t < nt; t += 2) {
            const bool last = (t == nt - 2);
            const char* a1 = cA + (size_t)(t + 1) * kstep;
            const char* a2 = last ? nA : cA + (size_t)(t + 2) * kstep; const char* b2 = last ? nB : cB + (size_t)(t + 2) * kstep;
            const char* a3 = a2 + kstep; const char* b3 = b2 + kstep;
            if (last && has_next) S.a_ready(nxt);
            if constexpr (SP2) {
            PG8_LDB(B0, 0, 0); PG8_LDB(B1, 0, 1); PG8_SCHED; PG8_LDA(At, 0, 0); PG8_STAGE(PG8_SA(1, 1), a1 + hstep, voffA);
            PG8_WAIT_V(8); PG8_WAIT_L(0); PG8_BAR; PG8_MMA(0, 0, At, B0); PG8_MMA(0, 1, At, B1); PG8_BAR; PG8_SCHED;
            PG8_LDA(At, 0, 1); PG8_STAGE(PG8_SB(0, 0), b2, voffB); PG8_STAGE(PG8_SB(0, 1), b2 + hstep, voffB); PG8_STAGE(PG8_SA(0, 0), a2, voffA);
            PG8_WAIT_V(8); PG8_WAIT_L(0); PG8_BAR; PG8_MMA(1, 0, At, B0); PG8_MMA(1, 1, At, B1); PG8_BAR; PG8_SCHED;
            PG8_LDB(B0, 1, 0); PG8_LDB(B1, 1, 1); PG8_SCHED; PG8_LDA(At, 1, 0); PG8_STAGE(PG8_SA(0, 1), a2 + hstep, voffA);
            PG8_WAIT_V(8); PG8_WAIT_L(0); PG8_BAR; PG8_MMA(0, 0, At, B0); PG8_MMA(0, 1, At, B1); PG8_BAR; PG8_SCHED;
            PG8_LDA(At, 1, 1); PG8_STAGE(PG8_SB(1, 0), b3, voffB); PG8_STAGE(PG8_SB(1, 1), b3 + hstep, voffB); PG8_STAGE(PG8_SA(1, 0), a3, voffA);
            PG8_WAIT_V(8); PG8_WAIT_L(0); PG8_BAR; PG8_MMA(1, 0, At, B0); PG8_MMA(1, 1, At, B1); PG8_BAR; PG8_SCHED;
            } else {
            PG8_LDB(B0, 0, 0); PG8_SCHED; PG8_LDA(At, 0, 0); PG8_STAGE(PG8_SA(1, 1), a1 + hstep, voffA);
            PG8_WAIT_L(8); PG8_BAR; PG8_WAIT_L(0); PG8_MMA(0, 0, At, B0); PG8_BAR; PG8_SCHED;
            PG8_LDB(B1, 0, 1); PG8_STAGE(PG8_SB(0, 0), b2, voffB);
            PG8_BAR; PG8_WAIT_L(0); PG8_MMA(0, 1, At, B1); PG8_BAR;
            PG8_LDA(At, 0, 1); PG8_STAGE(PG8_SA(0, 0), a2, voffA);
            PG8_BAR; PG8_WAIT_L(0); PG8_MMA(1, 0, At, B0); PG8_BAR; PG8_SCHED;
            PG8_STAGE(PG8_SB(0, 1), b2 + hstep, voffB);
            PG8_WAIT_V(6); PG8_BAR; PG8_MMA(1, 1, At, B1); PG8_BAR;
            PG8_LDB(B0, 1, 0); PG8_SCHED; PG8_LDA(At, 1, 0); PG8_STAGE(PG8_SA(0, 1), a2 + hstep, voffA);
            PG8_WAIT_L(8); PG8_BAR; PG8_WAIT_L(0); PG8_MMA(0, 0, At, B0); PG8_BAR; PG8_SCHED;
            PG8_LDB(B1, 1, 1); PG8_STAGE(PG8_SB(1, 0), b3, voffB);
            PG8_BAR; PG8_WAIT_L(0); PG8_MMA(0, 1, At, B1); PG8_BAR;
            PG8_LDA(At, 1, 1); PG8_STAGE(PG8_SA(1, 0), a3, voffA);
            PG8_BAR; PG8_WAIT_L(0); PG8_MMA(1, 0, At, B0); PG8_BAR; PG8_SCHED;
            PG8_STAGE(PG8_SB(1, 1), b3 + hstep, voffB);
            PG8_WAIT_V(6); PG8_BAR; PG8_MMA(1, 1, At, B1); PG8_BAR;
            }
        }
        if constexpr (ALIGN_EPI) { if (wr == 0) PG8_BAR; }
        if constexpr (!Epi::AFTER_DRAIN) { E(acc, cur, wr, wc, fr, fq); S.done(cur); }
        if (!has_next) break;
#pragma unroll
        for (int a = 0; a < 2; ++a)
#pragma unroll
            for (int b = 0; b < 2; ++b)
#pragma unroll
                for (int m = 0; m < 4; ++m)
#pragma unroll
                    for (int n = 0; n < 2; ++n) acc[a][b][m][n] = (f32x4){0.f, 0.f, 0.f, 0.f};
        cur = nxt; cA = nA; cB = nB; ++ui;
        if constexpr (ALIGN_EPI) { if (wr == 1) PG8_BAR; }
    }
    PG8_WAIT_V(0);
    if constexpr (!ALIGN_EPI) { if (wr == 0) PG8_BAR; }
    PG8_BAR;
    if constexpr (Epi::AFTER_DRAIN) { E.fused(acc, cur, wr, wc, fr, fq, lds, wid, lane); S.done(cur); }
#undef PG8_SA
#undef PG8_SB
#undef PG8_STAGE
#undef PG8_LDA
#undef PG8_LDB
#undef PG8_MMA
#undef PG8_WAIT_V
#undef PG8_WAIT_L
#undef PG8_BAR
#undef PG8_SCHED
}
}
#define XB_TMO      128
#define XB_XCNT(j)  (256  + 64 * (j))
#define XB_XSUB(j)  (1280 + 64 * (j))
#define XB_XGEN(j)  (2304 + 64 * (j))
#define XB_TOP      3328
#define XB_TOPGEN   3392
#define XCD_BAR_WORDS 3456
#define XB_SPIN_CAP (1u << 18)

__device__ __forceinline__ unsigned xb_ld(unsigned* p)              { return __hip_atomic_load(p, __ATOMIC_RELAXED, __HIP_MEMORY_SCOPE_AGENT); }
__device__ __forceinline__ unsigned xb_add(unsigned* p, unsigned v) { return __hip_atomic_fetch_add(p, v, __ATOMIC_RELAXED, __HIP_MEMORY_SCOPE_AGENT); }
__device__ __forceinline__ unsigned xb_xcc_id() { return (unsigned)__builtin_amdgcn_s_getreg((3 << 11) | 20) & 0xFu; }
#define XB_SPIN(cond, bar) do { unsigned _sp = 0; while (cond) { __builtin_amdgcn_s_sleep(1); \
    if ((++_sp & 255u) == 0u) { if (xb_ld(&(bar)[XB_TMO])) break; if (_sp > XB_SPIN_CAP) { atomicAdd(&(bar)[XB_TMO], 1u); break; } } } } while (0)

struct XcdBarrier {
    unsigned* bar; unsigned x;
    volatile LAS unsigned* st;
};

__device__ __forceinline__ XcdBarrier xcd_barrier_post(unsigned* bar, volatile LAS unsigned* st) {
    XcdBarrier b; b.bar = bar; b.x = xb_xcc_id(); b.st = st;
    if (threadIdx.x == 0) (void)xb_add(&bar[XB_XCNT(b.x)], 1u);
    return b;
}
__device__ __forceinline__ void xcd_barrier_complete(unsigned* bar, unsigned x, unsigned& nloc, unsigned& nx) {
    const unsigned G = gridDim.x * gridDim.y * gridDim.z;
    unsigned sum, cnt, mine, sp = 0u;
    for (;;) {
        sum = 0u; cnt = 0u; mine = 0u;
#pragma unroll
        for (unsigned j = 0; j < 16; ++j) { const unsigned c = xb_ld(&bar[XB_XCNT(j)]); sum += c; cnt += (c > 0u) ? 1u : 0u; mine = (j == x) ? c : mine; }
        if (sum == G) break;
        __builtin_amdgcn_s_sleep(1);
        if ((++sp & 255u) == 0u) { if (xb_ld(&bar[XB_TMO])) break; if (sp > XB_SPIN_CAP) { atomicAdd(&bar[XB_TMO], 1u); break; } }
    }
    nloc = mine > 0u ? mine : 1u; nx = cnt > 0u ? cnt : 1u;
}

__device__ __forceinline__ void xcd_barrier(const XcdBarrier& b) {
    asm volatile("s_waitcnt vmcnt(0)" ::: "memory");
    __syncthreads();
    if (threadIdx.x == 0) {
        unsigned* bar = b.bar;
        __builtin_amdgcn_s_waitcnt(0);
        unsigned nloc = b.st[0], nx = b.st[1];
        if (nloc == 0u) { xcd_barrier_complete(bar, b.x, nloc, nx); b.st[0] = nloc; b.st[1] = nx; }
        const unsigned old = xb_add(&bar[XB_XSUB(b.x)], 1u);
        const unsigned gen = old / nloc;
        if (old + 1u == (gen + 1u) * nloc) {
            __builtin_amdgcn_fence(__ATOMIC_RELEASE, "agent");
            asm volatile("s_waitcnt vmcnt(0)" ::: "memory");
            const unsigned og = xb_add(&bar[XB_TOP], 1u);
            const unsigned tg = og / nx;
            if (og + 1u == (tg + 1u) * nx) xb_add(&bar[XB_TOPGEN], 1u);
            else XB_SPIN(xb_ld(&bar[XB_TOPGEN]) == tg, bar);
            __builtin_amdgcn_fence(__ATOMIC_ACQUIRE, "agent");
            xb_add(&bar[XB_XGEN(b.x)], 1u);
            asm volatile("s_waitcnt vmcnt(0)" ::: "memory");
        } else {
            XB_SPIN(xb_ld(&bar[XB_XGEN(b.x)]) == gen, bar);
            __builtin_amdgcn_fence(__ATOMIC_ACQUIRE, "agent");
            asm volatile("s_waitcnt vmcnt(0)" ::: "memory");
        }
    }
    __syncthreads();
}

#ifndef PG8_SP2
#define PG8_SP2 true
#endif
#ifndef PG8_ALIGN
#define PG8_ALIGN true
#endif
#ifndef MK_SPLIT
#define MK_SPLIT 0
#endif

constexpr int DM = 2048, NBATCH = 4, SEQ = 4096, NLAYER = 2, M = NBATCH * SEQ, GW = 512, HD = 128, NH = 4, DFF = 5504, DIN = 6152, NP = 6144;
constexpr int NT = 512, NWAVES = 8;
constexpr float EPS = 1e-6f, KSCALE = 0.08838834764831845f;
constexpr int PH_PER_LAYER = 10, N_PHASES = 1 + NLAYER * PH_PER_LAYER;

constexpr size_t MiB = 1u << 20, KiB = 1024;
constexpr size_t WS_CTL = 0, CTL_ZERO_BYTES = 2 * MiB;
constexpr int CW_BAR = 4096, CW_Q = 8192;
constexpr size_t WS_SSQ = 1 * MiB;
constexpr size_t WS_G = 2 * MiB;
constexpr size_t WS_BLAST = 2560 * KiB, WS_MLOC = WS_BLAST + 4096, WS_MRUN = WS_MLOC + 4096;
constexpr size_t WS_DN = 3 * MiB, WS_NST = 3 * MiB + 512 * KiB;
constexpr size_t WS_LSE = 5 * MiB + 512 * KiB;
constexpr size_t WS_LRUW = 7 * MiB;
constexpr size_t WS_WGU1 = 8 * MiB, WS_WD1 = 52 * MiB, WS_WIN = 74 * MiB, WS_WOUT = 98 * MiB, WS_WGU2 = 106 * MiB, WS_WD2 = 149 * MiB;
constexpr size_t WS_XB = 171 * MiB;
constexpr size_t WS_PACT = 235 * MiB;
constexpr size_t WS_MIXED = 427 * MiB;
constexpr size_t WS_DCT = 491 * MiB;
constexpr size_t WS_CST = 555 * MiB;
constexpr size_t WS_CPART = 587 * MiB;
constexpr size_t WS_DOUT = 635 * MiB;
constexpr size_t WS_LAP = 651 * MiB, WS_LHE = 653 * MiB, WS_LCI = 655 * MiB;
constexpr size_t WS_END = 657 * MiB;
static_assert(WS_WGU1 + (size_t)2 * DFF * DM * 2 <= WS_WD1 && WS_WD1 + (size_t)DM * DFF * 2 <= WS_WIN && WS_WIN + (size_t)NP * DM * 2 <= WS_WOUT && WS_WOUT + (size_t)DM * DM * 2 <= WS_WGU2 &&
              WS_WGU2 + (size_t)2 * DFF * DM * 2 <= WS_WD2 && WS_WD2 + (size_t)DM * DFF * 2 <= WS_XB && WS_PACT + (size_t)M * DFF * 2 <= WS_MIXED && WS_PACT + (size_t)12 * M * 512 * 2 <= WS_MIXED, "ws map");
constexpr size_t SEG_STRIDE = (size_t)M * 512;
enum { SEG_LX = 0, SEG_LG, SEG_MQ, SEG_MK, SEG_MV, SEG_MO, SEG_CQ, SEG_CK, SEG_CV, SEG_SQ, SEG_SK, SEG_SV };

constexpr int LDS_MISC_OFF = 152 * 1024, LDS_BYTES = LDS_MISC_OFF + 64;

typedef unsigned short bf16;
typedef short bf16x8 __attribute__((ext_vector_type(8)));
typedef float f32x4 __attribute__((ext_vector_type(4)));
typedef unsigned v4u __attribute__((ext_vector_type(4)));
typedef unsigned v2u __attribute__((ext_vector_type(2)));
typedef float f32x2 __attribute__((ext_vector_type(2)));
__device__ __forceinline__ int opaque_tid_w(int wid) { int t = (wid << 6) | (int)__builtin_amdgcn_mbcnt_hi(~0u, __builtin_amdgcn_mbcnt_lo(~0u, 0u)); asm volatile("" : "+v"(t)); return t; }
#define opaque_tid() opaque_tid_w(p.wid)
#define LDS_WAIT() asm volatile("s_waitcnt lgkmcnt(0)" ::: "memory")
__device__ __forceinline__ unsigned f2bf(float f) { unsigned u = __builtin_bit_cast(unsigned, f); return (u + 0x7fffu + ((u >> 16) & 1u)) >> 16; }
__device__ __forceinline__ unsigned pk2(float lo, float hi) { return f2bf(lo) | (f2bf(hi) << 16); }
__device__ __forceinline__ float bf2f(unsigned b) { return __builtin_bit_cast(float, b << 16); }
__device__ __forceinline__ float bflo(unsigned w) { return __builtin_bit_cast(float, w << 16); }
__device__ __forceinline__ float bfhi(unsigned w) { return __builtin_bit_cast(float, w & 0xffff0000u); }
__device__ __forceinline__ float wave_sum(float v) {
#pragma unroll
    for (int o = 1; o < 64; o <<= 1) v += __shfl_xor(v, o);
    return v;
}
__device__ __forceinline__ float wave_max(float v) {
#pragma unroll
    for (int o = 1; o < 64; o <<= 1) v = fmaxf(v, __shfl_xor(v, o));
    return v;
}
__device__ __forceinline__ float softplusf(float x) { return fmaxf(x, 0.f) + __logf(1.0f + __expf(-fabsf(x))); }
__device__ __forceinline__ float sigmoidf(float x) { return 1.0f / (1.0f + __expf(-x)); }
__device__ __forceinline__ float gelu_tanh(float x) { const float y = 0.7978845608028654f * (x + 0.044715f * x * x * x); const float t = 1.0f - 2.0f / (1.0f + __expf(2.0f * y)); return 0.5f * x * (1.0f + t); }
template <int K> __device__ __forceinline__ void mma_lds(f32x4& acc, const LAS bf16* X, int ldx, const LAS bf16* Y, int ldy, int lane) {
    const LAS bf16* xp = X + (lane & 15) * ldx + (lane >> 4) * 8;
    const LAS bf16* yp = Y + (lane & 15) * ldy + (lane >> 4) * 8;
#pragma unroll
    for (int k = 0; k < K; k += 32) {
        const bf16x8 a = *(const LAS bf16x8*)(xp + k), b = *(const LAS bf16x8*)(yp + k);
        acc = __builtin_amdgcn_mfma_f32_16x16x32_bf16(a, b, acc, 0, 0, 0);
    }
}

typedef short v4i16_t __attribute__((ext_vector_type(4)));
__device__ __forceinline__ bf16x8 tr_frag(const LAS bf16* T, int ks, int c, int lane) {
    const LAS bf16* a0 = T + (32 * ks + 8 * (lane >> 4) + ((lane & 15) >> 2)) * 144 + 16 * c + 4 * (lane & 3);
    const v4i16_t lo = __builtin_amdgcn_ds_read_tr16_b64_v4i16((LAS v4i16_t*)a0), hi = __builtin_amdgcn_ds_read_tr16_b64_v4i16((LAS v4i16_t*)(a0 + 4 * 144));
    return (bf16x8){lo[0], lo[1], lo[2], lo[3], hi[0], hi[1], hi[2], hi[3]};
}

struct Params { const float* in[24]; float* out; unsigned char* ws; int ph_lo, ph_hi; };
typedef __attribute__((address_space(4))) const unsigned char* kptr_t;
template <typename T> __device__ __forceinline__ T karg(kptr_t k, int off) { return *(const __attribute__((address_space(4))) T*)(k + off); }
struct Ctx { kptr_t k; unsigned char* ws; float* out; int wid;
    __device__ __forceinline__ const float* in(int i) const { return karg<const float*>(k, 8 * i); } };
__device__ __forceinline__ Ctx make_ctx(int wid) { Ctx c; c.wid = wid; kptr_t k = (kptr_t)__builtin_amdgcn_kernarg_segment_ptr(); asm volatile("" : "+s"(k)); c.k = k; c.ws = karg<unsigned char*>(k, 200); c.out = karg<float*>(k, 192); return c; }
static_assert(sizeof(Params) == 216, "kernarg layout");

__device__ __forceinline__ int q_next(const Ctx& p, unsigned* ctr, volatile LAS int* slot) {
    __syncthreads();
    if (opaque_tid() == 0) *slot = (int)__hip_atomic_fetch_add(ctr, 1u, __ATOMIC_RELAXED, __HIP_MEMORY_SCOPE_AGENT);
    __syncthreads();
    return *slot;
}
struct TItem { const float* src; const float* gain; bf16* dst; int ldw, K_dst; };
__device__ __forceinline__ TItem titem(const float* W, int ldw, int K_dst, bf16* WT, int dst_row0, int src_col0, int k0, const float* gain, int lane) {
    const int c = lane >> 3, n4 = lane & 7; TItem t;
    t.src = W + (size_t)(k0 + 16 * c) * ldw + src_col0 + 4 * n4; t.gain = gain ? gain + k0 + 16 * c : nullptr; t.dst = WT + (size_t)(dst_row0 + 4 * n4) * K_dst + k0 + 16 * c; t.ldw = ldw; t.K_dst = K_dst; return t;
}
__device__ __forceinline__ TItem decode_item(const Ctx& p, int l, int it, int lane) {
    constexpr int I_GU = 16 * 344, I_D = 43 * 64, I_IN = 16 * 192, I_OUT = 16 * 64;
    unsigned char* ws = p.ws; int r = it;
    if (r < 2 * I_GU) {
        const int f = r >= I_GU; r -= f * I_GU; const int kb = r / 344, nb = r % 344, pn = nb >> 3, jj = nb & 7;
        const float* src = p.in((f ? 21 : 2) + (jj >> 2)) + (size_t)l * DM * DFF;
        return titem(src, DFF, DM, (bf16*)(ws + (f ? WS_WGU2 : WS_WGU1)), 32 * nb, 128 * pn + 32 * (jj & 3), 128 * kb, p.in(f ? 20 : 1) + l * DM, lane); }
    r -= 2 * I_GU;
    if (r < 2 * I_D) {
        const int f = r >= I_D; r -= f * I_D; const int kb = r / 64, nb = r % 64;
        return titem(p.in(f ? 23 : 4) + (size_t)l * DFF * DM, DM, DFF, (bf16*)(ws + (f ? WS_WD2 : WS_WD1)), 32 * nb, 32 * nb, 128 * kb, nullptr, lane); }
    r -= 2 * I_D;
    if (r < I_IN) {
        const int kb = r / 192, nb = r % 192, d0 = 32 * nb;
        return titem(p.in(6) + (size_t)l * DM * DIN, DIN, DM, (bf16*)(ws + WS_WIN), d0, d0 + (d0 >= 3072 ? 8 : 0), 128 * kb, p.in(5) + l * DM, lane); }
    r -= I_IN;
    if (r < I_OUT) { const int kb = r / 64, nb = r % 64;
        return titem(p.in(19) + (size_t)l * DM * DM, DM, DM, (bf16*)(ws + WS_WOUT), 32 * nb, 32 * nb, 128 * kb, nullptr, lane); }
    r -= I_OUT;
    const int mat = r >> 4, n = (r >> 2) & 3, nb = r & 3;
    return titem(p.in(mat ? 11 : 9) + (size_t)l * 65536 + n * 16384, 128, 128, (bf16*)(ws + WS_LRUW) + (mat * 4 + n) * 16384, 32 * nb, 32 * nb, 0, nullptr, lane);
}
__device__ __forceinline__ void convert_layer(const Ctx& p, int l, int part) {
    const int tid = opaque_tid(), lane = tid & 63, w = tid >> 6;
    const int gw = blockIdx.x * NWAVES + w, NGW = gridDim.x * NWAVES;
    constexpr int NITEMS_ALL = 2 * 16 * 344 + 2 * 43 * 64 + 16 * 192 + 16 * 64 + 32, THIRD = (NITEMS_ALL + 2) / 3;
    const int it0 = part < 0 ? 0 : part * THIRD, NITEMS = part < 0 ? NITEMS_ALL : (it0 + THIRD < NITEMS_ALL ? it0 + THIRD : NITEMS_ALL);
    for (int it = it0 + gw; it < NITEMS; it += NGW) {
        const TItem t = decode_item(p, l, it, lane);
        f32x4 v[16];
#pragma unroll
        for (int e = 0; e < 16; ++e) v[e] = *(const f32x4*)(t.src + (size_t)e * t.ldw);
        if (t.gain) {
#pragma unroll
            for (int q = 0; q < 4; ++q) { const f32x4 g = *(const f32x4*)(t.gain + 4 * q);
#pragma unroll
                for (int e = 0; e < 4; ++e) v[4 * q + e] = v[4 * q + e] * g[e]; } }
#pragma unroll
        for (int j = 0; j < 4; ++j) {
            v4u o0, o1; o0.x = pk2(v[0][j], v[1][j]); o0.y = pk2(v[2][j], v[3][j]); o0.z = pk2(v[4][j], v[5][j]); o0.w = pk2(v[6][j], v[7][j]);
            o1.x = pk2(v[8][j], v[9][j]); o1.y = pk2(v[10][j], v[11][j]); o1.z = pk2(v[12][j], v[13][j]); o1.w = pk2(v[14][j], v[15][j]);
            *(v4u*)(t.dst + (size_t)j * t.K_dst) = o0; *(v4u*)(t.dst + (size_t)j * t.K_dst + 8) = o1;
        }
    }
}
__device__ __forceinline__ void prologue_x(const Ctx& p) {
    const int tid = opaque_tid(), lane = tid & 63, w = tid >> 6;
    const int gw = blockIdx.x * NWAVES + w, NGW = gridDim.x * NWAVES;
    bf16* xb = (bf16*)(p.ws + WS_XB); unsigned long long* ssq = (unsigned long long*)(p.ws + WS_SSQ);
    for (int m = gw; m < M; m += NGW) {
        const f32x4* xr = (const f32x4*)(p.in(0) + (size_t)m * DM) + lane; float s = 0.f;
        v2u* o8 = (v2u*)(xb + (size_t)m * DM) + lane;
#pragma unroll
        for (int j = 0; j < 8; ++j) { const f32x4 v = xr[64 * j]; s += (v[0] * v[0] + v[1] * v[1]) + (v[2] * v[2] + v[3] * v[3]); v2u o; o.x = pk2(v[0], v[1]); o.y = pk2(v[2], v[3]); o8[64 * j] = o; }
        s = wave_sum(s);
        if (lane == 0) ssq[m] = (unsigned long long)(s * pg8::SSQ_FX + 0.5f);
    }
}
__device__ __forceinline__ void gates_phase(const Ctx& p, int l, const unsigned long long* ssq, LAS unsigned char* lds) {
    const int tid = opaque_tid(), lane = tid & 63, w = tid >> 6;
    LAS float* WG8 = (LAS float*)lds;
    const float* win = p.in(6) + (size_t)l * DM * DIN; const float* gain = p.in(5) + l * DM;
    for (int idx = tid; idx < DM * 8; idx += NT) { const int k = idx >> 3, c = idx & 7; WG8[k * 8 + (k >> 3) * 4 + c] = win[(size_t)k * DIN + 3072 + c] * gain[k]; }
    __syncthreads();
    const bf16* xb = (const bf16*)(p.ws + WS_XB); float* G = (float*)(p.ws + WS_G);
    for (int rb = blockIdx.x; rb < M / 64; rb += gridDim.x)
        for (int rr = 0; rr < 8; ++rr) {
            const int row = rb * 64 + w * 8 + rr;
            float a8[8];
#pragma unroll
            for (int c = 0; c < 8; ++c) a8[c] = 0.f;
#pragma unroll 1
            for (int it = 0; it < 4; ++it) {
                const int k0 = it * 512 + lane * 8;
                const v4u xv = *(const v4u*)(xb + (size_t)row * DM + k0);
                const float xs[8] = {bflo(xv.x), bfhi(xv.x), bflo(xv.y), bfhi(xv.y), bflo(xv.z), bfhi(xv.z), bflo(xv.w), bfhi(xv.w)};
#pragma unroll
                for (int e = 0; e < 8; ++e) { const int k = k0 + e; const LAS f32x4* wp = (const LAS f32x4*)(WG8 + k * 8 + (k >> 3) * 4); const f32x4 w0 = wp[0], w1 = wp[1];
                    a8[0] += xs[e] * w0[0]; a8[1] += xs[e] * w0[1]; a8[2] += xs[e] * w0[2]; a8[3] += xs[e] * w0[3]; a8[4] += xs[e] * w1[0]; a8[5] += xs[e] * w1[1]; a8[6] += xs[e] * w1[2]; a8[7] += xs[e] * w1[3]; }
            }
            const float rs = __builtin_amdgcn_rsqf((float)ssq[row] * (1.0f / (DM * pg8::SSQ_FX)) + EPS);
            float mine = 0.f;
#pragma unroll
            for (int c = 0; c < 8; ++c) { const float s = wave_sum(a8[c]); if (lane == c) mine = s; }
            if (lane < 8) G[(size_t)row * 8 + lane] = mine * rs;
        }
    __syncthreads();
}

constexpr int LRU_T = 16, LRU_NC = SEQ / LRU_T;
template <int PASS>
__device__ __forceinline__ void lru_unit(const Ctx& p, int l, int u, LAS unsigned char* lds) {
    const int tid = opaque_tid(), lane = tid & 63, w = tid >> 6, fr = lane & 15, fq = lane >> 4;
    const int b = u >> 8, c = u & 255, row0 = b * SEQ + c * LRU_T;
    LAS float* XC = (LAS float*)lds;
    LAS float* AA = (LAS float*)(lds + 32768);
    LAS bf16* XCB = (LAS bf16*)(lds + 65536);
    LAS bf16* Y = (LAS bf16*)(lds + 82176);
    const bf16* xr = (const bf16*)(p.ws + WS_PACT) + SEG_LX * SEG_STRIDE;
    const bf16* gt = (const bf16*)(p.ws + WS_PACT) + SEG_LG * SEG_STRIDE;
    float gate_v[16];
    if (PASS == 3) {
#pragma unroll
        for (int t = 0; t < 16; ++t) gate_v[t] = bf2f(gt[(size_t)(row0 + t) * GW + tid]);
    }
    {
        const int ch = 2 * (tid & 255), th = tid >> 8;
        const float* cw = p.in(7) + l * 4 * GW + ch; const float* cb = p.in(8) + l * GW + ch;
        const f32x2 w0 = *(const f32x2*)cw, w1 = *(const f32x2*)(cw + GW), w2 = *(const f32x2*)(cw + 2 * GW), w3 = *(const f32x2*)(cw + 3 * GW), cbv = *(const f32x2*)cb;
        const bf16* xp = xr + (size_t)(row0 + 8 * th - 3) * GW + ch;
        unsigned xv[11];
#pragma unroll
        for (int i = 0; i < 11; ++i) xv[i] = (c * LRU_T + 8 * th - 3 + i >= 0) ? *(const unsigned*)(xp + (size_t)i * GW) : 0u;
#pragma unroll
        for (int i = 0; i < 8; ++i) {
            const int t = 8 * th + i;
            const float xa = w0.x * bflo(xv[i]) + w1.x * bflo(xv[i + 1]) + w2.x * bflo(xv[i + 2]) + w3.x * bflo(xv[i + 3]) + cbv.x;
            const float xbv = w0.y * bfhi(xv[i]) + w1.y * bfhi(xv[i + 1]) + w2.y * bfhi(xv[i + 2]) + w3.y * bfhi(xv[i + 3]) + cbv.y;
            *(LAS f32x2*)(XC + t * 512 + ch) = (f32x2){xa, xbv}; *(LAS unsigned*)(XCB + t * 520 + ch) = pk2(xa, xbv);
        }
    }
    __syncthreads();
    {
        const int n = w >> 1;
        const float* ba = p.in(10) + l * GW; const float* bx = p.in(12) + l * GW; const float* lam = p.in(13) + l * GW;
        const bf16* WaT = (const bf16*)(p.ws + WS_LRUW); const bf16* WxT = WaT + 4 * 16384;
        const LAS bf16* xp = XCB + fr * 520 + n * 128 + 8 * fq;
        bf16x8 af[4];
#pragma unroll
        for (int k = 0; k < 4; ++k) af[k] = *(const LAS bf16x8*)(xp + 32 * k);
#pragma unroll
        for (int ds = 0; ds < 4; ++ds) {
            const int d0 = 16 * (4 * (w & 1) + ds);
            const bf16* wap = WaT + (size_t)(n * 128 + d0 + fr) * 128 + 8 * fq; const bf16* wxp = WxT + (size_t)(n * 128 + d0 + fr) * 128 + 8 * fq;
            f32x4 za = {0.f, 0.f, 0.f, 0.f}, zx = {0.f, 0.f, 0.f, 0.f};
#pragma unroll
            for (int k = 0; k < 4; ++k) {
                const bf16x8 b1 = *(const bf16x8*)(wap + 32 * k), b2 = *(const bf16x8*)(wxp + 32 * k);
                za = __builtin_amdgcn_mfma_f32_16x16x32_bf16(af[k], b1, za, 0, 0, 0); zx = __builtin_amdgcn_mfma_f32_16x16x32_bf16(af[k], b2, zx, 0, 0, 0);
            }
            const int dg = n * 128 + d0 + fr; const float bav = ba[dg], bxv = bx[dg], spl = 8.0f * softplusf(-lam[dg]);
#pragma unroll
            for (int j = 0; j < 4; ++j) {
                const int t = 4 * fq + j;
                const float r = sigmoidf(za[j] + bav), ii = sigmoidf(zx[j] + bxv), loga = -spl * r, a = __expf(loga), mult = sqrtf(-expm1f(2.0f * loga));
                const float xc = XC[t * 512 + dg]; AA[t * 512 + dg] = a; XC[t * 512 + dg] = mult * ii * xc;
            }
        }
    }
    __syncthreads();
    {
        const int dg = tid; const size_t ci = (size_t)(b * LRU_NC + c) * GW + dg;
        float h = (PASS == 3) ? ((const float*)(p.ws + WS_LCI))[ci] : 0.f, ap = 1.f;
#pragma unroll
        for (int t = 0; t < 16; ++t) { const float a = AA[t * 512 + dg], uu = XC[t * 512 + dg]; h = a * h + uu; ap *= a; if (PASS == 3) Y[t * 520 + dg] = (bf16)f2bf(h * gelu_tanh(gate_v[t])); }
        if (PASS == 1) { ((float*)(p.ws + WS_LAP))[ci] = ap; ((float*)(p.ws + WS_LHE))[ci] = h; }
    }
    if (PASS == 3) {
        __syncthreads();
        const float* ga = p.in(18) + l * DM; bf16* mixed = (bf16*)(p.ws + WS_MIXED);
        float gv[8];
#pragma unroll
        for (int e = 0; e < 8; ++e) gv[e] = ga[lane * 8 + e];
#pragma unroll
        for (int tt = 0; tt < 2; ++tt) {
            const int t = w * 2 + tt; const v4u v = *(const LAS v4u*)(Y + t * 520 + lane * 8);
            float f[8] = {bflo(v.x), bfhi(v.x), bflo(v.y), bfhi(v.y), bflo(v.z), bfhi(v.z), bflo(v.w), bfhi(v.w)}; float ss = 0.f;
#pragma unroll
            for (int e = 0; e < 8; ++e) ss += f[e] * f[e];
            ss = wave_sum(ss); const float rs = __builtin_amdgcn_rsqf(ss * (1.0f / GW) + EPS);
            v4u o; o.x = pk2(f[0] * rs * gv[0], f[1] * rs * gv[1]); o.y = pk2(f[2] * rs * gv[2], f[3] * rs * gv[3]); o.z = pk2(f[4] * rs * gv[4], f[5] * rs * gv[5]); o.w = pk2(f[6] * rs * gv[6], f[7] * rs * gv[7]);
            *(v4u*)(mixed + (size_t)(row0 + t) * DM + lane * 8) = o;
        }
    }
}
__device__ __forceinline__ void lru_carry_unit(const Ctx& p, int b) {
    const int ch = opaque_tid(); const float* LAP = (const float*)(p.ws + WS_LAP); const float* LHE = (const float*)(p.ws + WS_LHE); float* LCI = (float*)(p.ws + WS_LCI);
    float carry = 0.f;
    for (int c0 = 0; c0 < LRU_NC; c0 += 32) {
        float ap[32], he[32];
#pragma unroll
        for (int j = 0; j < 32; ++j) { const size_t o = (size_t)(b * LRU_NC + c0 + j) * GW + ch; ap[j] = LAP[o]; he[j] = LHE[o]; }
#pragma unroll
        for (int j = 0; j < 32; ++j) { LCI[(size_t)(b * LRU_NC + c0 + j) * GW + ch] = carry; carry = ap[j] * carry + he[j]; }
    }
}

__device__ __forceinline__ void mlstm1_unit(const Ctx& p, int l, int u, LAS unsigned char* lds) {
    const int tid = opaque_tid(), lane = tid & 63, w = tid >> 6, fr = lane & 15, fq = lane >> 4;
    const int bh = u >> 6, c = u & 63, b = bh >> 2, h = bh & 3, row0 = b * SEQ + c * 64;
    LAS bf16* VH = (LAS bf16*)lds;
    LAS bf16* KW = (LAS bf16*)(lds + 18432);
    LAS float* WS = (LAS float*)(lds + 36864);
    const float* G = (const float*)(p.ws + WS_G);
    const bf16* Kg = (const bf16*)(p.ws + WS_PACT) + SEG_MK * SEG_STRIDE + h * HD; const bf16* Vg = (const bf16*)(p.ws + WS_PACT) + SEG_MV * SEG_STRIDE + h * HD;
    v4u kvr[2], vvr[2];
#pragma unroll
    for (int i = 0; i < 2; ++i) { const int q = tid + NT * i, s = q >> 4, kc = (q & 15) * 8; kvr[i] = *(const v4u*)(Kg + (size_t)(row0 + s) * GW + kc); vvr[i] = *(const v4u*)(Vg + (size_t)(row0 + s) * GW + kc); }
    if (w == 0) {
        const int s = lane;
        const float ip = G[(size_t)(row0 + s) * 8 + h] + p.in(14)[l * NH + h], fp = G[(size_t)(row0 + s) * 8 + 4 + h] + p.in(15)[l * NH + h];
        float bc = -softplusf(-fp);
#pragma unroll
        for (int o = 1; o < 64; o <<= 1) { const float t = __shfl_up(bc, o); if (lane >= o) bc += t; }
        const float blast = __shfl(bc, 63), logw = blast - bc + ip, mloc = wave_max(logw);
        WS[s] = __expf(logw - mloc);
        if (lane == 0) { ((float*)(p.ws + WS_BLAST))[u] = blast; ((float*)(p.ws + WS_MLOC))[u] = mloc; }
    }
    __syncthreads();
#pragma unroll
    for (int i = 0; i < 2; ++i) {
        const int q = tid + NT * i, s = q >> 4, kc = (q & 15) * 8;
        const v4u kv = kvr[i]; const float ws = WS[s] * KSCALE;
        v4u ko; ko.x = pk2(bflo(kv.x) * ws, bfhi(kv.x) * ws); ko.y = pk2(bflo(kv.y) * ws, bfhi(kv.y) * ws); ko.z = pk2(bflo(kv.z) * ws, bfhi(kv.z) * ws); ko.w = pk2(bflo(kv.w) * ws, bfhi(kv.w) * ws);
        *(LAS v4u*)(KW + s * 144 + kc) = ko; *(LAS v4u*)(VH + s * 144 + kc) = vvr[i];
    }
    __syncthreads();
    float* DCT = (float*)(p.ws + WS_DCT) + (size_t)u * 16384;
    const bf16x8 vb0 = tr_frag(VH, 0, w, lane), vb1 = tr_frag(VH, 1, w, lane);
#pragma unroll
    for (int ki = 0; ki < 8; ++ki) {
        f32x4 acc = {0.f, 0.f, 0.f, 0.f};
        acc = __builtin_amdgcn_mfma_f32_16x16x32_bf16(tr_frag(KW, 0, ki, lane), vb0, acc, 0, 0, 0);
        acc = __builtin_amdgcn_mfma_f32_16x16x32_bf16(tr_frag(KW, 1, ki, lane), vb1, acc, 0, 0, 0);
        *(f32x4*)(DCT + (16 * w + fr) * 128 + 16 * ki + 4 * fq) = acc;
    }
    if (tid < 128) { float s = 0.f;
#pragma unroll 8
        for (int t = 0; t < 64; ++t) s += bf2f(KW[t * 144 + tid]);
        ((float*)(p.ws + WS_DN))[(size_t)u * 128 + tid] = s; }
}
__device__ __forceinline__ void mlstm_scan_unit(const Ctx& p, int su) {
    const int tid = opaque_tid(), bh = su >> 3, slice = su & 7, e0 = slice * 2048 + tid * 4;
    const float* DCT = (const float*)(p.ws + WS_DCT); bf16* CST = (bf16*)(p.ws + WS_CST);
    const float* DN = (const float*)(p.ws + WS_DN); float* NST = (float*)(p.ws + WS_NST);
    const float* BL = (const float*)(p.ws + WS_BLAST); const float* ML = (const float*)(p.ws + WS_MLOC); float* MR = (float*)(p.ws + WS_MRUN);
    f32x4 C = {0.f, 0.f, 0.f, 0.f}, nv = {0.f, 0.f, 0.f, 0.f}; float mrun = 0.f;
    const bool donv = (slice == 0 && tid < 32);
    for (int c0 = 0; c0 < 64; c0 += 16) {
        f32x4 d4[16], n4[16]; float bl[16], ml[16];
#pragma unroll
        for (int j = 0; j < 16; ++j) { const int ui = bh * 64 + c0 + j; d4[j] = *(const f32x4*)(DCT + (size_t)ui * 16384 + e0); bl[j] = BL[ui]; ml[j] = ML[ui];
            n4[j] = donv ? *(const f32x4*)(DN + (size_t)ui * 128 + tid * 4) : (f32x4){0.f, 0.f, 0.f, 0.f}; }
#pragma unroll
        for (int j = 0; j < 16; ++j) {
            const int ui = bh * 64 + c0 + j;
            v2u o; o.x = pk2(C[0], C[1]); o.y = pk2(C[2], C[3]); *(v2u*)(CST + (size_t)ui * 16384 + e0) = o;
            if (donv) *(f32x4*)(NST + (size_t)ui * 128 + tid * 4) = nv;
            if (slice == 0 && tid == 0) MR[ui] = mrun;
            const float mnext = fmaxf(bl[j] + mrun, ml[j]), dec = __expf(bl[j] + mrun - mnext), sc = __expf(ml[j] - mnext);
            C = C * dec + d4[j] * sc; nv = nv * dec + n4[j] * sc; mrun = mnext;
        }
    }
}
__device__ __forceinline__ void mlstm3_unit(const Ctx& p, int l, int u, LAS unsigned char* lds) {
    const int tid = opaque_tid(), lane = tid & 63, w = tid >> 6, fr = lane & 15, fq = lane >> 4;
    const int bh = u >> 6, c = u & 63, b = bh >> 2, h = bh & 3, row0 = b * SEQ + c * 64;
    LAS bf16* Q = (LAS bf16*)lds;
    LAS bf16* KS = (LAS bf16*)(lds + 17408);
    LAS bf16* VH = (LAS bf16*)(lds + 34816);
    LAS bf16* CT = (LAS bf16*)(lds + 53248);
    LAS bf16* SB = (LAS bf16*)(lds + 88064);
    LAS float* HF = (LAS float*)(lds + 97280);
    LAS float* BV = (LAS float*)(lds + 130304);
    LAS float* CV = BV + 64;
    LAS float* MT = BV + 128;
    LAS float* WI = BV + 192;
    LAS float* QN = BV + 256;
    LAS float* NV = BV + 320;
    LAS float* RSP = BV + 448;
    const float* G = (const float*)(p.ws + WS_G);
    const bf16* Qg = (const bf16*)(p.ws + WS_PACT) + SEG_MQ * SEG_STRIDE + h * HD; const bf16* Kg = (const bf16*)(p.ws + WS_PACT) + SEG_MK * SEG_STRIDE + h * HD;
    const bf16* Vg = (const bf16*)(p.ws + WS_PACT) + SEG_MV * SEG_STRIDE + h * HD; const bf16* Cg = (const bf16*)(p.ws + WS_CST) + (size_t)u * 16384;
    const bf16* Og = (const bf16*)(p.ws + WS_PACT) + SEG_MO * SEG_STRIDE + h * HD;
    {
        v4u qv[2], kv[2], vv[2], cv4[4];
#pragma unroll
        for (int i = 0; i < 2; ++i) { const int q = tid + NT * i, s = q >> 4, kc = (q & 15) * 8;
            qv[i] = *(const v4u*)(Qg + (size_t)(row0 + s) * GW + kc); kv[i] = *(const v4u*)(Kg + (size_t)(row0 + s) * GW + kc); vv[i] = *(const v4u*)(Vg + (size_t)(row0 + s) * GW + kc); }
#pragma unroll
        for (int i = 0; i < 4; ++i) { const int q = tid + NT * i, r = q >> 4, kc = (q & 15) * 8; cv4[i] = *(const v4u*)(Cg + r * 128 + kc); }
        if (w == 0) {
            const int s = lane;
            const float ip = G[(size_t)(row0 + s) * 8 + h] + p.in(14)[l * NH + h], fp = G[(size_t)(row0 + s) * 8 + 4 + h] + p.in(15)[l * NH + h];
            float bc = -softplusf(-fp);
#pragma unroll
            for (int o = 1; o < 64; o <<= 1) { const float t = __shfl_up(bc, o); if (lane >= o) bc += t; }
            const float cv = ip - bc; float g = cv;
#pragma unroll
            for (int o = 1; o < 64; o <<= 1) { const float t = __shfl_up(g, o); if (lane >= o) g = fmaxf(g, t); }
            const float mrun = ((const float*)(p.ws + WS_MRUN))[u], mt = bc + fmaxf(mrun, g);
            BV[s] = bc; CV[s] = cv; MT[s] = mt; WI[s] = __expf(bc + mrun - mt);
        }
        if (tid >= 64 && tid < 192) NV[tid - 64] = ((const float*)(p.ws + WS_NST))[(size_t)u * 128 + tid - 64];
#pragma unroll
        for (int i = 0; i < 2; ++i) { const int q = tid + NT * i, s = q >> 4, kc = (q & 15) * 8;
            *(LAS v4u*)(Q + s * 136 + kc) = qv[i];
            v4u ko; ko.x = pk2(bflo(kv[i].x) * KSCALE, bfhi(kv[i].x) * KSCALE); ko.y = pk2(bflo(kv[i].y) * KSCALE, bfhi(kv[i].y) * KSCALE); ko.z = pk2(bflo(kv[i].z) * KSCALE, bfhi(kv[i].z) * KSCALE); ko.w = pk2(bflo(kv[i].w) * KSCALE, bfhi(kv[i].w) * KSCALE);
            *(LAS v4u*)(KS + s * 136 + kc) = ko; *(LAS v4u*)(VH + s * 144 + kc) = vv[i]; }
#pragma unroll
        for (int i = 0; i < 4; ++i) { const int q = tid + NT * i, r = q >> 4, kc = (q & 15) * 8; *(LAS v4u*)(CT + r * 136 + kc) = cv4[i]; }
    }
    float op0[8], op1[8];
#pragma unroll
    for (int tt = 0; tt < 8; ++tt) { op0[tt] = bf2f(Og[(size_t)(row0 + w * 8 + tt) * GW + lane]); op1[tt] = bf2f(Og[(size_t)(row0 + w * 8 + tt) * GW + lane + 64]); }
    __syncthreads();
    const int ti = w >> 1;
    {
#pragma unroll
        for (int x = 0; x < 2; ++x) {
            const int si = 2 * (w & 1) + x;
            f32x4 acc = {0.f, 0.f, 0.f, 0.f};
            if (si <= ti) mma_lds<128>(acc, Q + 16 * ti * 136, 136, KS + 16 * si * 136, 136, lane);
            const int s = 16 * si + fr; const float cvs = CV[s];
#pragma unroll
            for (int j = 0; j < 4; ++j) { const int t = 16 * ti + 4 * fq + j; const float sd = (s <= t) ? acc[j] * __expf(BV[t] + cvs - MT[t]) : 0.f;
                SB[t * 72 + s] = (bf16)f2bf(sd);
                float r = sd; r += __shfl_xor(r, 1); r += __shfl_xor(r, 2); r += __shfl_xor(r, 4); r += __shfl_xor(r, 8);
                if (fr == 0) RSP[t * 4 + si] = r; }
        }
        if (w == 7) { const int t = lane; float qn = 0.f;
#pragma unroll 8
            for (int k = 0; k < 128; ++k) qn += bf2f(Q[t * 136 + k]) * NV[k];
            QN[t] = qn; }
    }
    __syncthreads();
    {
        const bf16x8 sa0 = *(const LAS bf16x8*)(SB + (16 * ti + fr) * 72 + 8 * fq), sa1 = *(const LAS bf16x8*)(SB + (16 * ti + fr) * 72 + 32 + 8 * fq);
        float wi[4], dinv[4];
#pragma unroll
        for (int j = 0; j < 4; ++j) { const int t = 16 * ti + 4 * fq + j; wi[j] = WI[t];
            const float den = (RSP[t * 4] + RSP[t * 4 + 1]) + (RSP[t * 4 + 2] + RSP[t * 4 + 3]) + wi[j] * QN[t];
            dinv[j] = 1.0f / fmaxf(fabsf(den), __expf(-MT[t])); }
#pragma unroll
        for (int x = 0; x < 4; ++x) {
            const int vi = 4 * (w & 1) + x;
            f32x4 a1 = {0.f, 0.f, 0.f, 0.f}, a2 = {0.f, 0.f, 0.f, 0.f};
            a1 = __builtin_amdgcn_mfma_f32_16x16x32_bf16(sa0, tr_frag(VH, 0, vi, lane), a1, 0, 0, 0);
            a1 = __builtin_amdgcn_mfma_f32_16x16x32_bf16(sa1, tr_frag(VH, 1, vi, lane), a1, 0, 0, 0);
            mma_lds<128>(a2, Q + 16 * ti * 136, 136, CT + 16 * vi * 136, 136, lane);
#pragma unroll
            for (int j = 0; j < 4; ++j) HF[(16 * ti + 4 * fq + j) * 129 + 16 * vi + fr] = (a1[j] + wi[j] * a2[j]) * dinv[j];
        }
    }
    __syncthreads();
    {
        const float* gb = p.in(18) + l * DM + GW + h * HD; bf16* mixed = (bf16*)(p.ws + WS_MIXED);
        const float g0 = gb[lane], g1 = gb[lane + 64];
#pragma unroll
        for (int tt = 0; tt < 8; ++tt) {
            const int t = w * 8 + tt; const float h0 = HF[t * 129 + lane], h1 = HF[t * 129 + lane + 64];
            const float ss = wave_sum(h0 * h0 + h1 * h1), rs = __builtin_amdgcn_rsqf(ss * (1.0f / HD) + EPS);
            bf16* mo = mixed + (size_t)(row0 + t) * DM + GW + h * HD;
            mo[lane] = (bf16)f2bf(h0 * rs * g0 * sigmoidf(op0[tt])); mo[lane + 64] = (bf16)f2bf(h1 * rs * g1 * sigmoidf(op1[tt]));
        }
    }
}

template <int NCH> __device__ __forceinline__ void ld_rows(v4u (&r)[NCH], const bf16* src, int gbase, int gstride, int tid) {
#pragma unroll
    for (int i = 0; i < NCH; ++i) { const int q = tid + NT * i, row = q >> 4, kc = (q & 15) * 8; r[i] = *(const v4u*)(src + (size_t)(gbase + row * gstride) * GW + kc); }
}
template <bool NORM, int NCH, int PITCH> __device__ __forceinline__ void st_rows(LAS bf16* dst, const v4u (&r)[NCH], const float (&gain)[8], int tid) {
#pragma unroll
    for (int i = 0; i < NCH; ++i) {
        const int q = tid + NT * i, row = q >> 4, kc = (q & 15) * 8; v4u v = r[i];
        if (NORM) {
            float f[8] = {bflo(v.x), bfhi(v.x), bflo(v.y), bfhi(v.y), bflo(v.z), bfhi(v.z), bflo(v.w), bfhi(v.w)}; float ss = 0.f;
#pragma unroll
            for (int e = 0; e < 8; ++e) ss += f[e] * f[e];
            ss += __shfl_xor(ss, 1); ss += __shfl_xor(ss, 2); ss += __shfl_xor(ss, 4); ss += __shfl_xor(ss, 8);
            const float rs = __builtin_amdgcn_rsqf(ss * (1.0f / HD) + EPS);
            v.x = pk2(f[0] * rs * gain[0], f[1] * rs * gain[1]); v.y = pk2(f[2] * rs * gain[2], f[3] * rs * gain[3]);
            v.z = pk2(f[4] * rs * gain[4], f[5] * rs * gain[5]); v.w = pk2(f[6] * rs * gain[6], f[7] * rs * gain[7]);
        }
        *(LAS v4u*)(dst + row * PITCH + kc) = v;
    }
}
constexpr int ATT_K = 0, ATT_V = 17408, ATT_PL = 35840, ATT_VOTE = 72704, ATT_Q = 73728;
__device__ __forceinline__ void load_qfrags(bf16x8 (&qf)[2][4], const LAS bf16* QH, int w, int lane) {
#pragma unroll
    for (int rt = 0; rt < 2; ++rt)
#pragma unroll
        for (int k = 0; k < 4; ++k) qf[rt][k] = *(const LAS bf16x8*)(QH + (32 * w + 16 * rt + (lane & 15)) * 136 + 32 * k + 8 * (lane >> 4));
}

__device__ __forceinline__ void dilated_unit(const Ctx& p, int l, int u, LAS unsigned char* lds) {
    const int tid = opaque_tid(), lane = tid & 63, w = tid >> 6, fr = lane & 15, fq = lane >> 4;
    const int pat = u >> 8, rem = u & 255, bh = rem >> 4, x = rem & 15, b = bh >> 2, h = bh & 3;
    const int d = pat == 0 ? 1 : (pat == 1 ? 4 : 16);
    const int r = pat == 0 ? 0 : (pat == 1 ? (x >> 2) : x), nbk = pat == 0 ? x : (pat == 1 ? (x & 3) : 0);
    LAS bf16* QH = (LAS bf16*)(lds + ATT_Q); LAS bf16* KH = (LAS bf16*)(lds + ATT_K); LAS bf16* VH = (LAS bf16*)(lds + ATT_V); LAS bf16* PL = (LAS bf16*)(lds + ATT_PL) + w * 32 * 72;
    const bf16* Qg = (const bf16*)(p.ws + WS_PACT) + SEG_CQ * SEG_STRIDE + h * HD; const bf16* Kg = (const bf16*)(p.ws + WS_PACT) + SEG_CK * SEG_STRIDE + h * HD;
    const bf16* Vg = (const bf16*)(p.ws + WS_PACT) + SEG_CV * SEG_STRIDE + h * HD;
    float qgain[8], kgain[8];
#pragma unroll
    for (int e = 0; e < 8; ++e) { qgain[e] = p.in(16)[l * HD + (tid & 15) * 8 + e]; kgain[e] = p.in(17)[l * HD + (tid & 15) * 8 + e]; }
    const float slope_d = exp2f(-2.0f * (float)(h + 1)) * (float)d;
    const int kt0 = (nbk == 0 ? 2 : 0), gk0 = b * SEQ + (nbk * 256 - 128) * d + r;
    v4u kr[2], vr[2];
    { v4u qr[8]; ld_rows<8>(qr, Qg, b * SEQ + (nbk * 256) * d + r, d, tid); ld_rows<2>(kr, Kg, gk0 + kt0 * 64 * d, d, tid); ld_rows<2>(vr, Vg, gk0 + kt0 * 64 * d, d, tid);
      st_rows<true, 8, 136>(QH, qr, qgain, tid); }
    __syncthreads();
    bf16x8 qf[2][4]; load_qfrags(qf, QH, w, lane);
    float m_i[2] = {-1e30f, -1e30f}, l_i[2] = {0.f, 0.f}; f32x4 o[2][8];
#pragma unroll
    for (int rt = 0; rt < 2; ++rt)
#pragma unroll
        for (int ds = 0; ds < 8; ++ds) o[rt][ds] = (f32x4){0.f, 0.f, 0.f, 0.f};
    for (int kt = kt0; kt < 6; ++kt) {
        __syncthreads();
        st_rows<true, 2, 136>(KH, kr, kgain, tid); st_rows<false, 2, 144>(VH, vr, kgain, tid);
        __syncthreads();
        if (kt < 5) { ld_rows<2>(kr, Kg, gk0 + (kt + 1) * 64 * d, d, tid); ld_rows<2>(vr, Vg, gk0 + (kt + 1) * 64 * d, d, tid); }
        if ((64 * kt + 63 >= 32 * w) && (64 * kt <= 32 * w + 31 + 128)) {
            f32x4 s[2][4];
#pragma unroll
            for (int rt = 0; rt < 2; ++rt)
#pragma unroll
                for (int n = 0; n < 4; ++n) s[rt][n] = (f32x4){0.f, 0.f, 0.f, 0.f};
#pragma unroll
            for (int k = 0; k < 4; ++k)
#pragma unroll
                for (int n = 0; n < 4; ++n) { const bf16x8 kf = *(const LAS bf16x8*)(KH + (16 * n + fr) * 136 + 32 * k + 8 * fq);
                    s[0][n] = __builtin_amdgcn_mfma_f32_16x16x32_bf16(kf, qf[0][k], s[0][n], 0, 0, 0); s[1][n] = __builtin_amdgcn_mfma_f32_16x16x32_bf16(kf, qf[1][k], s[1][n], 0, 0, 0); }
            float alpha[2];
#pragma unroll
            for (int rt = 0; rt < 2; ++rt) {
                const int qi = 32 * w + 16 * rt + fr; float mx = -1e30f;
#pragma unroll
                for (int n = 0; n < 4; ++n)
#pragma unroll
                    for (int j = 0; j < 4; ++j) { const int dist = 128 + qi - (64 * kt + 16 * n + 4 * fq + j); const bool valid = dist >= 0 && dist <= 128;
                        const float sc = valid ? s[rt][n][j] * KSCALE - slope_d * (float)dist : -1e30f; s[rt][n][j] = sc; mx = fmaxf(mx, sc); }
                mx = fmaxf(mx, __shfl_xor(mx, 16)); mx = fmaxf(mx, __shfl_xor(mx, 32));
                const float m_new = fmaxf(m_i[rt], mx); alpha[rt] = __expf(m_i[rt] - m_new); float ls = 0.f;
#pragma unroll
                for (int n = 0; n < 4; ++n) {
#pragma unroll
                    for (int j = 0; j < 4; ++j) { const float pv = s[rt][n][j] > -1e29f ? __expf(s[rt][n][j] - m_new) : 0.f; ls += pv; s[rt][n][j] = pv; }
                    v2u pw; pw.x = pk2(s[rt][n][0], s[rt][n][1]); pw.y = pk2(s[rt][n][2], s[rt][n][3]);
                    *(LAS v2u*)(PL + (16 * rt + fr) * 72 + 16 * n + 4 * fq) = pw;
                }
                ls += __shfl_xor(ls, 16); ls += __shfl_xor(ls, 32);
                l_i[rt] = l_i[rt] * alpha[rt] + ls; m_i[rt] = m_new;
            }
            asm volatile("" ::: "memory");
            bf16x8 pf[2][2];
#pragma unroll
            for (int rt = 0; rt < 2; ++rt) { pf[rt][0] = *(const LAS bf16x8*)(PL + (16 * rt + fr) * 72 + 8 * fq); pf[rt][1] = *(const LAS bf16x8*)(PL + (16 * rt + fr) * 72 + 32 + 8 * fq); }
#pragma unroll
            for (int ds = 0; ds < 8; ++ds) { const bf16x8 v0 = tr_frag(VH, 0, ds, lane), v1 = tr_frag(VH, 1, ds, lane);
#pragma unroll
                for (int rt = 0; rt < 2; ++rt) { o[rt][ds] = o[rt][ds] * alpha[rt];
                    o[rt][ds] = __builtin_amdgcn_mfma_f32_16x16x32_bf16(v0, pf[rt][0], o[rt][ds], 0, 0, 0); o[rt][ds] = __builtin_amdgcn_mfma_f32_16x16x32_bf16(v1, pf[rt][1], o[rt][ds], 0, 0, 0); } }
        }
    }
#pragma unroll
    for (int rt = 0; rt < 2; ++rt) {
        const int qi = 32 * w + 16 * rt + fr; const float inv = 1.0f / l_i[rt]; const int grow = b * SEQ + (nbk * 256 + qi) * d + r;
        bf16* og = (bf16*)(p.ws + WS_CPART) + (size_t)pat * SEG_STRIDE + (size_t)grow * GW + h * HD;
#pragma unroll
        for (int ds = 0; ds < 8; ++ds) { v2u ov; ov.x = pk2(o[rt][ds][0] * inv, o[rt][ds][1] * inv); ov.y = pk2(o[rt][ds][2] * inv, o[rt][ds][3] * inv); *(v2u*)(og + 16 * ds + 4 * fq) = ov; }
        if (fq == 0) ((float*)(p.ws + WS_LSE))[((size_t)pat * M + grow) * 4 + h] = m_i[rt] + __logf(l_i[rt]);
    }
}

__device__ __forceinline__ void stick_unit(const Ctx& p, int u, LAS unsigned char* lds) {
    const int tid = opaque_tid(), lane = tid & 63, w = tid >> 6, fr = lane & 15, fq = lane >> 4;
    const int qb = 15 - (u >> 4), bh = u & 15, b = bh >> 2, h = bh & 3;
    LAS bf16* QH = (LAS bf16*)(lds + ATT_Q); LAS bf16* KH = (LAS bf16*)(lds + ATT_K); LAS bf16* VH = (LAS bf16*)(lds + ATT_V); LAS bf16* PL = (LAS bf16*)(lds + ATT_PL) + w * 32 * 72;
    volatile LAS int* vote = (volatile LAS int*)(lds + ATT_VOTE);
    const bf16* Qg = (const bf16*)(p.ws + WS_PACT) + SEG_SQ * SEG_STRIDE + h * HD; const bf16* Kg = (const bf16*)(p.ws + WS_PACT) + SEG_SK * SEG_STRIDE + h * HD;
    const bf16* Vg = (const bf16*)(p.ws + WS_PACT) + SEG_SV * SEG_STRIDE + h * HD;
    const float nogain[8] = {1.f, 1.f, 1.f, 1.f, 1.f, 1.f, 1.f, 1.f};
    const int ktop = 4 * qb + 3;
    v4u kr[2], vr[2];
    { v4u qr[8]; ld_rows<8>(qr, Qg, b * SEQ + qb * 256, 1, tid); ld_rows<2>(kr, Kg, b * SEQ + ktop * 64, 1, tid); ld_rows<2>(vr, Vg, b * SEQ + ktop * 64, 1, tid);
      st_rows<false, 8, 136>(QH, qr, nogain, tid); }
    if (tid < 8) vote[tid] = 0;
    __syncthreads();
    bf16x8 qf[2][4]; load_qfrags(qf, QH, w, lane);
    float R[2] = {0.f, 0.f}; f32x4 o[2][8];
#pragma unroll
    for (int rt = 0; rt < 2; ++rt)
#pragma unroll
        for (int ds = 0; ds < 8; ++ds) o[rt][ds] = (f32x4){0.f, 0.f, 0.f, 0.f};
    for (int kt = ktop; kt >= 0; --kt) {
        __syncthreads();
        { int all = 1;
#pragma unroll
          for (int i = 0; i < 8; ++i) all &= vote[i];
          if (all) break; }
        st_rows<false, 2, 136>(KH, kr, nogain, tid); st_rows<false, 2, 144>(VH, vr, nogain, tid);
        __syncthreads();
        if (kt > 0) { ld_rows<2>(kr, Kg, b * SEQ + (kt - 1) * 64, 1, tid); ld_rows<2>(vr, Vg, b * SEQ + (kt - 1) * 64, 1, tid); }
        if (64 * kt < 256 * qb + 32 * w + 31) {
            f32x4 s[2][4];
#pragma unroll
            for (int rt = 0; rt < 2; ++rt)
#pragma unroll
                for (int n = 0; n < 4; ++n) s[rt][n] = (f32x4){0.f, 0.f, 0.f, 0.f};
#pragma unroll
            for (int k = 0; k < 4; ++k)
#pragma unroll
                for (int n = 0; n < 4; ++n) { const bf16x8 kf = *(const LAS bf16x8*)(KH + (16 * n + fr) * 136 + 32 * k + 8 * fq);
                    s[0][n] = __builtin_amdgcn_mfma_f32_16x16x32_bf16(kf, qf[0][k], s[0][n], 0, 0, 0); s[1][n] = __builtin_amdgcn_mfma_f32_16x16x32_bf16(kf, qf[1][k], s[1][n], 0, 0, 0); }
#pragma unroll
            for (int rt = 0; rt < 2; ++rt) {
                const int qpos = 256 * qb + 32 * w + 16 * rt + fr; float carry = 0.f;
#pragma unroll
                for (int n = 3; n >= 0; --n) {
                    float lk[4], lsg[4];
#pragma unroll
                    for (int j = 0; j < 4; ++j) { const int key = 64 * kt + 16 * n + 4 * fq + j; const float z = s[rt][n][j] * KSCALE, sp = softplusf(z); lk[j] = key < qpos ? -sp : 0.f; lsg[j] = z - sp; }
                    const float s2 = lk[3], s1 = s2 + lk[2], s0 = s1 + lk[1], T = s0 + lk[0];
                    const float t1 = __shfl(T, (lane + 16) & 63), t2 = __shfl(T, (lane + 32) & 63), t3 = __shfl(T, (lane + 48) & 63);
                    const float base = (fq < 3 ? t1 : 0.f) + (fq < 2 ? t2 : 0.f) + (fq < 1 ? t3 : 0.f) + carry + R[rt];
                    const float suf[4] = {s0, s1, s2, 0.f};
                    float wv[4];
#pragma unroll
                    for (int j = 0; j < 4; ++j) { const int key = 64 * kt + 16 * n + 4 * fq + j; wv[j] = key < qpos ? __expf(lsg[j] + suf[j] + base) : 0.f; }
                    v2u pw; pw.x = pk2(wv[0], wv[1]); pw.y = pk2(wv[2], wv[3]);
                    *(LAS v2u*)(PL + (16 * rt + fr) * 72 + 16 * n + 4 * fq) = pw;
                    carry += (T + t1) + (t2 + t3);
                }
                R[rt] += carry;
            }
            asm volatile("" ::: "memory");
            bf16x8 pf[2][2];
#pragma unroll
            for (int rt = 0; rt < 2; ++rt) { pf[rt][0] = *(const LAS bf16x8*)(PL + (16 * rt + fr) * 72 + 8 * fq); pf[rt][1] = *(const LAS bf16x8*)(PL + (16 * rt + fr) * 72 + 32 + 8 * fq); }
#pragma unroll
            for (int ds = 0; ds < 8; ++ds) { const bf16x8 v0 = tr_frag(VH, 0, ds, lane), v1 = tr_frag(VH, 1, ds, lane);
#pragma unroll
                for (int rt = 0; rt < 2; ++rt) { o[rt][ds] = __builtin_amdgcn_mfma_f32_16x16x32_bf16(v0, pf[rt][0], o[rt][ds], 0, 0, 0); o[rt][ds] = __builtin_amdgcn_mfma_f32_16x16x32_bf16(v1, pf[rt][1], o[rt][ds], 0, 0, 0); } }
        }
        { const int done = __all(R[0] <= -104.0f && R[1] <= -104.0f); if (lane == 0) vote[w] = done; }
    }
#pragma unroll
    for (int rt = 0; rt < 2; ++rt) {
        bf16* og = (bf16*)(p.ws + WS_DOUT) + (size_t)(b * SEQ + 256 * qb + 32 * w + 16 * rt + fr) * GW + h * HD;
#pragma unroll
        for (int ds = 0; ds < 8; ++ds) { v2u ov; ov.x = pk2(o[rt][ds][0], o[rt][ds][1]); ov.y = pk2(o[rt][ds][2], o[rt][ds][3]); *(v2u*)(og + 16 * ds + 4 * fq) = ov; }
    }
}

__device__ __forceinline__ void finalize_unit(const Ctx& p, int l, int u) {
    const int tid = opaque_tid(), lane = tid & 63, w = tid >> 6, hd = lane >> 4;
    const bf16* CP = (const bf16*)(p.ws + WS_CPART); const float* LSE = (const float*)(p.ws + WS_LSE); const bf16* DO = (const bf16*)(p.ws + WS_DOUT); bf16* mixed = (bf16*)(p.ws + WS_MIXED);
    const float* gc = p.in(18) + l * DM + 2 * GW + lane * 8; const float* gd = p.in(18) + l * DM + 3 * GW + lane * 8;
    float gcv[8], gdv[8];
#pragma unroll
    for (int e = 0; e < 8; ++e) { gcv[e] = gc[e]; gdv[e] = gd[e]; }
    for (int tb = 0; tb < 8; tb += 4) {
        v4u a[4], bq[4], cq[4], dv[4]; float l0[4], l1[4], l2[4];
#pragma unroll
        for (int tt = 0; tt < 4; ++tt) {
            const int grow = u * 64 + w * 8 + tb + tt;
            l0[tt] = LSE[((size_t)0 * M + grow) * 4 + hd]; l1[tt] = LSE[((size_t)1 * M + grow) * 4 + hd]; l2[tt] = LSE[((size_t)2 * M + grow) * 4 + hd];
            a[tt] = *(const v4u*)(CP + (size_t)grow * GW + lane * 8); bq[tt] = *(const v4u*)(CP + SEG_STRIDE + (size_t)grow * GW + lane * 8); cq[tt] = *(const v4u*)(CP + 2 * SEG_STRIDE + (size_t)grow * GW + lane * 8);
            dv[tt] = *(const v4u*)(DO + (size_t)grow * GW + lane * 8);
        }
#pragma unroll
        for (int tt = 0; tt < 4; ++tt) {
            const int grow = u * 64 + w * 8 + tb + tt;
            const float L = fmaxf(l0[tt], fmaxf(l1[tt], l2[tt])); float w0 = __expf(l0[tt] - L), w1 = __expf(l1[tt] - L), w2 = __expf(l2[tt] - L); const float inv = 1.0f / (w0 + w1 + w2); w0 *= inv; w1 *= inv; w2 *= inv;
            const unsigned aw[4] = {a[tt].x, a[tt].y, a[tt].z, a[tt].w}, bw[4] = {bq[tt].x, bq[tt].y, bq[tt].z, bq[tt].w}, cw[4] = {cq[tt].x, cq[tt].y, cq[tt].z, cq[tt].w};
            float f[8]; float ss = 0.f;
#pragma unroll
            for (int e = 0; e < 4; ++e) { f[2 * e] = w0 * bflo(aw[e]) + w1 * bflo(bw[e]) + w2 * bflo(cw[e]); f[2 * e + 1] = w0 * bfhi(aw[e]) + w1 * bfhi(bw[e]) + w2 * bfhi(cw[e]); ss += f[2 * e] * f[2 * e] + f[2 * e + 1] * f[2 * e + 1]; }
            ss = wave_sum(ss); float rs = __builtin_amdgcn_rsqf(ss * (1.0f / GW) + EPS);
            v4u ov; ov.x = pk2(f[0] * rs * gcv[0], f[1] * rs * gcv[1]); ov.y = pk2(f[2] * rs * gcv[2], f[3] * rs * gcv[3]); ov.z = pk2(f[4] * rs * gcv[4], f[5] * rs * gcv[5]); ov.w = pk2(f[6] * rs * gcv[6], f[7] * rs * gcv[7]);
            *(v4u*)(mixed + (size_t)grow * DM + 2 * GW + lane * 8) = ov;
            const unsigned dw[4] = {dv[tt].x, dv[tt].y, dv[tt].z, dv[tt].w};
            ss = 0.f;
#pragma unroll
            for (int e = 0; e < 4; ++e) { f[2 * e] = bflo(dw[e]); f[2 * e + 1] = bfhi(dw[e]); ss += f[2 * e] * f[2 * e] + f[2 * e + 1] * f[2 * e + 1]; }
            ss = wave_sum(ss); rs = __builtin_amdgcn_rsqf(ss * (1.0f / GW) + EPS);
            ov.x = pk2(f[0] * rs * gdv[0], f[1] * rs * gdv[1]); ov.y = pk2(f[2] * rs * gdv[2], f[3] * rs * gdv[3]); ov.z = pk2(f[4] * rs * gdv[4], f[5] * rs * gdv[5]); ov.w = pk2(f[6] * rs * gdv[6], f[7] * rs * gdv[7]);
            *(v4u*)(mixed + (size_t)grow * DM + 3 * GW + lane * 8) = ov;
        }
    }
}

#ifndef PROBE_REPEAT
#define PROBE_REPEAT 0
#endif
#define REP(k) for (int rep_ = 0; rep_ < (((PROBE_REPEAT) >> (k)) & 1) + 1; ++rep_)
__global__ void __launch_bounds__(NT, 2) fwd_kernel(Params kp) {
    extern __shared__ __attribute__((aligned(16))) unsigned char lds_raw[];
    LAS unsigned char* lds = (LAS unsigned char*)lds_raw;
    volatile LAS unsigned* MISC = (volatile LAS unsigned*)(lds + LDS_MISC_OFF);
    volatile LAS int* qslot = (volatile LAS int*)(MISC + 4);
    const int wid0 = __builtin_amdgcn_readfirstlane((int)threadIdx.x >> 6);
    if (threadIdx.x < 16) MISC[threadIdx.x] = 0u;
    __syncthreads();
    XcdBarrier bar; bar.bar = (unsigned*)(kp.ws + WS_CTL) + CW_BAR; bar.x = 0; bar.st = nullptr;
    if (!MK_SPLIT) bar = xcd_barrier_post((unsigned*)(kp.ws + WS_CTL) + CW_BAR, MISC);
    const int lo = kp.ph_lo, hi = kp.ph_hi;
#define IN(k) (lo <= (k) && (k) < hi)
#define SEAM(k) do { if (IN(k) && IN((k) + 1)) { if (!MK_SPLIT) xcd_barrier(bar); } } while (0)
#define CTX() const Ctx p = make_ctx(wid0); unsigned* ctl = (unsigned*)(p.ws + WS_CTL); unsigned long long* ssq = (unsigned long long*)(p.ws + WS_SSQ); bf16* xb = (bf16*)(p.ws + WS_XB); bf16* act = (bf16*)(p.ws + WS_PACT); bf16* mixed = (bf16*)(p.ws + WS_MIXED); \
    unsigned long long* ssqA = ssq + (size_t)(3 * l) * M; unsigned long long* ssqB = ssq + (size_t)(3 * l + 1) * M; unsigned long long* ssqC = ssq + (size_t)(3 * l + 2) * M; unsigned long long* ssqN = ssq + (size_t)(3 * l + 3) * M; \
    (void)ctl; (void)xb; (void)act; (void)mixed; (void)ssqA; (void)ssqB; (void)ssqC; (void)ssqN

    if (IN(0)) { const Ctx p = make_ctx(wid0); prologue_x(p); }
    for (int l = 0; l < NLAYER; ++l) {
        const int pb = 1 + l * PH_PER_LAYER;
        if (IN(pb + 0)) REP(0) { const Ctx p = make_ctx(wid0); convert_layer(p, l, -1); }
        SEAM(pb + 0);
        if (IN(pb + 1)) REP(4) { CTX(); if (rep_) xcd_barrier(bar);
            pg8::Gemm g{xb, (const bf16*)(p.ws + WS_WGU1), M, 2 * DFF, DM}; pg8::StaticOrder S; S.init(M, 2 * DFF, (int)gridDim.x, (int)blockIdx.x);
            pg8::EpiSwiglu E{act, DFF, ssqA, 1.0f / (DM * pg8::SSQ_FX)};
            pg8::gemm_phase<pg8::EpiSwiglu, pg8::StaticOrder, PG8_ALIGN, PG8_SP2>(lds, g, S, E, wid0);
        }
        SEAM(pb + 1);
#if (PROBE_REPEAT >> 6) & 1
        if (IN(pb + 2)) { CTX();
            pg8::Gemm g{act, (const bf16*)(p.ws + WS_WD1), M, DM, DFF}; pg8::StaticOrder S; S.init(M, DM, (int)gridDim.x, (int)blockIdx.x);
            pg8::EpiResid E{xb, nullptr, xb, nullptr, DM, 0.25f};
            pg8::gemm_phase<pg8::EpiResid, pg8::StaticOrder, PG8_ALIGN, PG8_SP2>(lds, g, S, E, wid0);
            xcd_barrier(bar);
        }
        if (IN(pb + 2)) { CTX();
            pg8::Gemm g{act, (const bf16*)(p.ws + WS_WD1), M, DM, DFF}; pg8::StaticOrder S; S.init(M, DM, (int)gridDim.x, (int)blockIdx.x);
            pg8::EpiResid E{xb, nullptr, xb, ssqB, DM, 0.25f};
            pg8::gemm_phase<pg8::EpiResid, pg8::StaticOrder, PG8_ALIGN, PG8_SP2>(lds, g, S, E, wid0);
        }
#else
        if (IN(pb + 2)) { CTX();
            pg8::Gemm g{act, (const bf16*)(p.ws + WS_WD1), M, DM, DFF}; pg8::StaticOrder S; S.init(M, DM, (int)gridDim.x, (int)blockIdx.x);
            pg8::EpiResid E{xb, nullptr, xb, ssqB, DM, 0.5f};
            pg8::gemm_phase<pg8::EpiResid, pg8::StaticOrder, PG8_ALIGN, PG8_SP2>(lds, g, S, E, wid0);
        }
#endif
        SEAM(pb + 2);
        if (IN(pb + 3)) REP(5) { CTX(); if (rep_) xcd_barrier(bar);
            pg8::Gemm g{xb, (const bf16*)(p.ws + WS_WIN), M, NP, DM}; pg8::StaticOrder S; S.init(M, NP, (int)gridDim.x, (int)blockIdx.x);
            pg8::EpiSplit E{act, SEG_STRIDE, ssqB, 1.0f / (DM * pg8::SSQ_FX)};
            pg8::gemm_phase<pg8::EpiSplit, pg8::StaticOrder, PG8_ALIGN, PG8_SP2>(lds, g, S, E, wid0);
            gates_phase(p, l, ssqB, lds);
        }
        SEAM(pb + 3);
        if (IN(pb + 4)) REP(1) { CTX(); if (rep_) xcd_barrier(bar);
            for (int u = (int)blockIdx.x; u < 256; u += (int)gridDim.x) { __syncthreads(); stick_unit(p, u, lds); }
            for (int u = (int)blockIdx.x; u < 768; u += (int)gridDim.x) { __syncthreads(); dilated_unit(p, l, u, lds); }
            for (int u = (int)blockIdx.x; u < 1024; u += (int)gridDim.x) { __syncthreads(); mlstm1_unit(p, l, u, lds); }
            for (int u = (int)blockIdx.x; u < 1024; u += (int)gridDim.x) { __syncthreads(); lru_unit<1>(p, l, u, lds); }
        }
        SEAM(pb + 4);
        if (IN(pb + 5)) REP(2) { CTX(); if (rep_) xcd_barrier(bar);
            unsigned* ctr = ctl + CW_Q + 64 * (pb + 5 + 32 * rep_);
            for (int u = q_next(p, ctr, qslot); u < 132; u = q_next(p, ctr, qslot)) {
                if (u < 4) lru_carry_unit(p, u);
                else mlstm_scan_unit(p, u - 4);
            }
        }
        SEAM(pb + 5);
        if (IN(pb + 6)) REP(3) { CTX(); if (rep_) xcd_barrier(bar);
            for (int u = (int)blockIdx.x; u < 1024; u += (int)gridDim.x) { __syncthreads(); mlstm3_unit(p, l, u, lds); }
            for (int u = (int)blockIdx.x; u < 1024; u += (int)gridDim.x) { __syncthreads(); lru_unit<3>(p, l, u, lds); }
            for (int u = (int)blockIdx.x; u < 256; u += (int)gridDim.x) { __syncthreads(); finalize_unit(p, l, u); }
        }
        SEAM(pb + 6);
#if (PROBE_REPEAT >> 7) & 1
        for (int xb_ = 0; xb_ < 20; ++xb_) xcd_barrier(bar);
#endif
        if (IN(pb + 7)) { CTX();
            pg8::Gemm g{mixed, (const bf16*)(p.ws + WS_WOUT), M, DM, DM}; pg8::StaticOrder S; S.init(M, DM, (int)gridDim.x, (int)blockIdx.x);
            pg8::EpiResid E{xb, nullptr, xb, ssqC, DM, 1.0f};
            pg8::gemm_phase<pg8::EpiResid, pg8::StaticOrder, PG8_ALIGN, PG8_SP2>(lds, g, S, E, wid0);
        }
        SEAM(pb + 7);
        if (IN(pb + 8)) { CTX();
            pg8::Gemm g{xb, (const bf16*)(p.ws + WS_WGU2), M, 2 * DFF, DM}; pg8::StaticOrder S; S.init(M, 2 * DFF, (int)gridDim.x, (int)blockIdx.x);
            pg8::EpiSwiglu E{act, DFF, ssqC, 1.0f / (DM * pg8::SSQ_FX)};
            pg8::gemm_phase<pg8::EpiSwiglu, pg8::StaticOrder, PG8_ALIGN, PG8_SP2>(lds, g, S, E, wid0);
        }
        SEAM(pb + 8);
        if (IN(pb + 9)) { CTX();
            pg8::Gemm g{act, (const bf16*)(p.ws + WS_WD2), M, DM, DFF}; pg8::StaticOrder S; S.init(M, DM, (int)gridDim.x, (int)blockIdx.x);
            const bool lastl = (l == NLAYER - 1);
            pg8::EpiResid E{xb, lastl ? p.out : nullptr, lastl ? nullptr : xb, lastl ? nullptr : ssqN, DM, 0.5f};
            pg8::gemm_phase<pg8::EpiResid, pg8::StaticOrder, PG8_ALIGN, PG8_SP2>(lds, g, S, E, wid0);
        }
        SEAM(pb + 9);
    }
#undef IN
#undef SEAM
#undef CTX
}

extern "C" void kernel_launch(void* const* d_in, const int* in_sizes, int n_in, void* d_out, int out_size, void* d_ws, size_t ws_size, hipStream_t stream) {
    static int grid = 0;
    if (grid == 0) {
        if (n_in != 24 || in_sizes[0] != M * DM || out_size != M * DM || ws_size < WS_END) { fprintf(stderr, "kernel_launch: unexpected shapes (n_in %d, in0 %d, out %d, ws %zu < %zu)\n", n_in, n_in > 0 ? in_sizes[0] : -1, out_size, ws_size, (size_t)WS_END); grid = -1; return; }
        int dev = 0, cus = 0, per_cu = 0;
        if (hipGetDevice(&dev) != hipSuccess || hipDeviceGetAttribute(&cus, hipDeviceAttributeMultiprocessorCount, dev) != hipSuccess) { grid = -1; return; }
        if (hipFuncSetAttribute((const void*)fwd_kernel, hipFuncAttributeMaxDynamicSharedMemorySize, LDS_BYTES) != hipSuccess) { fprintf(stderr, "kernel_launch: hipFuncSetAttribute failed\n"); grid = -1; return; }
        if (hipOccupancyMaxActiveBlocksPerMultiprocessor(&per_cu, (const void*)fwd_kernel, NT, LDS_BYTES) != hipSuccess || per_cu < 1) { fprintf(stderr, "kernel_launch: occupancy query says %d\n", per_cu); (void)hipGetLastError(); }
        grid = cus;
    }
    if (grid < 0) return;
    (void)hipMemsetAsync((char*)d_ws + WS_CTL, 0, CTL_ZERO_BYTES, stream);
    Params a{};
    for (int i = 0; i < 24; ++i) a.in[i] = (const float*)d_in[i];
    a.out = (float*)d_out; a.ws = (unsigned char*)d_ws;
#if MK_SPLIT
    for (int ph = 0; ph < N_PHASES; ++ph) { a.ph_lo = ph; a.ph_hi = ph + 1; hipLaunchKernelGGL(fwd_kernel, dim3(grid), dim3(NT), LDS_BYTES, stream, a); }
#else
    a.ph_lo = 0; a.ph_hi = N_PHASES;
    hipLaunchKernelGGL(fwd_kernel, dim3(grid), dim3(NT), LDS_BYTES, stream, a);
#endif
}
```

```cpp
#include <hip/hip_runtime.h>
#include <cstdio>
#include <cstdint>
#define LAS __attribute__((address_space(3)))
namespace pg8 {
#define PG8_LAS __attribute__((address_space(3)))
typedef unsigned short bf16_t;
typedef short bf16x8 __attribute__((ext_vector_type(8)));
typedef float f32x4 __attribute__((ext_vector_type(4)));
typedef unsigned u32x4 __attribute__((ext_vector_type(4)));
constexpr int BM = 256, BK = 64, HALF = 128, HTB = HALF * BK * 2  , STAGE_BYTES = 8 * HTB, NXCD = 8, WGM = 4;

__host__ __device__ __forceinline__ int lds_byte(int r, int c) { const int st = (r >> 4) * 2 + (c >> 5), rr = r & 15, cc = c & 31, ob = rr * 64 + cc * 2; return st * 1024 + (ob ^ (((ob >> 9) & 1) << 5)); }
__host__ __device__ __forceinline__ void stage_rc(int b, int& R, int& C) { const int st = b / 1024, sb = b % 1024, swz = sb ^ (((sb >> 9) & 1) << 5); R = (st >> 1) * 16 + swz / 64; C = (st & 1) * 32 + (swz % 64) / 2; }
__host__ __device__ __forceinline__ int perm32(int rho) { const int n = rho >> 4, i = rho & 15; return 8 * (i >> 2) + 4 * n + (i & 3); }

struct Unit { int pm, pn; };
struct Gemm { const bf16_t* A; const bf16_t* Bt; int M, N, K; };

struct StaticOrder {
    int nM, nN, nwg, G, c;
    __host__ __device__ void init(int M, int N, int G_, int c_) { nM = M / BM; nN = N / BM; nwg = nM * nN; G = G_; c = c_; }
    __host__ __device__ bool next(int i, Unit& u) const {
        const long L = (long)i * G + c; if (L >= nwg) return false;
        int wgid = (int)L; { const int q = nwg / NXCD, r = nwg % NXCD, xcd = wgid % NXCD, off = wgid / NXCD; wgid = (xcd < r ? xcd * (q + 1) : r * (q + 1) + (xcd - r) * q) + off; }
        const int nig = WGM * nN, gid = wgid / nig, fm = gid * WGM, gsz = (nM - fm) < WGM ? (nM - fm) : WGM;
        u.pm = fm + ((wgid % nig) % gsz); u.pn = (wgid % nig) / gsz; return true;
    }
    __device__ __forceinline__ void a_ready(const Unit&) const {}
    __device__ __forceinline__ void done(const Unit&) const {}
};

__device__ __forceinline__ unsigned cvt_pk_bf16(float lo, float hi) { unsigned r; asm volatile("v_cvt_pk_bf16_f32 %0, %1, %2" : "=v"(r) : "v"(lo), "v"(hi)); return r; }

typedef float f32x2 __attribute__((ext_vector_type(2)));
constexpr float RMS_EPS_F = 1e-6f, SSQ_FX = 1048576.0f;
struct EpiSwiglu {
    static constexpr bool PERM = true, AFTER_DRAIN = false;
    bf16_t* O; int ldc; const unsigned long long* ssq; float inv_d;
    __device__ __forceinline__ void operator()(const f32x4 (&acc)[2][2][4][2], const Unit& u, int wr, int wc, int fr, int fq) const {
        const int row0 = u.pm * BM + wr * 64 + fr, col0 = u.pn * HALF + wc * 32 + 8 * fq;
#pragma unroll
        for (int ai = 0; ai < 2; ++ai)
#pragma unroll
            for (int m = 0; m < 4; ++m) {
                const int row = row0 + ai * HALF + m * 16;
                const float rs = __builtin_amdgcn_rsqf((float)ssq[row] * inv_d + RMS_EPS_F);
                const f32x2 ce = {-rs * 1.4426950408889634f, -rs * 1.4426950408889634f}, c2 = {rs * rs, rs * rs}, one = {1.0f, 1.0f};
                unsigned wv[4];
#pragma unroll
                for (int n = 0; n < 2; ++n)
#pragma unroll
                    for (int hh = 0; hh < 2; ++hh) {
                        const f32x2 g = {acc[ai][0][m][n][2 * hh], acc[ai][0][m][n][2 * hh + 1]}, up = {acc[ai][1][m][n][2 * hh], acc[ai][1][m][n][2 * hh + 1]};
                        const f32x2 a = g * ce; f32x2 e; e.x = __builtin_amdgcn_exp2f(a.x); e.y = __builtin_amdgcn_exp2f(a.y);
                        const f32x2 d = e + one; f32x2 r; r.x = __builtin_amdgcn_rcpf(d.x); r.y = __builtin_amdgcn_rcpf(d.y);
                        const f32x2 v = ((g * up) * c2) * r;
                        wv[n * 2 + hh] = cvt_pk_bf16(v.x, v.y);
                    }
                u32x4 w; w.x = wv[0]; w.y = wv[1]; w.z = wv[2]; w.w = wv[3];
                *(u32x4*)(O + (size_t)row * ldc + col0) = w;
            }
    }
};
struct EpiResid {
    static constexpr bool PERM = false, AFTER_DRAIN = false;
    const bf16_t* base; float* out; bf16_t* xb; unsigned long long* ssq; int ldc; float alpha;
    __device__ __forceinline__ void operator()(const f32x4 (&acc)[2][2][4][2], const Unit& u, int wr, int wc, int fr, int fq) const {
        typedef unsigned u32x2v __attribute__((ext_vector_type(2)));
        const int row0 = u.pm * BM + wr * 64 + fr, col0 = u.pn * BM + wc * 32 + 4 * fq;
#pragma unroll
        for (int ai = 0; ai < 2; ++ai) {
            u32x2v b4[4][2][2];
#pragma unroll
            for (int m = 0; m < 4; ++m)
#pragma unroll
                for (int bj = 0; bj < 2; ++bj)
#pragma unroll
                    for (int n = 0; n < 2; ++n) b4[m][bj][n] = *(const u32x2v*)(base + (size_t)(row0 + ai * HALF + m * 16) * ldc + col0 + bj * HALF + n * 16);
#pragma unroll
            for (int m = 0; m < 4; ++m) {
                const int row = row0 + ai * HALF + m * 16; const size_t off = (size_t)row * ldc + col0; float s = 0.f;
#pragma unroll
                for (int bj = 0; bj < 2; ++bj)
#pragma unroll
                    for (int n = 0; n < 2; ++n) {
                        const u32x2v bb = b4[m][bj][n];
                        const f32x4 bf = {__builtin_bit_cast(float, bb.x << 16), __builtin_bit_cast(float, bb.x & 0xffff0000u), __builtin_bit_cast(float, bb.y << 16), __builtin_bit_cast(float, bb.y & 0xffff0000u)};
                        const f32x4 o = bf + acc[ai][bj][m][n] * alpha;
                        if (out) *(f32x4*)(out + off + bj * HALF + n * 16) = o;
                        if (xb) { u32x2v w; w.x = cvt_pk_bf16(o[0], o[1]); w.y = cvt_pk_bf16(o[2], o[3]); *(u32x2v*)(xb + off + bj * HALF + n * 16) = w; }
                        s += (o[0] * o[0] + o[1] * o[1]) + (o[2] * o[2] + o[3] * o[3]);
                    }
                if (ssq) { s += __shfl_xor(s, 16); s += __shfl_xor(s, 32); if (fq == 0) atomicAdd(ssq + row, (unsigned long long)(s * SSQ_FX + 0.5f)); }
            }
            asm volatile("" ::: "memory");
        }
    }
};
struct EpiSplit {
    static constexpr bool PERM = true, AFTER_DRAIN = false;
    bf16_t* O; size_t seg_stride; const unsigned long long* ssq; float inv_d;
    __device__ __forceinline__ void operator()(const f32x4 (&acc)[2][2][4][2], const Unit& u, int wr, int wc, int fr, int fq) const {
        const int colt = u.pn * BM, seg = colt >> 9, cin = colt & 511;
        bf16_t* base = O + (size_t)seg * seg_stride;
        const int row0 = u.pm * BM + wr * 64 + fr, col0 = cin + wc * 32 + 8 * fq;
#pragma unroll
        for (int ai = 0; ai < 2; ++ai)
#pragma unroll
            for (int m = 0; m < 4; ++m) {
                const int row = row0 + ai * HALF + m * 16;
                const float rs = __builtin_amdgcn_rsqf((float)ssq[row] * inv_d + RMS_EPS_F);
#pragma unroll
                for (int bj = 0; bj < 2; ++bj) {
                    const f32x4 v0 = acc[ai][bj][m][0] * rs, v1 = acc[ai][bj][m][1] * rs;
                    u32x4 w; w.x = cvt_pk_bf16(v0[0], v0[1]); w.y = cvt_pk_bf16(v0[2], v0[3]); w.z = cvt_pk_bf16(v1[0], v1[1]); w.w = cvt_pk_bf16(v1[2], v1[3]);
                    *(u32x4*)(base + (size_t)row * 512 + col0 + bj * HALF) = w;
                }
            }
    }
};
template <class Epi, class Sched, bool ALIGN_EPI = false, bool SP2 = false>
__device__ __forceinline__ void gemm_phase(PG8_LAS unsigned char* lds, const Gemm g, const Sched& S, const Epi& E, int wid0) {
    int tid_ = (wid0 << 6) | (int)__builtin_amdgcn_mbcnt_hi(~0u, __builtin_amdgcn_mbcnt_lo(~0u, 0u)); asm volatile("" : "+v"(tid_));
    const int tid = tid_, wid = __builtin_amdgcn_readfirstlane(tid >> 6), lane = tid & 63, wr = wid >> 2, wc = wid & 3, fr = lane & 15, fq = lane >> 4;
    const int K = g.K, nt = K / BK;
    unsigned voffA[2], voffB[2];
#pragma unroll
    for (int i = 0; i < 2; ++i) { int R, C; stage_rc(tid * 16 + i * 8192, R, C); const int Rb = Epi::PERM ? ((R & ~31) + perm32(R & 31)) : R;
        voffA[i] = (unsigned)(R * K + C) * 2u; voffB[i] = (unsigned)(Rb * K + C) * 2u; }
    const size_t kstep = (size_t)(BK * 2);
    const size_t hstep = (size_t)HALF * K * 2;
    const size_t tstep = 2 * hstep;
    const unsigned ldsw = (unsigned)wid * 1024u;
    const int aoff = lds_byte(wr * 64 + fr, fq * 8), boff = lds_byte(wc * 32 + fr, fq * 8);
#define PG8_SA(b, h) (((b) * 2 + (h)) * HTB)
#define PG8_SB(b, h) ((4 + (b) * 2 + (h)) * HTB)
#define PG8_STAGE(bufoff, gbase, voff) do { _Pragma("unroll") for (int _i = 0; _i < 2; ++_i) \
        __builtin_amdgcn_global_load_lds((const unsigned*)((const char*)(gbase) + (voff)[_i]), (PG8_LAS unsigned*)(lds + (bufoff) + ldsw + _i * 8192), 16, 0, 0); } while (0)
#define PG8_LDA(dst, b, h) do { _Pragma("unroll") for (int m = 0; m < 4; ++m) _Pragma("unroll") for (int k = 0; k < 2; ++k) dst[m][k] = *(const PG8_LAS bf16x8*)(lds + PG8_SA(b, h) + aoff + m * 2048 + k * 1024); } while (0)
#define PG8_LDB(dst, b, h) do { _Pragma("unroll") for (int n = 0; n < 2; ++n) _Pragma("unroll") for (int k = 0; k < 2; ++k) dst[n][k] = *(const PG8_LAS bf16x8*)(lds + PG8_SB(b, h) + boff + n * 2048 + k * 1024); } while (0)
#define PG8_MMA(ai, bj, At, Bt) do { __builtin_amdgcn_s_setprio(1); _Pragma("unroll") for (int m = 0; m < 4; ++m) _Pragma("unroll") for (int n = 0; n < 2; ++n) _Pragma("unroll") for (int k = 0; k < 2; ++k) \
        acc[ai][bj][m][n] = __builtin_amdgcn_mfma_f32_16x16x32_bf16(Bt[n][k], At[m][k], acc[ai][bj][m][n], 0, 0, 0); __builtin_amdgcn_s_setprio(0); } while (0)
#define PG8_WAIT_V(n) asm volatile("s_waitcnt vmcnt(" #n ")" ::: "memory")
#define PG8_WAIT_L(n) asm volatile("s_waitcnt lgkmcnt(" #n ")" ::: "memory")
#define PG8_BAR __builtin_amdgcn_s_barrier()
#define PG8_SCHED __builtin_amdgcn_sched_barrier(0)
    Unit cur, nxt; int ui = 0;
    if (!S.next(0, cur)) return;
    f32x4 acc[2][2][4][2];
#pragma unroll
    for (int a = 0; a < 2; ++a)
#pragma unroll
        for (int b = 0; b < 2; ++b)
#pragma unroll
            for (int m = 0; m < 4; ++m)
#pragma unroll
                for (int n = 0; n < 2; ++n) acc[a][b][m][n] = (f32x4){0.f, 0.f, 0.f, 0.f};
    bf16x8 At[4][2], B0[2][2], B1[2][2];
    const char* cA = (const char*)g.A + (size_t)cur.pm * tstep; const char* cB = (const char*)g.Bt + (size_t)cur.pn * tstep;
    S.a_ready(cur);
    if constexpr (SP2) {
        PG8_STAGE(PG8_SB(0, 0), cB, voffB); PG8_STAGE(PG8_SB(0, 1), cB + hstep, voffB); PG8_STAGE(PG8_SA(0, 0), cA, voffA); PG8_STAGE(PG8_SA(0, 1), cA + hstep, voffA);
        if (wr == 1) PG8_BAR;
        PG8_WAIT_V(2); PG8_BAR;
        PG8_STAGE(PG8_SB(1, 0), cB + kstep, voffB); PG8_STAGE(PG8_SA(1, 0), cA + kstep, voffA); PG8_STAGE(PG8_SB(1, 1), cB + hstep + kstep, voffB);
        PG8_WAIT_V(6); PG8_BAR;
    } else {
        PG8_STAGE(PG8_SB(0, 0), cB, voffB); PG8_STAGE(PG8_SA(0, 0), cA, voffA); PG8_STAGE(PG8_SB(0, 1), cB + hstep, voffB); PG8_STAGE(PG8_SA(0, 1), cA + hstep, voffA);
        if (wr == 1) PG8_BAR;
        PG8_WAIT_V(4); PG8_BAR;
        PG8_STAGE(PG8_SB(1, 0), cB + kstep, voffB); PG8_STAGE(PG8_SA(1, 0), cA + kstep, voffA); PG8_STAGE(PG8_SB(1, 1), cB + hstep + kstep, voffB);
        PG8_WAIT_V(6); PG8_BAR;
    }
    for (;;) {
        const bool has_next = S.next(ui + 1, nxt);
        const char* nA = has_next ? (const char*)g.A + (size_t)nxt.pm * tstep : cA; const char* nB = has_next ? (const char*)g.Bt + (size_t)nxt.pn * tstep : cB;
        for (int t = 0; t < nt; t += 2) {
            const bool last = (t == nt - 2);
            const char* a1 = cA + (size_t)(t + 1) * kstep;
            const char* a2 = last ? nA : cA + (size_t)(t + 2) * kstep; const char* b2 = last ? nB : cB + (size_t)(t + 2) * kstep;
            const char* a3 = a2 + kstep; const char* b3 = b2 + kstep;
            if (last && has_next) S.a_ready(nxt);
            if constexpr (SP2) {
            PG8_LDB(B0, 0, 0); PG8_LDB(B1, 0, 1); PG8_SCHED; PG8_LDA(At, 0, 0); PG8_STAGE(PG8_SA(1, 1), a1 + hstep, voffA);
            PG8_WAIT_V(8); PG8_WAIT_L(0); PG8_BAR; PG8_MMA(0, 0, At, B0); PG8_MMA(0, 1, At, B1); PG8_BAR; PG8_SCHED;
            PG8_LDA(At, 0, 1); PG8_STAGE(PG8_SB(0, 0), b2, voffB); PG8_STAGE(PG8_SB(0, 1), b2 + hstep, voffB); PG8_STAGE(PG8_SA(0, 0), a2, voffA);
            PG8_WAIT_V(8); PG8_WAIT_L(0); PG8_BAR; PG8_MMA(1, 0, At, B0); PG8_MMA(1, 1, At, B1); PG8_BAR; PG8_SCHED;
            PG8_LDB(B0, 1, 0); PG8_LDB(B1, 1, 1); PG8_SCHED; PG8_LDA(At, 1, 0); PG8_STAGE(PG8_SA(0, 1), a2 + hstep, voffA);
            PG8_WAIT_V(8); PG8_WAIT_L(0); PG8_BAR; PG8_MMA(0, 0, At, B0); PG8_MMA(0, 1, At, B1); PG8_BAR; PG8_SCHED;
            PG8_LDA(At, 1, 1); PG8_STAGE(PG8_SB(1, 0), b3, voffB); PG8_STAGE(PG8_SB(1, 1), b3 + hstep, voffB); PG8_STAGE(PG8_SA(1, 0), a3, voffA);
            PG8_WAIT_V(8); PG8_WAIT_L(0); PG8_BAR; PG8_MMA(1, 0, At, B0); PG8_MMA(1, 1, At, B1); PG8_BAR; PG8_SCHED;
            } else {
            PG8_LDB(B0, 0, 0); PG8_SCHED; PG8_LDA(At, 0, 0); PG8_STAGE(PG8_SA(1, 1), a1 + hstep, voffA);
            PG8_WAIT_L(8); PG8_BAR; PG8_WAIT_L(0); PG8_MMA(0, 0, At, B0); PG8_BAR; PG8_SCHED;
            PG8_LDB(B1, 0, 1); PG8_STAGE(PG8_SB(0, 0), b2, voffB);
            PG8_BAR; PG8_WAIT_L(0); PG8_MMA(0, 1, At, B1); PG8_BAR;
            PG8_LDA(At, 0, 1); PG8_STAGE(PG8_SA(0, 0), a2, voffA);
            PG8_BAR; PG8_WAIT_L(0); PG8_MMA(1, 0, At, B0); PG8_BAR; PG8_SCHED;
            PG8_STAGE(PG8_SB(0, 1), b2 + hstep, voffB);
            PG8_WAIT_V(6); PG8_BAR; PG8_MMA(1, 1, At, B1); PG8_BAR;
            PG8_LDB(B0, 1, 0); PG8_SCHED; PG8_LDA(At, 1, 0); PG8_STAGE(PG8_SA(0, 1), a2 + hstep, voffA);
            PG8_WAIT_L(8); PG8_BAR; PG8_WAIT_L(0); PG8_MMA(0, 0, At, B0); PG8_BAR; PG8_SCHED;
            PG8_LDB(B1, 1, 1); PG8_STAGE(PG8_SB(1, 0), b3, voffB);
            PG8_BAR; PG8_WAIT_L(0); PG8_MMA(0, 1, At, B1); PG8_BAR;
            PG8_LDA(At, 1, 1); PG8_STAGE(PG8_SA(1, 0), a3, voffA);
            PG8_BAR; PG8_WAIT_L(0); PG8_MMA(1, 0, At, B0); PG8_BAR; PG8_SCHED;
            PG8_STAGE(PG8_SB(1, 1), b3 + hstep, voffB);
            PG8_WAIT_V(6); PG8_BAR; PG8_MMA(1, 1, At, B1); PG8_BAR;
            }
        }
        if constexpr (ALIGN_EPI) { if (wr == 0) PG8_BAR; }
        if constexpr (!Epi::AFTER_DRAIN) { E(acc, cur, wr, wc, fr, fq); S.done(cur); }
        if (!has_next) break;
#pragma unroll
        for (int a = 0; a < 2; ++a)
#pragma unroll
            for (int b = 0; b < 2; ++b)
#pragma unroll
                for (int m = 0; m < 4; ++m)
#pragma unroll
                    for (int n = 0; n < 2; ++n) acc[a][b][m][n] = (f32x4){0.f, 0.f, 0.f, 0.f};
        cur = nxt; cA = nA; cB = nB; ++ui;
        if constexpr (ALIGN_EPI) { if (wr == 1) PG8_BAR; }
    }
    PG8_WAIT_V(0);
    if constexpr (!ALIGN_EPI) { if (wr == 0) PG8_BAR; }
    PG8_BAR;
    if constexpr (Epi::AFTER_DRAIN) { E.fused(acc, cur, wr, wc, fr, fq, lds, wid, lane); S.done(cur); }
#undef PG8_SA
#undef PG8_SB
#undef PG8_STAGE
#undef PG8_LDA
#undef PG8_LDB
#undef PG8_MMA
#undef PG8_WAIT_V
#undef PG8_WAIT_L
#undef PG8_BAR
#undef PG8_SCHED
}
}
#define XB_TMO      128
#define XB_XCNT(j)  (256  + 64 * (j))
#define XB_XSUB(j)  (1280 + 64 * (j))
#define XB_XGEN(j)  (2304 + 64 * (j))
#define XB_TOP      3328
#define XB_TOPGEN   3392
#define XCD_BAR_WORDS 3456
#define XB_SPIN_CAP (1u << 18)

__device__ __forceinline__ unsigned xb_ld(unsigned* p)              { return __hip_atomic_load(p, __ATOMIC_RELAXED, __HIP_MEMORY_SCOPE_AGENT); }
__device__ __forceinline__ unsigned xb_add(unsigned* p, unsigned v) { return __hip_atomic_fetch_add(p, v, __ATOMIC_RELAXED, __HIP_MEMORY_SCOPE_AGENT); }
__device__ __forceinline__ unsigned xb_xcc_id() { return (unsigned)__builtin_amdgcn_s_getreg((3 << 11) | 20) & 0xFu; }
#define XB_SPIN(cond, bar) do { unsigned _sp = 0; while (cond) { __builtin_amdgcn_s_sleep(1); \
    if ((++_sp & 255u) == 0u) { if (xb_ld(&(bar)[XB_TMO])) break; if (_sp > XB_SPIN_CAP) { atomicAdd(&(bar)[XB_TMO], 1u); break; } } } } while (0)

struct XcdBarrier {
    unsigned* bar; unsigned x;
    volatile LAS unsigned* st;
};

__device__ __forceinline__ XcdBarrier xcd_barrier_post(unsigned* bar, volatile LAS unsigned* st) {
    XcdBarrier b; b.bar = bar; b.x = xb_xcc_id(); b.st = st;
    if (threadIdx.x == 0) (void)xb_add(&bar[XB_XCNT(b.x)], 1u);
    return b;
}
__device__ __forceinline__ void xcd_barrier_complete(unsigned* bar, unsigned x, unsigned& nloc, unsigned& nx) {
    const unsigned G = gridDim.x * gridDim.y * gridDim.z;
    unsigned sum, cnt, mine, sp = 0u;
    for (;;) {
        sum = 0u; cnt = 0u; mine = 0u;
#pragma unroll
        for (unsigned j = 0; j < 16; ++j) { const unsigned c = xb_ld(&bar[XB_XCNT(j)]); sum += c; cnt += (c > 0u) ? 1u : 0u; mine = (j == x) ? c : mine; }
        if (sum == G) break;
        __builtin_amdgcn_s_sleep(1);
        if ((++sp & 255u) == 0u) { if (xb_ld(&bar[XB_TMO])) break; if (sp > XB_SPIN_CAP) { atomicAdd(&bar[XB_TMO], 1u); break; } }
    }
    nloc = mine > 0u ? mine : 1u; nx = cnt > 0u ? cnt : 1u;
}

__device__ __forceinline__ void xcd_barrier(const XcdBarrier& b) {
    asm volatile("s_waitcnt vmcnt(0)" ::: "memory");
    __syncthreads();
    if (threadIdx.x == 0) {
        unsigned* bar = b.bar;
        __builtin_amdgcn_s_waitcnt(0);
        unsigned nloc = b.st[0], nx = b.st[1];
        if (nloc == 0u) { xcd_barrier_complete(bar, b.x, nloc, nx); b.st[0] = nloc; b.st[1] = nx; }
        const unsigned old = xb_add(&bar[XB_XSUB(b.x)], 1u);
        const unsigned gen = old / nloc;
        if (old + 1u == (gen + 1u) * nloc) {
            __builtin_amdgcn_fence(__ATOMIC_RELEASE, "agent");
            asm volatile("s_waitcnt vmcnt(0)" ::: "memory");
            const unsigned og = xb_add(&bar[XB_TOP], 1u);
            const unsigned tg = og / nx;
            if (og + 1u == (tg + 1u) * nx) xb_add(&bar[XB_TOPGEN], 1u);
            else XB_SPIN(xb_ld(&bar[XB_TOPGEN]) == tg, bar);
            __builtin_amdgcn_fence(__ATOMIC_ACQUIRE, "agent");
            xb_add(&bar[XB_XGEN(b.x)], 1u);
            asm volatile("s_waitcnt vmcnt(0)" ::: "memory");
        } else {
            XB_SPIN(xb_ld(&bar[XB_XGEN(b.x)]) == gen, bar);
            __builtin_amdgcn_fence(__ATOMIC_ACQUIRE, "agent");
            asm volatile("s_waitcnt vmcnt(0)" ::: "memory");
        }
    }
    __syncthreads();
}

#ifndef PG8_SP2
#define PG8_SP2 true
#endif
#ifndef PG8_ALIGN
#define PG8_ALIGN true
#endif
#ifndef MK_SPLIT
#define MK_SPLIT 0
#endif

constexpr int DM = 2048, NBATCH = 4, SEQ = 4096, NLAYER = 2, M = NBATCH * SEQ, GW = 512, HD = 128, NH = 4, DFF = 5504, DIN = 6152, NP = 6144;
constexpr int NT = 512, NWAVES = 8;
constexpr float EPS = 1e-6f, KSCALE = 0.08838834764831845f;
constexpr int PH_PER_LAYER = 10, N_PHASES = 1 + NLAYER * PH_PER_LAYER;

constexpr size_t MiB = 1u << 20, KiB = 1024;
constexpr size_t WS_CTL = 0, CTL_ZERO_BYTES = 2 * MiB;
constexpr int CW_BAR = 4096, CW_Q = 8192;
constexpr size_t WS_SSQ = 1 * MiB;
constexpr size_t WS_G = 2 * MiB;
constexpr size_t WS_BLAST = 2560 * KiB, WS_MLOC = WS_BLAST + 4096, WS_MRUN = WS_MLOC + 4096;
constexpr size_t WS_DN = 3 * MiB, WS_NST = 3 * MiB + 512 * KiB;
constexpr size_t WS_LSE = 5 * MiB + 512 * KiB;
constexpr size_t WS_LRUW = 7 * MiB;
constexpr size_t WS_WGU1 = 8 * MiB, WS_WD1 = 52 * MiB, WS_WIN = 74 * MiB, WS_WOUT = 98 * MiB, WS_WGU2 = 106 * MiB, WS_WD2 = 149 * MiB;
constexpr size_t WS_XB = 171 * MiB;
constexpr size_t WS_PACT = 235 * MiB;
constexpr size_t WS_MIXED = 427 * MiB;
constexpr size_t WS_DCT = 491 * MiB;
constexpr size_t WS_CST = 555 * MiB;
constexpr size_t WS_CPART = 587 * MiB;
constexpr size_t WS_DOUT = 635 * MiB;
constexpr size_t WS_LAP = 651 * MiB, WS_LHE = 653 * MiB, WS_LCI = 655 * MiB;
constexpr size_t WS_END = 657 * MiB;
static_assert(WS_WGU1 + (size_t)2 * DFF * DM * 2 <= WS_WD1 && WS_WD1 + (size_t)DM * DFF * 2 <= WS_WIN && WS_WIN + (size_t)NP * DM * 2 <= WS_WOUT && WS_WOUT + (size_t)DM * DM * 2 <= WS_WGU2 &&
              WS_WGU2 + (size_t)2 * DFF * DM * 2 <= WS_WD2 && WS_WD2 + (size_t)DM * DFF * 2 <= WS_XB && WS_PACT + (size_t)M * DFF * 2 <= WS_MIXED && WS_PACT + (size_t)12 * M * 512 * 2 <= WS_MIXED, "ws map");
constexpr size_t SEG_STRIDE = (size_t)M * 512;
enum { SEG_LX = 0, SEG_LG, SEG_MQ, SEG_MK, SEG_MV, SEG_MO, SEG_CQ, SEG_CK, SEG_CV, SEG_SQ, SEG_SK, SEG_SV };

constexpr int LDS_MISC_OFF = 152 * 1024, LDS_BYTES = LDS_MISC_OFF + 64;

typedef unsigned short bf16;
typedef short bf16x8 __attribute__((ext_vector_type(8)));
typedef float f32x4 __attribute__((ext_vector_type(4)));
typedef unsigned v4u __attribute__((ext_vector_type(4)));
typedef unsigned v2u __attribute__((ext_vector_type(2)));
typedef float f32x2 __attribute__((ext_vector_type(2)));
__device__ __forceinline__ int opaque_tid_w(int wid) { int t = (wid << 6) | (int)__builtin_amdgcn_mbcnt_hi(~0u, __builtin_amdgcn_mbcnt_lo(~0u, 0u)); asm volatile("" : "+v"(t)); return t; }
#define opaque_tid() opaque_tid_w(p.wid)
#define LDS_WAIT() asm volatile("s_waitcnt lgkmcnt(0)" ::: "memory")
__device__ __forceinline__ unsigned f2bf(float f) { unsigned u = __builtin_bit_cast(unsigned, f); return (u + 0x7fffu + ((u >> 16) & 1u)) >> 16; }
__device__ __forceinline__ unsigned pk2(float lo, float hi) { return f2bf(lo) | (f2bf(hi) << 16); }
__device__ __forceinline__ float bf2f(unsigned b) { return __builtin_bit_cast(float, b << 16); }
__device__ __forceinline__ float bflo(unsigned w) { return __builtin_bit_cast(float, w << 16); }
__device__ __forceinline__ float bfhi(unsigned w) { return __builtin_bit_cast(float, w & 0xffff0000u); }
__device__ __forceinline__ float wave_sum(float v) {
#pragma unroll
    for (int o = 1; o < 64; o <<= 1) v += __shfl_xor(v, o);
    return v;
}
__device__ __forceinline__ float wave_max(float v) {
#pragma unroll
    for (int o = 1; o < 64; o <<= 1) v = fmaxf(v, __shfl_xor(v, o));
    return v;
}
__device__ __forceinline__ float softplusf(float x) { return fmaxf(x, 0.f) + __logf(1.0f + __expf(-fabsf(x))); }
__device__ __forceinline__ float sigmoidf(float x) { return 1.0f / (1.0f + __expf(-x)); }
__device__ __forceinline__ float gelu_tanh(float x) { const float y = 0.7978845608028654f * (x + 0.044715f * x * x * x); const float t = 1.0f - 2.0f / (1.0f + __expf(2.0f * y)); return 0.5f * x * (1.0f + t); }
template <int K> __device__ __forceinline__ void mma_lds(f32x4& acc, const LAS bf16* X, int ldx, const LAS bf16* Y, int ldy, int lane) {
    const LAS bf16* xp = X + (lane & 15) * ldx + (lane >> 4) * 8;
    const LAS bf16* yp = Y + (lane & 15) * ldy + (lane >> 4) * 8;
#pragma unroll
    for (int k = 0; k < K; k += 32) {
        const bf16x8 a = *(const LAS bf16x8*)(xp + k), b = *(const LAS bf16x8*)(yp + k);
        acc = __builtin_amdgcn_mfma_f32_16x16x32_bf16(a, b, acc, 0, 0, 0);
    }
}

typedef short v4i16_t __attribute__((ext_vector_type(4)));
__device__ __forceinline__ bf16x8 tr_frag(const LAS bf16* T, int ks, int c, int lane) {
    const LAS bf16* a0 = T + (32 * ks + 8 * (lane >> 4) + ((lane & 15) >> 2)) * 144 + 16 * c + 4 * (lane & 3);
    const v4i16_t lo = __builtin_amdgcn_ds_read_tr16_b64_v4i16((LAS v4i16_t*)a0), hi = __builtin_amdgcn_ds_read_tr16_b64_v4i16((LAS v4i16_t*)(a0 + 4 * 144));
    return (bf16x8){lo[0], lo[1], lo[2], lo[3], hi[0], hi[1], hi[2], hi[3]};
}

__device__ __forceinline__ void touch_line(const void* ptr) { const unsigned v = *(const volatile unsigned*)ptr; asm volatile("" :: "v"(v)); }
struct Params { const float* in[24]; float* out; unsigned char* ws; int ph_lo, ph_hi; };
typedef __attribute__((address_space(4))) const unsigned char* kptr_t;
template <typename T> __device__ __forceinline__ T karg(kptr_t k, int off) { return *(const __attribute__((address_space(4))) T*)(k + off); }
struct Ctx { kptr_t k; unsigned char* ws; float* out; int wid;
    __device__ __forceinline__ const float* in(int i) const { return karg<const float*>(k, 8 * i); } };
__device__ __forceinline__ Ctx make_ctx(int wid) { Ctx c; c.wid = wid; kptr_t k = (kptr_t)__builtin_amdgcn_kernarg_segment_ptr(); asm volatile("" : "+s"(k)); c.k = k; c.ws = karg<unsigned char*>(k, 200); c.out = karg<float*>(k, 192); return c; }
static_assert(sizeof(Params) == 216, "kernarg layout");

__device__ __forceinline__ int q_next(const Ctx& p, unsigned* ctr, volatile LAS int* slot) {
    __syncthreads();
    if (opaque_tid() == 0) *slot = (int)__hip_atomic_fetch_add(ctr, 1u, __ATOMIC_RELAXED, __HIP_MEMORY_SCOPE_AGENT);
    __syncthreads();
    return *slot;
}
struct TItem { const float* src; const float* gain; bf16* dst; int ldw, K_dst; };
__device__ __forceinline__ TItem titem(const float* W, int ldw, int K_dst, bf16* WT, int dst_row0, int src_col0, int k0, const float* gain, int lane) {
    const int c = lane >> 3, n4 = lane & 7; TItem t;
    t.src = W + (size_t)(k0 + 16 * c) * ldw + src_col0 + 4 * n4; t.gain = gain ? gain + k0 + 16 * c : nullptr; t.dst = WT + (size_t)(dst_row0 + 4 * n4) * K_dst + k0 + 16 * c; t.ldw = ldw; t.K_dst = K_dst; return t;
}
__device__ __forceinline__ TItem decode_item(const Ctx& p, int l, int it, int lane) {
    constexpr int I_GU = 16 * 344, I_D = 43 * 64, I_IN = 16 * 192, I_OUT = 16 * 64;
    unsigned char* ws = p.ws; int r = it;
    if (r < 2 * I_GU) {
        const int f = r >= I_GU; r -= f * I_GU; const int kb = r / 344, nb = r % 344, pn = nb >> 3, jj = nb & 7;
        const float* src = p.in((f ? 21 : 2) + (jj >> 2)) + (size_t)l * DM * DFF;
        return titem(src, DFF, DM, (bf16*)(ws + (f ? WS_WGU2 : WS_WGU1)), 32 * nb, 128 * pn + 32 * (jj & 3), 128 * kb, p.in(f ? 20 : 1) + l * DM, lane); }
    r -= 2 * I_GU;
    if (r < 2 * I_D) {
        const int f = r >= I_D; r -= f * I_D; const int kb = r / 64, nb = r % 64;
        return titem(p.in(f ? 23 : 4) + (size_t)l * DFF * DM, DM, DFF, (bf16*)(ws + (f ? WS_WD2 : WS_WD1)), 32 * nb, 32 * nb, 128 * kb, nullptr, lane); }
    r -= 2 * I_D;
    if (r < I_IN) {
        const int kb = r / 192, nb = r % 192, d0 = 32 * nb;
        return titem(p.in(6) + (size_t)l * DM * DIN, DIN, DM, (bf16*)(ws + WS_WIN), d0, d0 + (d0 >= 3072 ? 8 : 0), 128 * kb, p.in(5) + l * DM, lane); }
    r -= I_IN;
    if (r < I_OUT) { const int kb = r / 64, nb = r % 64;
        return titem(p.in(19) + (size_t)l * DM * DM, DM, DM, (bf16*)(ws + WS_WOUT), 32 * nb, 32 * nb, 128 * kb, nullptr, lane); }
    r -= I_OUT;
    const int mat = r >> 4, n = (r >> 2) & 3, nb = r & 3;
    return titem(p.in(mat ? 11 : 9) + (size_t)l * 65536 + n * 16384, 128, 128, (bf16*)(ws + WS_LRUW) + (mat * 4 + n) * 16384, 32 * nb, 32 * nb, 0, nullptr, lane);
}
__device__ __forceinline__ void convert_layer(const Ctx& p, int l, int part) {
    const int tid = opaque_tid(), lane = tid & 63, w = tid >> 6;
    const int gw = blockIdx.x * NWAVES + w, NGW = gridDim.x * NWAVES;
    constexpr int NITEMS_ALL = 2 * 16 * 344 + 2 * 43 * 64 + 16 * 192 + 16 * 64 + 32, THIRD = (NITEMS_ALL + 2) / 3;
    const int it0 = part < 0 ? 0 : part * THIRD, NITEMS = part < 0 ? NITEMS_ALL : (it0 + THIRD < NITEMS_ALL ? it0 + THIRD : NITEMS_ALL);
    for (int it = it0 + gw; it < NITEMS; it += NGW) {
        const TItem t = decode_item(p, l, it, lane);
        f32x4 v[16];
#pragma unroll
        for (int e = 0; e < 16; ++e) v[e] = *(const f32x4*)(t.src + (size_t)e * t.ldw);
        if (t.gain) {
#pragma unroll
            for (int q = 0; q < 4; ++q) { const f32x4 g = *(const f32x4*)(t.gain + 4 * q);
#pragma unroll
                for (int e = 0; e < 4; ++e) v[4 * q + e] = v[4 * q + e] * g[e]; } }
#pragma unroll
        for (int j = 0; j < 4; ++j) {
            v4u o0, o1; o0.x = pk2(v[0][j], v[1][j]); o0.y = pk2(v[2][j], v[3][j]); o0.z = pk2(v[4][j], v[5][j]); o0.w = pk2(v[6][j], v[7][j]);
            o1.x = pk2(v[8][j], v[9][j]); o1.y = pk2(v[10][j], v[11][j]); o1.z = pk2(v[12][j], v[13][j]); o1.w = pk2(v[14][j], v[15][j]);
            *(v4u*)(t.dst + (size_t)j * t.K_dst) = o0; *(v4u*)(t.dst + (size_t)j * t.K_dst + 8) = o1;
        }
    }
}
__device__ __forceinline__ void prologue_x(const Ctx& p) {
    const int tid = opaque_tid(), lane = tid & 63, w = tid >> 6;
    const int gw = blockIdx.x * NWAVES + w, NGW = gridDim.x * NWAVES;
    bf16* xb = (bf16*)(p.ws + WS_XB); unsigned long long* ssq = (unsigned long long*)(p.ws + WS_SSQ);
    for (int m = gw; m < M; m += NGW) {
        const f32x4* xr = (const f32x4*)(p.in(0) + (size_t)m * DM) + lane; float s = 0.f;
        v2u* o8 = (v2u*)(xb + (size_t)m * DM) + lane;
#pragma unroll
        for (int j = 0; j < 8; ++j) { const f32x4 v = xr[64 * j]; s += (v[0] * v[0] + v[1] * v[1]) + (v[2] * v[2] + v[3] * v[3]); v2u o; o.x = pk2(v[0], v[1]); o.y = pk2(v[2], v[3]); o8[64 * j] = o; }
        s = wave_sum(s);
        if (lane == 0) ssq[m] = (unsigned long long)(s * pg8::SSQ_FX + 0.5f);
    }
}
__device__ __forceinline__ void gates_phase(const Ctx& p, int l, const unsigned long long* ssq, LAS unsigned char* lds) {
    const int tid = opaque_tid(), lane = tid & 63, w = tid >> 6;
    LAS float* WG8 = (LAS float*)lds;
    const float* win = p.in(6) + (size_t)l * DM * DIN; const float* gain = p.in(5) + l * DM;
    for (int idx = tid; idx < DM * 8; idx += NT) { const int k = idx >> 3, c = idx & 7; WG8[k * 8 + (k >> 3) * 4 + c] = win[(size_t)k * DIN + 3072 + c] * gain[k]; }
    __syncthreads();
    const bf16* xb = (const bf16*)(p.ws + WS_XB); float* G = (float*)(p.ws + WS_G);
    for (int rb = blockIdx.x; rb < M / 64; rb += gridDim.x)
        for (int rr = 0; rr < 8; ++rr) {
            const int row = rb * 64 + w * 8 + rr;
            float a8[8];
#pragma unroll
            for (int c = 0; c < 8; ++c) a8[c] = 0.f;
#pragma unroll 1
            for (int it = 0; it < 4; ++it) {
                const int k0 = it * 512 + lane * 8;
                const v4u xv = *(const v4u*)(xb + (size_t)row * DM + k0);
                const float xs[8] = {bflo(xv.x), bfhi(xv.x), bflo(xv.y), bfhi(xv.y), bflo(xv.z), bfhi(xv.z), bflo(xv.w), bfhi(xv.w)};
#pragma unroll
                for (int e = 0; e < 8; ++e) { const int k = k0 + e; const LAS f32x4* wp = (const LAS f32x4*)(WG8 + k * 8 + (k >> 3) * 4); const f32x4 w0 = wp[0], w1 = wp[1];
                    a8[0] += xs[e] * w0[0]; a8[1] += xs[e] * w0[1]; a8[2] += xs[e] * w0[2]; a8[3] += xs[e] * w0[3]; a8[4] += xs[e] * w1[0]; a8[5] += xs[e] * w1[1]; a8[6] += xs[e] * w1[2]; a8[7] += xs[e] * w1[3]; }
            }
            const float rs = __builtin_amdgcn_rsqf((float)ssq[row] * (1.0f / (DM * pg8::SSQ_FX)) + EPS);
            float mine = 0.f;
#pragma unroll
            for (int c = 0; c < 8; ++c) { const float s = wave_sum(a8[c]); if (lane == c) mine = s; }
            if (lane < 8) G[(size_t)row * 8 + lane] = mine * rs;
        }
    __syncthreads();
}

constexpr int LRU_T = 16, LRU_NC = SEQ / LRU_T;
template <int PASS>
__device__ __forceinline__ void lru_unit(const Ctx& p, int l, int u, int un, LAS unsigned char* lds) {
    const int tid = opaque_tid(), lane = tid & 63, w = tid >> 6, fr = lane & 15, fq = lane >> 4;
    const int b = u >> 8, c = u & 255, row0 = b * SEQ + c * LRU_T;
    LAS float* XC = (LAS float*)lds;
    LAS float* AA = (LAS float*)(lds + 32768);
    LAS bf16* XCB = (LAS bf16*)(lds + 65536);
    LAS bf16* Y = (LAS bf16*)(lds + 82176);
    const bf16* xr = (const bf16*)(p.ws + WS_PACT) + SEG_LX * SEG_STRIDE;
    const bf16* gt = (const bf16*)(p.ws + WS_PACT) + SEG_LG * SEG_STRIDE;
    if (un < NBATCH * LRU_NC) {
        const int rown = (un >> 8) * SEQ + (un & 255) * LRU_T;
        if (tid < 128) touch_line(xr + (size_t)(rown + (tid >> 3)) * GW + (tid & 7) * 64);
        else if (PASS == 3 && tid < 256) touch_line(gt + (size_t)(rown + ((tid - 128) >> 3)) * GW + (tid & 7) * 64);
    }
    float gate_v[16];
    if (PASS == 3) {
#pragma unroll
        for (int t = 0; t < 16; ++t) gate_v[t] = bf2f(gt[(size_t)(row0 + t) * GW + tid]);
    }
    {
        const int ch = 2 * (tid & 255), th = tid >> 8;
        const float* cw = p.in(7) + l * 4 * GW + ch; const float* cb = p.in(8) + l * GW + ch;
        const f32x2 w0 = *(const f32x2*)cw, w1 = *(const f32x2*)(cw + GW), w2 = *(const f32x2*)(cw + 2 * GW), w3 = *(const f32x2*)(cw + 3 * GW), cbv = *(const f32x2*)cb;
        const bf16* xp = xr + (size_t)(row0 + 8 * th - 3) * GW + ch;
        unsigned xv[11];
#pragma unroll
        for (int i = 0; i < 11; ++i) xv[i] = (c * LRU_T + 8 * th - 3 + i >= 0) ? *(const unsigned*)(xp + (size_t)i * GW) : 0u;
#pragma unroll
        for (int i = 0; i < 8; ++i) {
            const int t = 8 * th + i;
            const float xa = w0.x * bflo(xv[i]) + w1.x * bflo(xv[i + 1]) + w2.x * bflo(xv[i + 2]) + w3.x * bflo(xv[i + 3]) + cbv.x;
            const float xbv = w0.y * bfhi(xv[i]) + w1.y * bfhi(xv[i + 1]) + w2.y * bfhi(xv[i + 2]) + w3.y * bfhi(xv[i + 3]) + cbv.y;
            *(LAS f32x2*)(XC + t * 512 + ch) = (f32x2){xa, xbv}; *(LAS unsigned*)(XCB + t * 520 + ch) = pk2(xa, xbv);
        }
    }
    __syncthreads();
    {
        const int n = w >> 1;
        const float* ba = p.in(10) + l * GW; const float* bx = p.in(12) + l * GW; const float* lam = p.in(13) + l * GW;
        const bf16* WaT = (const bf16*)(p.ws + WS_LRUW); const bf16* WxT = WaT + 4 * 16384;
        const LAS bf16* xp = XCB + fr * 520 + n * 128 + 8 * fq;
        bf16x8 af[4];
#pragma unroll
        for (int k = 0; k < 4; ++k) af[k] = *(const LAS bf16x8*)(xp + 32 * k);
#pragma unroll
        for (int ds = 0; ds < 4; ++ds) {
            const int d0 = 16 * (4 * (w & 1) + ds);
            const bf16* wap = WaT + (size_t)(n * 128 + d0 + fr) * 128 + 8 * fq; const bf16* wxp = WxT + (size_t)(n * 128 + d0 + fr) * 128 + 8 * fq;
            f32x4 za = {0.f, 0.f, 0.f, 0.f}, zx = {0.f, 0.f, 0.f, 0.f};
#pragma unroll
            for (int k = 0; k < 4; ++k) {
                const bf16x8 b1 = *(const bf16x8*)(wap + 32 * k), b2 = *(const bf16x8*)(wxp + 32 * k);
                za = __builtin_amdgcn_mfma_f32_16x16x32_bf16(af[k], b1, za, 0, 0, 0); zx = __builtin_amdgcn_mfma_f32_16x16x32_bf16(af[k], b2, zx, 0, 0, 0);
            }
            const int dg = n * 128 + d0 + fr; const float bav = ba[dg], bxv = bx[dg], spl = 8.0f * softplusf(-lam[dg]);
#pragma unroll
            for (int j = 0; j < 4; ++j) {
                const int t = 4 * fq + j;
                const float r = sigmoidf(za[j] + bav), ii = sigmoidf(zx[j] + bxv), loga = -spl * r, a = __expf(loga), mult = sqrtf(-expm1f(2.0f * loga));
                const float xc = XC[t * 512 + dg]; AA[t * 512 + dg] = a; XC[t * 512 + dg] = mult * ii * xc;
            }
        }
    }
    __syncthreads();
    {
        const int dg = tid; const size_t ci = (size_t)(b * LRU_NC + c) * GW + dg;
        float h = (PASS == 3) ? ((const float*)(p.ws + WS_LCI))[ci] : 0.f, ap = 1.f;
#pragma unroll
        for (int t = 0; t < 16; ++t) { const float a = AA[t * 512 + dg], uu = XC[t * 512 + dg]; h = a * h + uu; ap *= a; if (PASS == 3) Y[t * 520 + dg] = (bf16)f2bf(h * gelu_tanh(gate_v[t])); }
        if (PASS == 1) { ((float*)(p.ws + WS_LAP))[ci] = ap; ((float*)(p.ws + WS_LHE))[ci] = h; }
    }
    if (PASS == 3) {
        __syncthreads();
        const float* ga = p.in(18) + l * DM; bf16* mixed = (bf16*)(p.ws + WS_MIXED);
        float gv[8];
#pragma unroll
        for (int e = 0; e < 8; ++e) gv[e] = ga[lane * 8 + e];
#pragma unroll
        for (int tt = 0; tt < 2; ++tt) {
            const int t = w * 2 + tt; const v4u v = *(const LAS v4u*)(Y + t * 520 + lane * 8);
            float f[8] = {bflo(v.x), bfhi(v.x), bflo(v.y), bfhi(v.y), bflo(v.z), bfhi(v.z), bflo(v.w), bfhi(v.w)}; float ss = 0.f;
#pragma unroll
            for (int e = 0; e < 8; ++e) ss += f[e] * f[e];
            ss = wave_sum(ss); const float rs = __builtin_amdgcn_rsqf(ss * (1.0f / GW) + EPS);
            v4u o; o.x = pk2(f[0] * rs * gv[0], f[1] * rs * gv[1]); o.y = pk2(f[2] * rs * gv[2], f[3] * rs * gv[3]); o.z = pk2(f[4] * rs * gv[4], f[5] * rs * gv[5]); o.w = pk2(f[6] * rs * gv[6], f[7] * rs * gv[7]);
            *(v4u*)(mixed + (size_t)(row0 + t) * DM + lane * 8) = o;
        }
    }
}
__device__ __forceinline__ void lru_carry_unit(const Ctx& p, int b) {
    const int ch = opaque_tid(); const float* LAP = (const float*)(p.ws + WS_LAP); const float* LHE = (const float*)(p.ws + WS_LHE); float* LCI = (float*)(p.ws + WS_LCI);
    float carry = 0.f;
    for (int c0 = 0; c0 < LRU_NC; c0 += 32) {
        float ap[32], he[32];
#pragma unroll
        for (int j = 0; j < 32; ++j) { const size_t o = (size_t)(b * LRU_NC + c0 + j) * GW + ch; ap[j] = LAP[o]; he[j] = LHE[o]; }
#pragma unroll
        for (int j = 0; j < 32; ++j) { LCI[(size_t)(b * LRU_NC + c0 + j) * GW + ch] = carry; carry = ap[j] * carry + he[j]; }
    }
}

__device__ __forceinline__ void mlstm1_unit(const Ctx& p, int l, int u, int un, LAS unsigned char* lds) {
    const int tid = opaque_tid(), lane = tid & 63, w = tid >> 6, fr = lane & 15, fq = lane >> 4;
    const int bh = u >> 6, c = u & 63, b = bh >> 2, h = bh & 3, row0 = b * SEQ + c * 64;
    LAS bf16* VH = (LAS bf16*)lds;
    LAS bf16* KW = (LAS bf16*)(lds + 18432);
    LAS float* WS = (LAS float*)(lds + 36864);
    const float* G = (const float*)(p.ws + WS_G);
    const bf16* Kg = (const bf16*)(p.ws + WS_PACT) + SEG_MK * SEG_STRIDE + h * HD; const bf16* Vg = (const bf16*)(p.ws + WS_PACT) + SEG_MV * SEG_STRIDE + h * HD;
    v4u kvr[2], vvr[2];
#pragma unroll
    for (int i = 0; i < 2; ++i) { const int q = tid + NT * i, s = q >> 4, kc = (q & 15) * 8; kvr[i] = *(const v4u*)(Kg + (size_t)(row0 + s) * GW + kc); vvr[i] = *(const v4u*)(Vg + (size_t)(row0 + s) * GW + kc); }
    if (un < 1024 && tid < 256) {
        const int bhn = un >> 6, rown = (bhn >> 2) * SEQ + (un & 63) * 64; const bf16* src = (tid < 128 ? Kg : Vg) + ((bhn & 3) - h) * HD;
        touch_line(src + (size_t)(rown + ((tid & 127) >> 1)) * GW + (tid & 1) * 64);
    }
    if (w == 0) {
        const int s = lane;
        const float ip = G[(size_t)(row0 + s) * 8 + h] + p.in(14)[l * NH + h], fp = G[(size_t)(row0 + s) * 8 + 4 + h] + p.in(15)[l * NH + h];
        float bc = -softplusf(-fp);
#pragma unroll
        for (int o = 1; o < 64; o <<= 1) { const float t = __shfl_up(bc, o); if (lane >= o) bc += t; }
        const float blast = __shfl(bc, 63), logw = blast - bc + ip, mloc = wave_max(logw);
        WS[s] = __expf(logw - mloc);
        if (lane == 0) { ((float*)(p.ws + WS_BLAST))[u] = blast; ((float*)(p.ws + WS_MLOC))[u] = mloc; }
    }
    __syncthreads();
#pragma unroll
    for (int i = 0; i < 2; ++i) {
        const int q = tid + NT * i, s = q >> 4, kc = (q & 15) * 8;
        const v4u kv = kvr[i]; const float ws = WS[s] * KSCALE;
        v4u ko; ko.x = pk2(bflo(kv.x) * ws, bfhi(kv.x) * ws); ko.y = pk2(bflo(kv.y) * ws, bfhi(kv.y) * ws); ko.z = pk2(bflo(kv.z) * ws, bfhi(kv.z) * ws); ko.w = pk2(bflo(kv.w) * ws, bfhi(kv.w) * ws);
        *(LAS v4u*)(KW + s * 144 + kc) = ko; *(LAS v4u*)(VH + s * 144 + kc) = vvr[i];
    }
    __syncthreads();
    float* DCT = (float*)(p.ws + WS_DCT) + (size_t)u * 16384;
    const bf16x8 vb0 = tr_frag(VH, 0, w, lane), vb1 = tr_frag(VH, 1, w, lane);
#pragma unroll
    for (int ki = 0; ki < 8; ++ki) {
        f32x4 acc = {0.f, 0.f, 0.f, 0.f};
        acc = __builtin_amdgcn_mfma_f32_16x16x32_bf16(tr_frag(KW, 0, ki, lane), vb0, acc, 0, 0, 0);
        acc = __builtin_amdgcn_mfma_f32_16x16x32_bf16(tr_frag(KW, 1, ki, lane), vb1, acc, 0, 0, 0);
        *(f32x4*)(DCT + (16 * w + fr) * 128 + 16 * ki + 4 * fq) = acc;
    }
    if (tid < 128) { float s = 0.f;
#pragma unroll 8
        for (int t = 0; t < 64; ++t) s += bf2f(KW[t * 144 + tid]);
        ((float*)(p.ws + WS_DN))[(size_t)u * 128 + tid] = s; }
}
__device__ __forceinline__ void mlstm_scan_unit(const Ctx& p, int su) {
    const int tid = opaque_tid(), bh = su >> 3, slice = su & 7, e0 = slice * 2048 + tid * 4;
    const float* DCT = (const float*)(p.ws + WS_DCT); bf16* CST = (bf16*)(p.ws + WS_CST);
    const float* DN = (const float*)(p.ws + WS_DN); float* NST = (float*)(p.ws + WS_NST);
    const float* BL = (const float*)(p.ws + WS_BLAST); const float* ML = (const float*)(p.ws + WS_MLOC); float* MR = (float*)(p.ws + WS_MRUN);
    f32x4 C = {0.f, 0.f, 0.f, 0.f}, nv = {0.f, 0.f, 0.f, 0.f}; float mrun = 0.f;
    const bool donv = (slice == 0 && tid < 32);
    for (int c0 = 0; c0 < 64; c0 += 16) {
        f32x4 d4[16], n4[16]; float bl[16], ml[16];
#pragma unroll
        for (int j = 0; j < 16; ++j) { const int ui = bh * 64 + c0 + j; d4[j] = *(const f32x4*)(DCT + (size_t)ui * 16384 + e0); bl[j] = BL[ui]; ml[j] = ML[ui];
            n4[j] = donv ? *(const f32x4*)(DN + (size_t)ui * 128 + tid * 4) : (f32x4){0.f, 0.f, 0.f, 0.f}; }
#pragma unroll
        for (int j = 0; j < 16; ++j) {
            const int ui = bh * 64 + c0 + j;
            v2u o; o.x = pk2(C[0], C[1]); o.y = pk2(C[2], C[3]); *(v2u*)(CST + (size_t)ui * 16384 + e0) = o;
            if (donv) *(f32x4*)(NST + (size_t)ui * 128 + tid * 4) = nv;
            if (slice == 0 && tid == 0) MR[ui] = mrun;
            const float mnext = fmaxf(bl[j] + mrun, ml[j]), dec = __expf(bl[j] + mrun - mnext), sc = __expf(ml[j] - mnext);
            C = C * dec + d4[j] * sc; nv = nv * dec + n4[j] * sc; mrun = mnext;
        }
    }
}
__device__ __forceinline__ void mlstm3_unit(const Ctx& p, int l, int u, int un, LAS unsigned char* lds) {
    const int tid = opaque_tid(), lane = tid & 63, w = tid >> 6, fr = lane & 15, fq = lane >> 4;
    const int bh = u >> 6, c = u & 63, b = bh >> 2, h = bh & 3, row0 = b * SEQ + c * 64;
    LAS bf16* Q = (LAS bf16*)lds;
    LAS bf16* KS = (LAS bf16*)(lds + 17408);
    LAS bf16* VH = (LAS bf16*)(lds + 34816);
    LAS bf16* CT = (LAS bf16*)(lds + 53248);
    LAS bf16* SB = (LAS bf16*)(lds + 88064);
    LAS float* HF = (LAS float*)(lds + 97280);
    LAS float* BV = (LAS float*)(lds + 130304);
    LAS float* CV = BV + 64;
    LAS float* MT = BV + 128;
    LAS float* WI = BV + 192;
    LAS float* QN = BV + 256;
    LAS float* NV = BV + 320;
    LAS float* RSP = BV + 448;
    const float* G = (const float*)(p.ws + WS_G);
    const bf16* Qg = (const bf16*)(p.ws + WS_PACT) + SEG_MQ * SEG_STRIDE + h * HD; const bf16* Kg = (const bf16*)(p.ws + WS_PACT) + SEG_MK * SEG_STRIDE + h * HD;
    const bf16* Vg = (const bf16*)(p.ws + WS_PACT) + SEG_MV * SEG_STRIDE + h * HD; const bf16* Cg = (const bf16*)(p.ws + WS_CST) + (size_t)u * 16384;
    const bf16* Og = (const bf16*)(p.ws + WS_PACT) + SEG_MO * SEG_STRIDE + h * HD;
    {
        v4u qv[2], kv[2], vv[2], cv4[4];
#pragma unroll
        for (int i = 0; i < 2; ++i) { const int q = tid + NT * i, s = q >> 4, kc = (q & 15) * 8;
            qv[i] = *(const v4u*)(Qg + (size_t)(row0 + s) * GW + kc); kv[i] = *(const v4u*)(Kg + (size_t)(row0 + s) * GW + kc); vv[i] = *(const v4u*)(Vg + (size_t)(row0 + s) * GW + kc); }
#pragma unroll
        for (int i = 0; i < 4; ++i) { const int q = tid + NT * i, r = q >> 4, kc = (q & 15) * 8; cv4[i] = *(const v4u*)(Cg + r * 128 + kc); }
        if (w == 0) {
            const int s = lane;
            const float ip = G[(size_t)(row0 + s) * 8 + h] + p.in(14)[l * NH + h], fp = G[(size_t)(row0 + s) * 8 + 4 + h] + p.in(15)[l * NH + h];
            float bc = -softplusf(-fp);
#pragma unroll
            for (int o = 1; o < 64; o <<= 1) { const float t = __shfl_up(bc, o); if (lane >= o) bc += t; }
            const float cv = ip - bc; float g = cv;
#pragma unroll
            for (int o = 1; o < 64; o <<= 1) { const float t = __shfl_up(g, o); if (lane >= o) g = fmaxf(g, t); }
            const float mrun = ((const float*)(p.ws + WS_MRUN))[u], mt = bc + fmaxf(mrun, g);
            BV[s] = bc; CV[s] = cv; MT[s] = mt; WI[s] = __expf(bc + mrun - mt);
        }
        if (tid >= 64 && tid < 192) NV[tid - 64] = ((const float*)(p.ws + WS_NST))[(size_t)u * 128 + tid - 64];
#pragma unroll
        for (int i = 0; i < 2; ++i) { const int q = tid + NT * i, s = q >> 4, kc = (q & 15) * 8;
            *(LAS v4u*)(Q + s * 136 + kc) = qv[i];
            v4u ko; ko.x = pk2(bflo(kv[i].x) * KSCALE, bfhi(kv[i].x) * KSCALE); ko.y = pk2(bflo(kv[i].y) * KSCALE, bfhi(kv[i].y) * KSCALE); ko.z = pk2(bflo(kv[i].z) * KSCALE, bfhi(kv[i].z) * KSCALE); ko.w = pk2(bflo(kv[i].w) * KSCALE, bfhi(kv[i].w) * KSCALE);
            *(LAS v4u*)(KS + s * 136 + kc) = ko; *(LAS v4u*)(VH + s * 144 + kc) = vv[i]; }
#pragma unroll
        for (int i = 0; i < 4; ++i) { const int q = tid + NT * i, r = q >> 4, kc = (q & 15) * 8; *(LAS v4u*)(CT + r * 136 + kc) = cv4[i]; }
    }
    if (un < 1024) {
        const int bhn = un >> 6, rown = (bhn >> 2) * SEQ + (un & 63) * 64, t4 = tid >> 7; const bf16* src = (t4 == 0 ? Qg : t4 == 1 ? Kg : t4 == 2 ? Vg : Og) + ((bhn & 3) - h) * HD;
        touch_line(src + (size_t)(rown + ((tid & 127) >> 1)) * GW + (tid & 1) * 64);
        if (tid < 256) touch_line((const bf16*)(p.ws + WS_CST) + (size_t)un * 16384 + tid * 64);
    }
    float op0[8], op1[8];
#pragma unroll
    for (int tt = 0; tt < 8; ++tt) { op0[tt] = bf2f(Og[(size_t)(row0 + w * 8 + tt) * GW + lane]); op1[tt] = bf2f(Og[(size_t)(row0 + w * 8 + tt) * GW + lane + 64]); }
    __syncthreads();
    const int ti = w >> 1;
    {
#pragma unroll
        for (int x = 0; x < 2; ++x) {
            const int si = 2 * (w & 1) + x;
            f32x4 acc = {0.f, 0.f, 0.f, 0.f};
            if (si <= ti) mma_lds<128>(acc, Q + 16 * ti * 136, 136, KS + 16 * si * 136, 136, lane);
            const int s = 16 * si + fr; const float cvs = CV[s];
#pragma unroll
            for (int j = 0; j < 4; ++j) { const int t = 16 * ti + 4 * fq + j; const float sd = (s <= t) ? acc[j] * __expf(BV[t] + cvs - MT[t]) : 0.f;
                SB[t * 72 + s] = (bf16)f2bf(sd);
                float r = sd; r += __shfl_xor(r, 1); r += __shfl_xor(r, 2); r += __shfl_xor(r, 4); r += __shfl_xor(r, 8);
                if (fr == 0) RSP[t * 4 + si] = r; }
        }
        if (w == 7) { const int t = lane; float qn = 0.f;
#pragma unroll 8
            for (int k = 0; k < 128; ++k) qn += bf2f(Q[t * 136 + k]) * NV[k];
            QN[t] = qn; }
    }
    __syncthreads();
    {
        const bf16x8 sa0 = *(const LAS bf16x8*)(SB + (16 * ti + fr) * 72 + 8 * fq), sa1 = *(const LAS bf16x8*)(SB + (16 * ti + fr) * 72 + 32 + 8 * fq);
        float wi[4], dinv[4];
#pragma unroll
        for (int j = 0; j < 4; ++j) { const int t = 16 * ti + 4 * fq + j; wi[j] = WI[t];
            const float den = (RSP[t * 4] + RSP[t * 4 + 1]) + (RSP[t * 4 + 2] + RSP[t * 4 + 3]) + wi[j] * QN[t];
            dinv[j] = 1.0f / fmaxf(fabsf(den), __expf(-MT[t])); }
#pragma unroll
        for (int x = 0; x < 4; ++x) {
            const int vi = 4 * (w & 1) + x;
            f32x4 a1 = {0.f, 0.f, 0.f, 0.f}, a2 = {0.f, 0.f, 0.f, 0.f};
            a1 = __builtin_amdgcn_mfma_f32_16x16x32_bf16(sa0, tr_frag(VH, 0, vi, lane), a1, 0, 0, 0);
            a1 = __builtin_amdgcn_mfma_f32_16x16x32_bf16(sa1, tr_frag(VH, 1, vi, lane), a1, 0, 0, 0);
            mma_lds<128>(a2, Q + 16 * ti * 136, 136, CT + 16 * vi * 136, 136, lane);
#pragma unroll
            for (int j = 0; j < 4; ++j) HF[(16 * ti + 4 * fq + j) * 129 + 16 * vi + fr] = (a1[j] + wi[j] * a2[j]) * dinv[j];
        }
    }
    __syncthreads();
    {
        const float* gb = p.in(18) + l * DM + GW + h * HD; bf16* mixed = (bf16*)(p.ws + WS_MIXED);
        const float g0 = gb[lane], g1 = gb[lane + 64];
#pragma unroll
        for (int tt = 0; tt < 8; ++tt) {
            const int t = w * 8 + tt; const float h0 = HF[t * 129 + lane], h1 = HF[t * 129 + lane + 64];
            const float ss = wave_sum(h0 * h0 + h1 * h1), rs = __builtin_amdgcn_rsqf(ss * (1.0f / HD) + EPS);
            bf16* mo = mixed + (size_t)(row0 + t) * DM + GW + h * HD;
            mo[lane] = (bf16)f2bf(h0 * rs * g0 * sigmoidf(op0[tt])); mo[lane + 64] = (bf16)f2bf(h1 * rs * g1 * sigmoidf(op1[tt]));
        }
    }
}

template <int NCH> __device__ __forceinline__ void ld_rows(v4u (&r)[NCH], const bf16* src, int gbase, int gstride, int tid) {
#pragma unroll
    for (int i = 0; i < NCH; ++i) { const int q = tid + NT * i, row = q >> 4, kc = (q & 15) * 8; r[i] = *(const v4u*)(src + (size_t)(gbase + row * gstride) * GW + kc); }
}
template <bool NORM, int NCH, int PITCH> __device__ __forceinline__ void st_rows(LAS bf16* dst, const v4u (&r)[NCH], const float (&gain)[8], int tid) {
#pragma unroll
    for (int i = 0; i < NCH; ++i) {
        const int q = tid + NT * i, row = q >> 4, kc = (q & 15) * 8; v4u v = r[i];
        if (NORM) {
            float f[8] = {bflo(v.x), bfhi(v.x), bflo(v.y), bfhi(v.y), bflo(v.z), bfhi(v.z), bflo(v.w), bfhi(v.w)}; float ss = 0.f;
#pragma unroll
            for (int e = 0; e < 8; ++e) ss += f[e] * f[e];
            ss += __shfl_xor(ss, 1); ss += __shfl_xor(ss, 2); ss += __shfl_xor(ss, 4); ss += __shfl_xor(ss, 8);
            const float rs = __builtin_amdgcn_rsqf(ss * (1.0f / HD) + EPS);
            v.x = pk2(f[0] * rs * gain[0], f[1] * rs * gain[1]); v.y = pk2(f[2] * rs * gain[2], f[3] * rs * gain[3]);
            v.z = pk2(f[4] * rs * gain[4], f[5] * rs * gain[5]); v.w = pk2(f[6] * rs * gain[6], f[7] * rs * gain[7]);
        }
        *(LAS v4u*)(dst + row * PITCH + kc) = v;
    }
}
constexpr int ATT_K = 0, ATT_V = 17408, ATT_PL = 35840, ATT_VOTE = 72704, ATT_Q = 73728;
__device__ __forceinline__ void load_qfrags(bf16x8 (&qf)[2][4], const LAS bf16* QH, int w, int lane) {
#pragma unroll
    for (int rt = 0; rt < 2; ++rt)
#pragma unroll
        for (int k = 0; k < 4; ++k) qf[rt][k] = *(const LAS bf16x8*)(QH + (32 * w + 16 * rt + (lane & 15)) * 136 + 32 * k + 8 * (lane >> 4));
}

__device__ __forceinline__ void dilated_unit(const Ctx& p, int l, int u, LAS unsigned char* lds) {
    const int tid = opaque_tid(), lane = tid & 63, w = tid >> 6, fr = lane & 15, fq = lane >> 4;
    const int pat = u >> 8, rem = u & 255, bh = rem >> 4, x = rem & 15, b = bh >> 2, h = bh & 3;
    const int d = pat == 0 ? 1 : (pat == 1 ? 4 : 16);
    const int r = pat == 0 ? 0 : (pat == 1 ? (x >> 2) : x), nbk = pat == 0 ? x : (pat == 1 ? (x & 3) : 0);
    LAS bf16* QH = (LAS bf16*)(lds + ATT_Q); LAS bf16* KH = (LAS bf16*)(lds + ATT_K); LAS bf16* VH = (LAS bf16*)(lds + ATT_V); LAS bf16* PL = (LAS bf16*)(lds + ATT_PL) + w * 32 * 72;
    const bf16* Qg = (const bf16*)(p.ws + WS_PACT) + SEG_CQ * SEG_STRIDE + h * HD; const bf16* Kg = (const bf16*)(p.ws + WS_PACT) + SEG_CK * SEG_STRIDE + h * HD;
    const bf16* Vg = (const bf16*)(p.ws + WS_PACT) + SEG_CV * SEG_STRIDE + h * HD;
    float qgain[8], kgain[8];
#pragma unroll
    for (int e = 0; e < 8; ++e) { qgain[e] = p.in(16)[l * HD + (tid & 15) * 8 + e]; kgain[e] = p.in(17)[l * HD + (tid & 15) * 8 + e]; }
    const float slope_d = exp2f(-2.0f * (float)(h + 1)) * (float)d;
    const int kt0 = (nbk == 0 ? 2 : 0), gk0 = b * SEQ + (nbk * 256 - 128) * d + r;
    v4u kr[2], vr[2];
    { v4u qr[8]; ld_rows<8>(qr, Qg, b * SEQ + (nbk * 256) * d + r, d, tid); ld_rows<2>(kr, Kg, gk0 + kt0 * 64 * d, d, tid); ld_rows<2>(vr, Vg, gk0 + kt0 * 64 * d, d, tid);
      st_rows<true, 8, 136>(QH, qr, qgain, tid); }
    __syncthreads();
    bf16x8 qf[2][4]; load_qfrags(qf, QH, w, lane);
    float m_i[2] = {-1e30f, -1e30f}, l_i[2] = {0.f, 0.f}; f32x4 o[2][8];
#pragma unroll
    for (int rt = 0; rt < 2; ++rt)
#pragma unroll
        for (int ds = 0; ds < 8; ++ds) o[rt][ds] = (f32x4){0.f, 0.f, 0.f, 0.f};
    for (int kt = kt0; kt < 6; ++kt) {
        __syncthreads();
        st_rows<true, 2, 136>(KH, kr, kgain, tid); st_rows<false, 2, 144>(VH, vr, kgain, tid);
        __syncthreads();
        if (kt < 5) { ld_rows<2>(kr, Kg, gk0 + (kt + 1) * 64 * d, d, tid); ld_rows<2>(vr, Vg, gk0 + (kt + 1) * 64 * d, d, tid); }
        if ((64 * kt + 63 >= 32 * w) && (64 * kt <= 32 * w + 31 + 128)) {
            f32x4 s[2][4];
#pragma unroll
            for (int rt = 0; rt < 2; ++rt)
#pragma unroll
                for (int n = 0; n < 4; ++n) s[rt][n] = (f32x4){0.f, 0.f, 0.f, 0.f};
#pragma unroll
            for (int k = 0; k < 4; ++k)
#pragma unroll
                for (int n = 0; n < 4; ++n) { const bf16x8 kf = *(const LAS bf16x8*)(KH + (16 * n + fr) * 136 + 32 * k + 8 * fq);
                    s[0][n] = __builtin_amdgcn_mfma_f32_16x16x32_bf16(kf, qf[0][k], s[0][n], 0, 0, 0); s[1][n] = __builtin_amdgcn_mfma_f32_16x16x32_bf16(kf, qf[1][k], s[1][n], 0, 0, 0); }
            float alpha[2];
#pragma unroll
            for (int rt = 0; rt < 2; ++rt) {
                const int qi = 32 * w + 16 * rt + fr; float mx = -1e30f;
#pragma unroll
                for (int n = 0; n < 4; ++n)
#pragma unroll
                    for (int j = 0; j < 4; ++j) { const int dist = 128 + qi - (64 * kt + 16 * n + 4 * fq + j); const bool valid = dist >= 0 && dist <= 128;
                        const float sc = valid ? s[rt][n][j] * KSCALE - slope_d * (float)dist : -1e30f; s[rt][n][j] = sc; mx = fmaxf(mx, sc); }
                mx = fmaxf(mx, __shfl_xor(mx, 16)); mx = fmaxf(mx, __shfl_xor(mx, 32));
                const float m_new = fmaxf(m_i[rt], mx); alpha[rt] = __expf(m_i[rt] - m_new); float ls = 0.f;
#pragma unroll
                for (int n = 0; n < 4; ++n) {
#pragma unroll
                    for (int j = 0; j < 4; ++j) { const float pv = s[rt][n][j] > -1e29f ? __expf(s[rt][n][j] - m_new) : 0.f; ls += pv; s[rt][n][j] = pv; }
                    v2u pw; pw.x = pk2(s[rt][n][0], s[rt][n][1]); pw.y = pk2(s[rt][n][2], s[rt][n][3]);
                    *(LAS v2u*)(PL + (16 * rt + fr) * 72 + 16 * n + 4 * fq) = pw;
                }
                ls += __shfl_xor(ls, 16); ls += __shfl_xor(ls, 32);
                l_i[rt] = l_i[rt] * alpha[rt] + ls; m_i[rt] = m_new;
            }
            asm volatile("" ::: "memory");
            bf16x8 pf[2][2];
#pragma unroll
            for (int rt = 0; rt < 2; ++rt) { pf[rt][0] = *(const LAS bf16x8*)(PL + (16 * rt + fr) * 72 + 8 * fq); pf[rt][1] = *(const LAS bf16x8*)(PL + (16 * rt + fr) * 72 + 32 + 8 * fq); }
#pragma unroll
            for (int ds = 0; ds < 8; ++ds) { const bf16x8 v0 = tr_frag(VH, 0, ds, lane), v1 = tr_frag(VH, 1, ds, lane);
#pragma unroll
                for (int rt = 0; rt < 2; ++rt) { o[rt][ds] = o[rt][ds] * alpha[rt];
                    o[rt][ds] = __builtin_amdgcn_mfma_f32_16x16x32_bf16(v0, pf[rt][0], o[rt][ds], 0, 0, 0); o[rt][ds] = __builtin_amdgcn_mfma_f32_16x16x32_bf16(v1, pf[rt][1], o[rt][ds], 0, 0, 0); } }
        }
    }
#pragma unroll
    for (int rt = 0; rt < 2; ++rt) {
        const int qi = 32 * w + 16 * rt + fr; const float inv = 1.0f / l_i[rt]; const int grow = b * SEQ + (nbk * 256 + qi) * d + r;
        bf16* og = (bf16*)(p.ws + WS_CPART) + (size_t)pat * SEG_STRIDE + (size_t)grow * GW + h * HD;
#pragma unroll
        for (int ds = 0; ds < 8; ++ds) { v2u ov; ov.x = pk2(o[rt][ds][0] * inv, o[rt][ds][1] * inv); ov.y = pk2(o[rt][ds][2] * inv, o[rt][ds][3] * inv); *(v2u*)(og + 16 * ds + 4 * fq) = ov; }
        if (fq == 0) ((float*)(p.ws + WS_LSE))[((size_t)pat * M + grow) * 4 + h] = m_i[rt] + __logf(l_i[rt]);
    }
}

__device__ __forceinline__ void stick_unit(const Ctx& p, int u, LAS unsigned char* lds) {
    const int tid = opaque_tid(), lane = tid & 63, w = tid >> 6, fr = lane & 15, fq = lane >> 4;
    const int qb = 15 - (u >> 4), bh = u & 15, b = bh >> 2, h = bh & 3;
    LAS bf16* QH = (LAS bf16*)(lds + ATT_Q); LAS bf16* KH = (LAS bf16*)(lds + ATT_K); LAS bf16* VH = (LAS bf16*)(lds + ATT_V); LAS bf16* PL = (LAS bf16*)(lds + ATT_PL) + w * 32 * 72;
    volatile LAS int* vote = (volatile LAS int*)(lds + ATT_VOTE);
    const bf16* Qg = (const bf16*)(p.ws + WS_PACT) + SEG_SQ * SEG_STRIDE + h * HD; const bf16* Kg = (const bf16*)(p.ws + WS_PACT) + SEG_SK * SEG_STRIDE + h * HD;
    const bf16* Vg = (const bf16*)(p.ws + WS_PACT) + SEG_SV * SEG_STRIDE + h * HD;
    const float nogain[8] = {1.f, 1.f, 1.f, 1.f, 1.f, 1.f, 1.f, 1.f};
    const int ktop = 4 * qb + 3;
    v4u kr[2], vr[2];
    { v4u qr[8]; ld_rows<8>(qr, Qg, b * SEQ + qb * 256, 1, tid); ld_rows<2>(kr, Kg, b * SEQ + ktop * 64, 1, tid); ld_rows<2>(vr, Vg, b * SEQ + ktop * 64, 1, tid);
      st_rows<false, 8, 136>(QH, qr, nogain, tid); }
    if (tid < 8) vote[tid] = 0;
    __syncthreads();
    bf16x8 qf[2][4]; load_qfrags(qf, QH, w, lane);
    float R[2] = {0.f, 0.f}; f32x4 o[2][8];
#pragma unroll
    for (int rt = 0; rt < 2; ++rt)
#pragma unroll
        for (int ds = 0; ds < 8; ++ds) o[rt][ds] = (f32x4){0.f, 0.f, 0.f, 0.f};
    for (int kt = ktop; kt >= 0; --kt) {
        __syncthreads();
        { int all = 1;
#pragma unroll
          for (int i = 0; i < 8; ++i) all &= vote[i];
          if (all) break; }
        st_rows<false, 2, 136>(KH, kr, nogain, tid); st_rows<false, 2, 144>(VH, vr, nogain, tid);
        __syncthreads();
        if (kt > 0) { ld_rows<2>(kr, Kg, b * SEQ + (kt - 1) * 64, 1, tid); ld_rows<2>(vr, Vg, b * SEQ + (kt - 1) * 64, 1, tid); }
        if (64 * kt < 256 * qb + 32 * w + 31) {
            f32x4 s[2][4];
#pragma unroll
            for (int rt = 0; rt < 2; ++rt)
#pragma unroll
                for (int n = 0; n < 4; ++n) s[rt][n] = (f32x4){0.f, 0.f, 0.f, 0.f};
#pragma unroll
            for (int k = 0; k < 4; ++k)
#pragma unroll
                for (int n = 0; n < 4; ++n) { const bf16x8 kf = *(const LAS bf16x8*)(KH + (16 * n + fr) * 136 + 32 * k + 8 * fq);
                    s[0][n] = __builtin_amdgcn_mfma_f32_16x16x32_bf16(kf, qf[0][k], s[0][n], 0, 0, 0); s[1][n] = __builtin_amdgcn_mfma_f32_16x16x32_bf16(kf, qf[1][k], s[1][n], 0, 0, 0); }
#pragma unroll
            for (int rt = 0; rt < 2; ++rt) {
                const int qpos = 256 * qb + 32 * w + 16 * rt + fr; float carry = 0.f;
#pragma unroll
                for (int n = 3; n >= 0; --n) {
                    float lk[4], lsg[4];
#pragma unroll
                    for (int j = 0; j < 4; ++j) { const int key = 64 * kt + 16 * n + 4 * fq + j; const float z = s[rt][n][j] * KSCALE, sp = softplusf(z); lk[j] = key < qpos ? -sp : 0.f; lsg[j] = z - sp; }
                    const float s2 = lk[3], s1 = s2 + lk[2], s0 = s1 + lk[1], T = s0 + lk[0];
                    const float t1 = __shfl(T, (lane + 16) & 63), t2 = __shfl(T, (lane + 32) & 63), t3 = __shfl(T, (lane + 48) & 63);
                    const float base = (fq < 3 ? t1 : 0.f) + (fq < 2 ? t2 : 0.f) + (fq < 1 ? t3 : 0.f) + carry + R[rt];
                    const float suf[4] = {s0, s1, s2, 0.f};
                    float wv[4];
#pragma unroll
                    for (int j = 0; j < 4; ++j) { const int key = 64 * kt + 16 * n + 4 * fq + j; wv[j] = key < qpos ? __expf(lsg[j] + suf[j] + base) : 0.f; }
                    v2u pw; pw.x = pk2(wv[0], wv[1]); pw.y = pk2(wv[2], wv[3]);
                    *(LAS v2u*)(PL + (16 * rt + fr) * 72 + 16 * n + 4 * fq) = pw;
                    carry += (T + t1) + (t2 + t3);
                }
                R[rt] += carry;
            }
            asm volatile("" ::: "memory");
            bf16x8 pf[2][2];
#pragma unroll
            for (int rt = 0; rt < 2; ++rt) { pf[rt][0] = *(const LAS bf16x8*)(PL + (16 * rt + fr) * 72 + 8 * fq); pf[rt][1] = *(const LAS bf16x8*)(PL + (16 * rt + fr) * 72 + 32 + 8 * fq); }
#pragma unroll
            for (int ds = 0; ds < 8; ++ds) { const bf16x8 v0 = tr_frag(VH, 0, ds, lane), v1 = tr_frag(VH, 1, ds, lane);
#pragma unroll
                for (int rt = 0; rt < 2; ++rt) { o[rt][ds] = __builtin_amdgcn_mfma_f32_16x16x32_bf16(v0, pf[rt][0], o[rt][ds], 0, 0, 0); o[rt][ds] = __builtin_amdgcn_mfma_f32_16x16x32_bf16(v1, pf[rt][1], o[rt][ds], 0, 0, 0); } }
        }
        { const int done = __all(R[0] <= -104.0f && R[1] <= -104.0f); if (lane == 0) vote[w] = done; }
    }
#pragma unroll
    for (int rt = 0; rt < 2; ++rt) {
        bf16* og = (bf16*)(p.ws + WS_DOUT) + (size_t)(b * SEQ + 256 * qb + 32 * w + 16 * rt + fr) * GW + h * HD;
#pragma unroll
        for (int ds = 0; ds < 8; ++ds) { v2u ov; ov.x = pk2(o[rt][ds][0], o[rt][ds][1]); ov.y = pk2(o[rt][ds][2], o[rt][ds][3]); *(v2u*)(og + 16 * ds + 4 * fq) = ov; }
    }
}

__device__ __forceinline__ void finalize_unit(const Ctx& p, int l, int u, int un) {
    const int tid = opaque_tid(), lane = tid & 63, w = tid >> 6, hd = lane >> 4;
    const bf16* CP = (const bf16*)(p.ws + WS_CPART); const float* LSE = (const float*)(p.ws + WS_LSE); const bf16* DO = (const bf16*)(p.ws + WS_DOUT); bf16* mixed = (bf16*)(p.ws + WS_MIXED);
    const float* gc = p.in(18) + l * DM + 2 * GW + lane * 8; const float* gd = p.in(18) + l * DM + 3 * GW + lane * 8;
    float gcv[8], gdv[8];
#pragma unroll
    for (int e = 0; e < 8; ++e) { gcv[e] = gc[e]; gdv[e] = gd[e]; }
    for (int tb = 0; tb < 8; tb += 4) {
        v4u a[4], bq[4], cq[4], dv[4]; float l0[4], l1[4], l2[4];
#pragma unroll
        for (int tt = 0; tt < 4; ++tt) {
            const int grow = u * 64 + w * 8 + tb + tt;
            l0[tt] = LSE[((size_t)0 * M + grow) * 4 + hd]; l1[tt] = LSE[((size_t)1 * M + grow) * 4 + hd]; l2[tt] = LSE[((size_t)2 * M + grow) * 4 + hd];
            a[tt] = *(const v4u*)(CP + (size_t)grow * GW + lane * 8); bq[tt] = *(const v4u*)(CP + SEG_STRIDE + (size_t)grow * GW + lane * 8); cq[tt] = *(const v4u*)(CP + 2 * SEG_STRIDE + (size_t)grow * GW + lane * 8);
            dv[tt] = *(const v4u*)(DO + (size_t)grow * GW + lane * 8);
        }
#pragma unroll
        for (int tt = 0; tt < 4; ++tt) {
            const int grow = u * 64 + w * 8 + tb + tt;
            const float L = fmaxf(l0[tt], fmaxf(l1[tt], l2[tt])); float w0 = __expf(l0[tt] - L), w1 = __expf(l1[tt] - L), w2 = __expf(l2[tt] - L); const float inv = 1.0f / (w0 + w1 + w2); w0 *= inv; w1 *= inv; w2 *= inv;
            const unsigned aw[4] = {a[tt].x, a[tt].y, a[tt].z, a[tt].w}, bw[4] = {bq[tt].x, bq[tt].y, bq[tt].z, bq[tt].w}, cw[4] = {cq[tt].x, cq[tt].y, cq[tt].z, cq[tt].w};
            float f[8]; float ss = 0.f;
#pragma unroll
            for (int e = 0; e < 4; ++e) { f[2 * e] = w0 * bflo(aw[e]) + w1 * bflo(bw[e]) + w2 * bflo(cw[e]); f[2 * e + 1] = w0 * bfhi(aw[e]) + w1 * bfhi(bw[e]) + w2 * bfhi(cw[e]); ss += f[2 * e] * f[2 * e] + f[2 * e + 1] * f[2 * e + 1]; }
            ss = wave_sum(ss); float rs = __builtin_amdgcn_rsqf(ss * (1.0f / GW) + EPS);
            v4u ov; ov.x = pk2(f[0] * rs * gcv[0], f[1] * rs * gcv[1]); ov.y = pk2(f[2] * rs * gcv[2], f[3] * rs * gcv[3]); ov.z = pk2(f[4] * rs * gcv[4], f[5] * rs * gcv[5]); ov.w = pk2(f[6] * rs * gcv[6], f[7] * rs * gcv[7]);
            *(v4u*)(mixed + (size_t)grow * DM + 2 * GW + lane * 8) = ov;
            const unsigned dw[4] = {dv[tt].x, dv[tt].y, dv[tt].z, dv[tt].w};
            ss = 0.f;
#pragma unroll
            for (int e = 0; e < 4; ++e) { f[2 * e] = bflo(dw[e]); f[2 * e + 1] = bfhi(dw[e]); ss += f[2 * e] * f[2 * e] + f[2 * e + 1] * f[2 * e + 1]; }
            ss = wave_sum(ss); rs = __builtin_amdgcn_rsqf(ss * (1.0f / GW) + EPS);
            ov.x = pk2(f[0] * rs * gdv[0], f[1] * rs * gdv[1]); ov.y = pk2(f[2] * rs * gdv[2], f[3] * rs * gdv[3]); ov.z = pk2(f[4] * rs * gdv[4], f[5] * rs * gdv[5]); ov.w = pk2(f[6] * rs * gdv[6], f[7] * rs * gdv[7]);
            *(v4u*)(mixed + (size_t)grow * DM + 3 * GW + lane * 8) = ov;
        }
    }
}

#ifndef PROBE_REPEAT
#define PROBE_REPEAT 0
#endif
#define REP(k) for (int rep_ = 0; rep_ < (((PROBE_REPEAT) >> (k)) & 1) + 1; ++rep_)
__global__ void __launch_bounds__(NT, 2) fwd_kernel(Params kp) {
    extern __shared__ __attribute__((aligned(16))) unsigned char lds_raw[];
    LAS unsigned char* lds = (LAS unsigned char*)lds_raw;
    volatile LAS unsigned* MISC = (volatile LAS unsigned*)(lds + LDS_MISC_OFF);
    volatile LAS int* qslot = (volatile LAS int*)(MISC + 4);
    const int wid0 = __builtin_amdgcn_readfirstlane((int)threadIdx.x >> 6);
    if (threadIdx.x < 16) MISC[threadIdx.x] = 0u;
    __syncthreads();
    XcdBarrier bar; bar.bar = (unsigned*)(kp.ws + WS_CTL) + CW_BAR; bar.x = 0; bar.st = nullptr;
    if (!MK_SPLIT) bar = xcd_barrier_post((unsigned*)(kp.ws + WS_CTL) + CW_BAR, MISC);
    const int lo = kp.ph_lo, hi = kp.ph_hi;
#define IN(k) (lo <= (k) && (k) < hi)
#define SEAM(k) do { if (IN(k) && IN((k) + 1)) { if (!MK_SPLIT) xcd_barrier(bar); } } while (0)
#define CTX() const Ctx p = make_ctx(wid0); unsigned* ctl = (unsigned*)(p.ws + WS_CTL); unsigned long long* ssq = (unsigned long long*)(p.ws + WS_SSQ); bf16* xb = (bf16*)(p.ws + WS_XB); bf16* act = (bf16*)(p.ws + WS_PACT); bf16* mixed = (bf16*)(p.ws + WS_MIXED); \
    unsigned long long* ssqA = ssq + (size_t)(3 * l) * M; unsigned long long* ssqB = ssq + (size_t)(3 * l + 1) * M; unsigned long long* ssqC = ssq + (size_t)(3 * l + 2) * M; unsigned long long* ssqN = ssq + (size_t)(3 * l + 3) * M; \
    (void)ctl; (void)xb; (void)act; (void)mixed; (void)ssqA; (void)ssqB; (void)ssqC; (void)ssqN

    if (IN(0)) { const Ctx p = make_ctx(wid0); prologue_x(p); }
    for (int l = 0; l < NLAYER; ++l) {
        const int pb = 1 + l * PH_PER_LAYER;
        if (IN(pb + 0)) REP(0) { const Ctx p = make_ctx(wid0); convert_layer(p, l, -1); }
        SEAM(pb + 0);
        if (IN(pb + 1)) REP(4) { CTX(); if (rep_) xcd_barrier(bar);
            pg8::Gemm g{xb, (const bf16*)(p.ws + WS_WGU1), M, 2 * DFF, DM}; pg8::StaticOrder S; S.init(M, 2 * DFF, (int)gridDim.x, (int)blockIdx.x);
            pg8::EpiSwiglu E{act, DFF, ssqA, 1.0f / (DM * pg8::SSQ_FX)};
            pg8::gemm_phase<pg8::EpiSwiglu, pg8::StaticOrder, PG8_ALIGN, PG8_SP2>(lds, g, S, E, wid0);
        }
        SEAM(pb + 1);
#if (PROBE_REPEAT >> 6) & 1
        if (IN(pb + 2)) { CTX();
            pg8::Gemm g{act, (const bf16*)(p.ws + WS_WD1), M, DM, DFF}; pg8::StaticOrder S; S.init(M, DM, (int)gridDim.x, (int)blockIdx.x);
            pg8::EpiResid E{xb, nullptr, xb, nullptr, DM, 0.25f};
            pg8::gemm_phase<pg8::EpiResid, pg8::StaticOrder, PG8_ALIGN, PG8_SP2>(lds, g, S, E, wid0);
            xcd_barrier(bar);
        }
        if (IN(pb + 2)) { CTX();
            pg8::Gemm g{act, (const bf16*)(p.ws + WS_WD1), M, DM, DFF}; pg8::StaticOrder S; S.init(M, DM, (int)gridDim.x, (int)blockIdx.x);
            pg8::EpiResid E{xb, nullptr, xb, ssqB, DM, 0.25f};
            pg8::gemm_phase<pg8::EpiResid, pg8::StaticOrder, PG8_ALIGN, PG8_SP2>(lds, g, S, E, wid0);
        }
#else
        if (IN(pb + 2)) { CTX();
            pg8::Gemm g{act, (const bf16*)(p.ws + WS_WD1), M, DM, DFF}; pg8::StaticOrder S; S.init(M, DM, (int)gridDim.x, (int)blockIdx.x);
            pg8::EpiResid E{xb, nullptr, xb, ssqB, DM, 0.5f};
            pg8::gemm_phase<pg8::EpiResid, pg8::StaticOrder, PG8_ALIGN, PG8_SP2>(lds, g, S, E, wid0);
        }
#endif
        SEAM(pb + 2);
        if (IN(pb + 3)) REP(5) { CTX(); if (rep_) xcd_barrier(bar);
            pg8::Gemm g{xb, (const bf16*)(p.ws + WS_WIN), M, NP, DM}; pg8::StaticOrder S; S.init(M, NP, (int)gridDim.x, (int)blockIdx.x);
            pg8::EpiSplit E{act, SEG_STRIDE, ssqB, 1.0f / (DM * pg8::SSQ_FX)};
            pg8::gemm_phase<pg8::EpiSplit, pg8::StaticOrder, PG8_ALIGN, PG8_SP2>(lds, g, S, E, wid0);
            gates_phase(p, l, ssqB, lds);
        }
        SEAM(pb + 3);
        if (IN(pb + 4)) REP(1) { CTX(); if (rep_) xcd_barrier(bar);
            for (int u = (int)blockIdx.x; u < 768; u += (int)gridDim.x) { __syncthreads(); dilated_unit(p, l, u, lds); }
            for (int u = (int)blockIdx.x; u < 1024; u += (int)gridDim.x) { __syncthreads(); mlstm1_unit(p, l, u, u + (int)gridDim.x, lds); }
            for (int u = (int)blockIdx.x; u < 1024; u += (int)gridDim.x) { __syncthreads(); lru_unit<1>(p, l, u, u + (int)gridDim.x, lds); }
        }
        SEAM(pb + 4);
        if (IN(pb + 5)) REP(2) { CTX(); if (rep_) xcd_barrier(bar);
            unsigned* ctr = ctl + CW_Q + 64 * (pb + 5 + 32 * rep_);
            for (int u = q_next(p, ctr, qslot); u < 132 + 256; u = q_next(p, ctr, qslot)) {
                if (u < 4) lru_carry_unit(p, u);
                else if (u < 132) mlstm_scan_unit(p, u - 4);
                else stick_unit(p, u - 132, lds);
            }
        }
        SEAM(pb + 5);
        if (IN(pb + 6)) REP(3) { CTX(); if (rep_) xcd_barrier(bar);
            for (int u = (int)blockIdx.x; u < 1024; u += (int)gridDim.x) { __syncthreads(); mlstm3_unit(p, l, u, u + (int)gridDim.x, lds); }
            for (int u = (int)blockIdx.x; u < 1024; u += (int)gridDim.x) { __syncthreads(); lru_unit<3>(p, l, u, u + (int)gridDim.x, lds); }
            for (int u = (int)blockIdx.x; u < 256; u += (int)gridDim.x) { __syncthreads(); finalize_unit(p, l, u, u + (int)gridDim.x); }
        }
        SEAM(pb + 6);
#if (PROBE_REPEAT >> 7) & 1
        for (int xb_ = 0; xb_ < 20; ++xb_) xcd_barrier(bar);
#endif
        if (IN(pb + 7)) { CTX();
            pg8::Gemm g{mixed, (const bf16*)(p.ws + WS_WOUT), M, DM, DM}; pg8::StaticOrder S; S.init(M, DM, (int)gridDim.x, (int)blockIdx.x);
            pg8::EpiResid E{xb, nullptr, xb, ssqC, DM, 1.0f};
            pg8::gemm_phase<pg8::EpiResid, pg8::StaticOrder, PG8_ALIGN, PG8_SP2>(lds, g, S, E, wid0);
        }
        SEAM(pb + 7);
        if (IN(pb + 8)) { CTX();
            pg8::Gemm g{xb, (const bf16*)(p.ws + WS_WGU2), M, 2 * DFF, DM}; pg8::StaticOrder S; S.init(M, 2 * DFF, (int)gridDim.x, (int)blockIdx.x);
            pg8::EpiSwiglu E{act, DFF, ssqC, 1.0f / (DM * pg8::SSQ_FX)};
            pg8::gemm_phase<pg8::EpiSwiglu, pg8::StaticOrder, PG8_ALIGN, PG8_SP2>(lds, g, S, E, wid0);
        }
        SEAM(pb + 8);
        if (IN(pb + 9)) { CTX();
            pg8::Gemm g{act, (const bf16*)(p.ws + WS_WD2), M, DM, DFF}; pg8::StaticOrder S; S.init(M, DM, (int)gridDim.x, (int)blockIdx.x);
            const bool lastl = (l == NLAYER - 1);
            pg8::EpiResid E{xb, lastl ? p.out : nullptr, lastl ? nullptr : xb, lastl ? nullptr : ssqN, DM, 0.5f};
            pg8::gemm_phase<pg8::EpiResid, pg8::StaticOrder, PG8_ALIGN, PG8_SP2>(lds, g, S, E, wid0);
        }
        SEAM(pb + 9);
    }
#undef IN
#undef SEAM
#undef CTX
}

extern "C" void kernel_launch(void* const* d_in, const int* in_sizes, int n_in, void* d_out, int out_size, void* d_ws, size_t ws_size, hipStream_t stream) {
    static int grid = 0;
    if (grid == 0) {
        if (n_in != 24 || in_sizes[0] != M * DM || out_size != M * DM || ws_size < WS_END) { fprintf(stderr, "kernel_launch: unexpected shapes (n_in %d, in0 %d, out %d, ws %zu < %zu)\n", n_in, n_in > 0 ? in_sizes[0] : -1, out_size, ws_size, (size_t)WS_END); grid = -1; return; }
        int dev = 0, cus = 0, per_cu = 0;
        if (hipGetDevice(&dev) != hipSuccess || hipDeviceGetAttribute(&cus, hipDeviceAttributeMultiprocessorCount, dev) != hipSuccess) { grid = -1; return; }
        if (hipFuncSetAttribute((const void*)fwd_kernel, hipFuncAttributeMaxDynamicSharedMemorySize, LDS_BYTES) != hipSuccess) { fprintf(stderr, "kernel_launch: hipFuncSetAttribute failed\n"); grid = -1; return; }
        if (hipOccupancyMaxActiveBlocksPerMultiprocessor(&per_cu, (const void*)fwd_kernel, NT, LDS_BYTES) != hipSuccess || per_cu < 1) { fprintf(stderr, "kernel_launch: occupancy query says %d\n", per_cu); (void)hipGetLastError(); }
        grid = cus;
    }
    if (grid < 0) return;
    (void)hipMemsetAsync((char*)d_ws + WS_CTL, 0, CTL_ZERO_BYTES, stream);
    Params a{};
    for (int i = 0; i < 24; ++i) a.in[i] = (const float*)d_in[i];
    a.out = (float*)d_out; a.ws = (unsigned char*)d_ws;
#if MK_SPLIT
    for (int ph = 0; ph < N_PHASES; ++ph) { a.ph_lo = ph; a.ph_hi = ph + 1; hipLaunchKernelGGL(fwd_kernel, dim3(grid), dim3(NT), LDS_BYTES, stream, a); }
#else
    a.ph_lo = 0; a.ph_hi = N_PHASES;
    hipLaunchKernelGGL(fwd_kernel, dim3(grid), dim3(NT), LDS_BYTES, stream, a);
#endif
}
```

```cpp
#include <hip/hip_runtime.h>
#include <cstdio>
#include <cstdint>
#define LAS __attribute__((address_space(3)))
namespace pg8 {
#define PG8_LAS __attribute__((address_space(3)))
typedef unsigned short bf16_t;
typedef short bf16x8 __attribute__((ext_vector_type(8)));
typedef float f32x4 __attribute__((ext_vector_type(4)));
typedef unsigned u32x4 __attribute__((ext_vector_type(4)));
constexpr int BM = 256, BK = 64, HALF = 128, HTB = HALF * BK * 2  , STAGE_BYTES = 8 * HTB, NXCD = 8, WGM = 4;

__host__ __device__ __forceinline__ int lds_byte(int r, int c) { const int st = (r >> 4) * 2 + (c >> 5), rr = r & 15, cc = c & 31, ob = rr * 64 + cc * 2; return st * 1024 + (ob ^ (((ob >> 9) & 1) << 5)); }
__host__ __device__ __forceinline__ void stage_rc(int b, int& R, int& C) { const int st = b / 1024, sb = b % 1024, swz = sb ^ (((sb >> 9) & 1) << 5); R = (st >> 1) * 16 + swz / 64; C = (st & 1) * 32 + (swz % 64) / 2; }
__host__ __device__ __forceinline__ int perm32(int rho) { const int n = rho >> 4, i = rho & 15; return 8 * (i >> 2) + 4 * n + (i & 3); }

struct Unit { int pm, pn; };
struct Gemm { const bf16_t* A; const bf16_t* Bt; int M, N, K, rot; };

struct StaticOrder {
    int nM, nN, nwg, G, c;
    __host__ __device__ void init(int M, int N, int G_, int c_) { nM = M / BM; nN = N / BM; nwg = nM * nN; G = G_; c = c_; }
    __host__ __device__ bool next(int i, Unit& u) const {
        const long L = (long)i * G + c; if (L >= nwg) return false;
        int wgid = (int)L; { const int q = nwg / NXCD, r = nwg % NXCD, xcd = wgid % NXCD, off = wgid / NXCD; wgid = (xcd < r ? xcd * (q + 1) : r * (q + 1) + (xcd - r) * q) + off; }
        const int nig = WGM * nN, gid = wgid / nig, fm = gid * WGM, gsz = (nM - fm) < WGM ? (nM - fm) : WGM;
        u.pm = fm + ((wgid % nig) % gsz); u.pn = (wgid % nig) / gsz; return true;
    }
    __device__ __forceinline__ void a_ready(const Unit&) const {}
    __device__ __forceinline__ void done(const Unit&) const {}
};

__device__ __forceinline__ unsigned cvt_pk_bf16(float lo, float hi) { unsigned r; asm volatile("v_cvt_pk_bf16_f32 %0, %1, %2" : "=v"(r) : "v"(lo), "v"(hi)); return r; }

typedef float f32x2 __attribute__((ext_vector_type(2)));
constexpr float RMS_EPS_F = 1e-6f, SSQ_FX = 1048576.0f;
struct EpiSwiglu {
    static constexpr bool PERM = true, AFTER_DRAIN = false;
    bf16_t* O; int ldc; const unsigned long long* ssq; float inv_d;
    __device__ __forceinline__ void operator()(const f32x4 (&acc)[2][2][4][2], const Unit& u, int wr, int wc, int fr, int fq) const {
        const int row0 = u.pm * BM + wr * 64 + fr, col0 = u.pn * HALF + wc * 32 + 8 * fq;
#pragma unroll
        for (int ai = 0; ai < 2; ++ai)
#pragma unroll
            for (int m = 0; m < 4; ++m) {
                const int row = row0 + ai * HALF + m * 16;
                const float rs = __builtin_amdgcn_rsqf((float)ssq[row] * inv_d + RMS_EPS_F);
                const f32x2 ce = {-rs * 1.4426950408889634f, -rs * 1.4426950408889634f}, c2 = {rs * rs, rs * rs}, one = {1.0f, 1.0f};
                unsigned wv[4];
#pragma unroll
                for (int n = 0; n < 2; ++n)
#pragma unroll
                    for (int hh = 0; hh < 2; ++hh) {
                        const f32x2 g = {acc[ai][0][m][n][2 * hh], acc[ai][0][m][n][2 * hh + 1]}, up = {acc[ai][1][m][n][2 * hh], acc[ai][1][m][n][2 * hh + 1]};
                        const f32x2 a = g * ce; f32x2 e; e.x = __builtin_amdgcn_exp2f(a.x); e.y = __builtin_amdgcn_exp2f(a.y);
                        const f32x2 d = e + one; f32x2 r; r.x = __builtin_amdgcn_rcpf(d.x); r.y = __builtin_amdgcn_rcpf(d.y);
                        const f32x2 v = ((g * up) * c2) * r;
                        wv[n * 2 + hh] = cvt_pk_bf16(v.x, v.y);
                    }
                u32x4 w; w.x = wv[0]; w.y = wv[1]; w.z = wv[2]; w.w = wv[3];
                *(u32x4*)(O + (size_t)row * ldc + col0) = w;
            }
    }
};
struct EpiResid {
    static constexpr bool PERM = false, AFTER_DRAIN = false;
    const bf16_t* base; float* out; bf16_t* xb; unsigned long long* ssq; int ldc; float alpha;
    __device__ __forceinline__ void operator()(const f32x4 (&acc)[2][2][4][2], const Unit& u, int wr, int wc, int fr, int fq) const {
        typedef unsigned u32x2v __attribute__((ext_vector_type(2)));
        const int row0 = u.pm * BM + wr * 64 + fr, col0 = u.pn * BM + wc * 32 + 4 * fq;
#pragma unroll
        for (int ai = 0; ai < 2; ++ai) {
            u32x2v b4[4][2][2];
#pragma unroll
            for (int m = 0; m < 4; ++m)
#pragma unroll
                for (int bj = 0; bj < 2; ++bj)
#pragma unroll
                    for (int n = 0; n < 2; ++n) b4[m][bj][n] = *(const u32x2v*)(base + (size_t)(row0 + ai * HALF + m * 16) * ldc + col0 + bj * HALF + n * 16);
#pragma unroll
            for (int m = 0; m < 4; ++m) {
                const int row = row0 + ai * HALF + m * 16; const size_t off = (size_t)row * ldc + col0; float s = 0.f;
#pragma unroll
                for (int bj = 0; bj < 2; ++bj)
#pragma unroll
                    for (int n = 0; n < 2; ++n) {
                        const u32x2v bb = b4[m][bj][n];
                        const f32x4 bf = {__builtin_bit_cast(float, bb.x << 16), __builtin_bit_cast(float, bb.x & 0xffff0000u), __builtin_bit_cast(float, bb.y << 16), __builtin_bit_cast(float, bb.y & 0xffff0000u)};
                        const f32x4 o = bf + acc[ai][bj][m][n] * alpha;
                        if (out) *(f32x4*)(out + off + bj * HALF + n * 16) = o;
                        if (xb) { u32x2v w; w.x = cvt_pk_bf16(o[0], o[1]); w.y = cvt_pk_bf16(o[2], o[3]); *(u32x2v*)(xb + off + bj * HALF + n * 16) = w; }
                        s += (o[0] * o[0] + o[1] * o[1]) + (o[2] * o[2] + o[3] * o[3]);
                    }
                if (ssq) { s += __shfl_xor(s, 16); s += __shfl_xor(s, 32); if (fq == 0) atomicAdd(ssq + row, (unsigned long long)(s * SSQ_FX + 0.5f)); }
            }
            asm volatile("" ::: "memory");
        }
    }
};
struct EpiSplit {
    static constexpr bool PERM = true, AFTER_DRAIN = false;
    bf16_t* O; size_t seg_stride; const unsigned long long* ssq; float inv_d;
    __device__ __forceinline__ void operator()(const f32x4 (&acc)[2][2][4][2], const Unit& u, int wr, int wc, int fr, int fq) const {
        const int colt = u.pn * BM, seg = colt >> 9, cin = colt & 511;
        bf16_t* base = O + (size_t)seg * seg_stride;
        const int row0 = u.pm * BM + wr * 64 + fr, col0 = cin + wc * 32 + 8 * fq;
#pragma unroll
        for (int ai = 0; ai < 2; ++ai)
#pragma unroll
            for (int m = 0; m < 4; ++m) {
                const int row = row0 + ai * HALF + m * 16;
                const float rs = __builtin_amdgcn_rsqf((float)ssq[row] * inv_d + RMS_EPS_F);
#pragma unroll
                for (int bj = 0; bj < 2; ++bj) {
                    const f32x4 v0 = acc[ai][bj][m][0] * rs, v1 = acc[ai][bj][m][1] * rs;
                    u32x4 w; w.x = cvt_pk_bf16(v0[0], v0[1]); w.y = cvt_pk_bf16(v0[2], v0[3]); w.z = cvt_pk_bf16(v1[0], v1[1]); w.w = cvt_pk_bf16(v1[2], v1[3]);
                    *(u32x4*)(base + (size_t)row * 512 + col0 + bj * HALF) = w;
                }
            }
    }
};
template <class Epi, class Sched, bool ALIGN_EPI = false, bool SP2 = false>
__device__ __forceinline__ void gemm_phase(PG8_LAS unsigned char* lds, const Gemm g, const Sched& S, const Epi& E, int wid0) {
    int tid_ = (wid0 << 6) | (int)__builtin_amdgcn_mbcnt_hi(~0u, __builtin_amdgcn_mbcnt_lo(~0u, 0u)); asm volatile("" : "+v"(tid_));
    const int tid = tid_, wid = __builtin_amdgcn_readfirstlane(tid >> 6), lane = tid & 63, wr = wid >> 2, wc = wid & 3, fr = lane & 15, fq = lane >> 4;
    const int K = g.K, nt = K / BK;
    const int rot = g.rot; const size_t rotoff = (size_t)rot * (size_t)(BK * 2);
    unsigned voffA[2], voffB[2];
#pragma unroll
    for (int i = 0; i < 2; ++i) { int R, C; stage_rc(tid * 16 + i * 8192, R, C); const int Rb = Epi::PERM ? ((R & ~31) + perm32(R & 31)) : R;
        voffA[i] = (unsigned)(R * K + C) * 2u; voffB[i] = (unsigned)(Rb * K + C) * 2u; }
    const size_t kstep = (size_t)(BK * 2);
    const size_t hstep = (size_t)HALF * K * 2;
    const size_t tstep = 2 * hstep;
    const unsigned ldsw = (unsigned)wid * 1024u;
    const int aoff = lds_byte(wr * 64 + fr, fq * 8), boff = lds_byte(wc * 32 + fr, fq * 8);
#define PG8_SA(b, h) (((b) * 2 + (h)) * HTB)
#define PG8_SB(b, h) ((4 + (b) * 2 + (h)) * HTB)
#define PG8_STAGE(bufoff, gbase, voff) do { _Pragma("unroll") for (int _i = 0; _i < 2; ++_i) \
        __builtin_amdgcn_global_load_lds((const unsigned*)((const char*)(gbase) + (voff)[_i]), (PG8_LAS unsigned*)(lds + (bufoff) + ldsw + _i * 8192), 16, 0, 0); } while (0)
#define PG8_LDA(dst, b, h) do { _Pragma("unroll") for (int m = 0; m < 4; ++m) _Pragma("unroll") for (int k = 0; k < 2; ++k) dst[m][k] = *(const PG8_LAS bf16x8*)(lds + PG8_SA(b, h) + aoff + m * 2048 + k * 1024); } while (0)
#define PG8_LDB(dst, b, h) do { _Pragma("unroll") for (int n = 0; n < 2; ++n) _Pragma("unroll") for (int k = 0; k < 2; ++k) dst[n][k] = *(const PG8_LAS bf16x8*)(lds + PG8_SB(b, h) + boff + n * 2048 + k * 1024); } while (0)
#define PG8_MMA(ai, bj, At, Bt) do { __builtin_amdgcn_s_setprio(1); _Pragma("unroll") for (int m = 0; m < 4; ++m) _Pragma("unroll") for (int n = 0; n < 2; ++n) _Pragma("unroll") for (int k = 0; k < 2; ++k) \
        acc[ai][bj][m][n] = __builtin_amdgcn_mfma_f32_16x16x32_bf16(Bt[n][k], At[m][k], acc[ai][bj][m][n], 0, 0, 0); __builtin_amdgcn_s_setprio(0); } while (0)
#define PG8_WAIT_V(n) asm volatile("s_waitcnt vmcnt(" #n ")" ::: "memory")
#define PG8_WAIT_L(n) asm volatile("s_waitcnt lgkmcnt(" #n ")" ::: "memory")
#define PG8_BAR __builtin_amdgcn_s_barrier()
#define PG8_SCHED __builtin_amdgcn_sched_barrier(0)
    Unit cur, nxt; int ui = 0;
    if (!S.next(0, cur)) return;
    f32x4 acc[2][2][4][2];
#pragma unroll
    for (int a = 0; a < 2; ++a)
#pragma unroll
        for (int b = 0; b < 2; ++b)
#pragma unroll
            for (int m = 0; m < 4; ++m)
#pragma unroll
                for (int n = 0; n < 2; ++n) acc[a][b][m][n] = (f32x4){0.f, 0.f, 0.f, 0.f};
    bf16x8 At[4][2], B0[2][2], B1[2][2];
    const char* cA = (const char*)g.A + (size_t)cur.pm * tstep; const char* cB = (const char*)g.Bt + (size_t)cur.pn * tstep;
    S.a_ready(cur);
    if constexpr (SP2) {
        PG8_STAGE(PG8_SB(0, 0), cB + rotoff, voffB); PG8_STAGE(PG8_SB(0, 1), cB + rotoff + hstep, voffB); PG8_STAGE(PG8_SA(0, 0), cA + rotoff, voffA); PG8_STAGE(PG8_SA(0, 1), cA + rotoff + hstep, voffA);
        if (wr == 1) PG8_BAR;
        PG8_WAIT_V(2); PG8_BAR;
        PG8_STAGE(PG8_SB(1, 0), cB + rotoff + kstep, voffB); PG8_STAGE(PG8_SA(1, 0), cA + rotoff + kstep, voffA); PG8_STAGE(PG8_SB(1, 1), cB + rotoff + hstep + kstep, voffB);
        PG8_WAIT_V(6); PG8_BAR;
    } else {
        PG8_STAGE(PG8_SB(0, 0), cB + rotoff, voffB); PG8_STAGE(PG8_SA(0, 0), cA + rotoff, voffA); PG8_STAGE(PG8_SB(0, 1), cB + rotoff + hstep, voffB); PG8_STAGE(PG8_SA(0, 1), cA + rotoff + hstep, voffA);
        if (wr == 1) PG8_BAR;
        PG8_WAIT_V(4); PG8_BAR;
        PG8_STAGE(PG8_SB(1, 0), cB + rotoff + kstep, voffB); PG8_STAGE(PG8_SA(1, 0), cA + rotoff + kstep, voffA); PG8_STAGE(PG8_SB(1, 1), cB + rotoff + hstep + kstep, voffB);
        PG8_WAIT_V(6); PG8_BAR;
    }
    for (;;) {
        const bool has_next = S.next(ui + 1, nxt);
        const char* nA = has_next ? (const char*)g.A + (size_t)nxt.pm * tstep : cA; const char* nB = has_next ? (const char*)g.Bt + (size_t)nxt.pn * tstep : cB;
        for (int t = 0; t < nt; t += 2) {
            const bool last = (t == nt - 2);
            int pt = t + rot; if (pt >= nt) pt -= nt; int pt2 = pt + 2; if (pt2 >= nt) pt2 -= nt;
            const char* a1 = cA + (size_t)(pt + 1) * kstep;
            const char* a2 = last ? nA + rotoff : cA + (size_t)pt2 * kstep; const char* b2 = last ? nB + rotoff : cB + (size_t)pt2 * kstep;
            const char* a3 = a2 + kstep; const char* b3 = b2 + kstep;
            if (last && has_next) S.a_ready(nxt);
            if constexpr (SP2) {
            PG8_LDB(B0, 0, 0); PG8_LDB(B1, 0, 1); PG8_SCHED; PG8_LDA(At, 0, 0); PG8_STAGE(PG8_SA(1, 1), a1 + hstep, voffA);
            PG8_WAIT_V(8); PG8_WAIT_L(0); PG8_BAR; PG8_MMA(0, 0, At, B0); PG8_MMA(0, 1, At, B1); PG8_BAR; PG8_SCHED;
            PG8_LDA(At, 0, 1); PG8_STAGE(PG8_SB(0, 0), b2, voffB); PG8_STAGE(PG8_SB(0, 1), b2 + hstep, voffB); PG8_STAGE(PG8_SA(0, 0), a2, voffA);
            PG8_WAIT_V(8); PG8_WAIT_L(0); PG8_BAR; PG8_MMA(1, 0, At, B0); PG8_MMA(1, 1, At, B1); PG8_BAR; PG8_SCHED;
            PG8_LDB(B0, 1, 0); PG8_LDB(B1, 1, 1); PG8_SCHED; PG8_LDA(At, 1, 0); PG8_STAGE(PG8_SA(0, 1), a2 + hstep, voffA);
            PG8_WAIT_V(8); PG8_WAIT_L(0); PG8_BAR; PG8_MMA(0, 0, At, B0); PG8_MMA(0, 1, At, B1); PG8_BAR; PG8_SCHED;
            PG8_LDA(At, 1, 1); PG8_STAGE(PG8_SB(1, 0), b3, voffB); PG8_STAGE(PG8_SB(1, 1), b3 + hstep, voffB); PG8_STAGE(PG8_SA(1, 0), a3, voffA);
            PG8_WAIT_V(8); PG8_WAIT_L(0); PG8_BAR; PG8_MMA(1, 0, At, B0); PG8_MMA(1, 1, At, B1); PG8_BAR; PG8_SCHED;
            } else {
            PG8_LDB(B0, 0, 0); PG8_SCHED; PG8_LDA(At, 0, 0); PG8_STAGE(PG8_SA(1, 1), a1 + hstep, voffA);
            PG8_WAIT_L(8); PG8_BAR; PG8_WAIT_L(0); PG8_MMA(0, 0, At, B0); PG8_BAR; PG8_SCHED;
            PG8_LDB(B1, 0, 1); PG8_STAGE(PG8_SB(0, 0), b2, voffB);
            PG8_BAR; PG8_WAIT_L(0); PG8_MMA(0, 1, At, B1); PG8_BAR;
            PG8_LDA(At, 0, 1); PG8_STAGE(PG8_SA(0, 0), a2, voffA);
            PG8_BAR; PG8_WAIT_L(0); PG8_MMA(1, 0, At, B0); PG8_BAR; PG8_SCHED;
            PG8_STAGE(PG8_SB(0, 1), b2 + hstep, voffB);
            PG8_WAIT_V(6); PG8_BAR; PG8_MMA(1, 1, At, B1); PG8_BAR;
            PG8_LDB(B0, 1, 0); PG8_SCHED; PG8_LDA(At, 1, 0); PG8_STAGE(PG8_SA(0, 1), a2 + hstep, voffA);
            PG8_WAIT_L(8); PG8_BAR; PG8_WAIT_L(0); PG8_MMA(0, 0, At, B0); PG8_BAR; PG8_SCHED;
            PG8_LDB(B1, 1, 1); PG8_STAGE(PG8_SB(1, 0), b3, voffB);
            PG8_BAR; PG8_WAIT_L(0); PG8_MMA(0, 1, At, B1); PG8_BAR;
            PG8_LDA(At, 1, 1); PG8_STAGE(PG8_SA(1, 0), a3, voffA);
            PG8_BAR; PG8_WAIT_L(0); PG8_MMA(1, 0, At, B0); PG8_BAR; PG8_SCHED;
            PG8_STAGE(PG8_SB(1, 1), b3 + hstep, voffB);
            PG8_WAIT_V(6); PG8_BAR; PG8_MMA(1, 1, At, B1); PG8_BAR;
            }
        }
        if constexpr (ALIGN_EPI) { if (wr == 0) PG8_BAR; }
        if constexpr (!Epi::AFTER_DRAIN) { E(acc, cur, wr, wc, fr, fq); S.done(cur); }
        if (!has_next) break;
#pragma unroll
        for (int a = 0; a < 2; ++a)
#pragma unroll
            for (int b = 0; b < 2; ++b)
#pragma unroll
                for (int m = 0; m < 4; ++m)
#pragma unroll
                    for (int n = 0; n < 2; ++n) acc[a][b][m][n] = (f32x4){0.f, 0.f, 0.f, 0.f};
        cur = nxt; cA = nA; cB = nB; ++ui;
        if constexpr (ALIGN_EPI) { if (wr == 1) PG8_BAR; }
    }
    PG8_WAIT_V(0);
    if constexpr (!ALIGN_EPI) { if (wr == 0) PG8_BAR; }
    PG8_BAR;
    if constexpr (Epi::AFTER_DRAIN) { E.fused(acc, cur, wr, wc, fr, fq, lds, wid, lane); S.done(cur); }
#undef PG8_SA
#undef PG8_SB
#undef PG8_STAGE
#undef PG8_LDA
#undef PG8_LDB
#undef PG8_MMA
#undef PG8_WAIT_V
#undef PG8_WAIT_L
#undef PG8_BAR
#undef PG8_SCHED
}
}
#define XB_TMO      128
#define XB_XCNT(j)  (256  + 64 * (j))
#define XB_XSUB(j)  (1280 + 64 * (j))
#define XB_XGEN(j)  (2304 + 64 * (j))
#define XB_TOP      3328
#define XB_TOPGEN   3392
#define XCD_BAR_WORDS 3456
#define XB_SPIN_CAP (1u << 18)

__device__ __forceinline__ unsigned xb_ld(unsigned* p)              { return __hip_atomic_load(p, __ATOMIC_RELAXED, __HIP_MEMORY_SCOPE_AGENT); }
__device__ __forceinline__ unsigned xb_add(unsigned* p, unsigned v) { return __hip_atomic_fetch_add(p, v, __ATOMIC_RELAXED, __HIP_MEMORY_SCOPE_AGENT); }
__device__ __forceinline__ unsigned xb_xcc_id() { return (unsigned)__builtin_amdgcn_s_getreg((3 << 11) | 20) & 0xFu; }
#define XB_SPIN(cond, bar) do { unsigned _sp = 0; while (cond) { __builtin_amdgcn_s_sleep(1); \
    if ((++_sp & 255u) == 0u) { if (xb_ld(&(bar)[XB_TMO])) break; if (_sp > XB_SPIN_CAP) { atomicAdd(&(bar)[XB_TMO], 1u); break; } } } } while (0)

struct XcdBarrier {
    unsigned* bar; unsigned x;
    volatile LAS unsigned* st;
};

__device__ __forceinline__ XcdBarrier xcd_barrier_post(unsigned* bar, volatile LAS unsigned* st) {
    XcdBarrier b; b.bar = bar; b.x = xb_xcc_id(); b.st = st;
    if (threadIdx.x == 0) (void)xb_add(&bar[XB_XCNT(b.x)], 1u);
    return b;
}
__device__ __forceinline__ void xcd_barrier_complete(unsigned* bar, unsigned x, unsigned& nloc, unsigned& nx) {
    const unsigned G = gridDim.x * gridDim.y * gridDim.z;
    unsigned sum, cnt, mine, sp = 0u;
    for (;;) {
        sum = 0u; cnt = 0u; mine = 0u;
#pragma unroll
        for (unsigned j = 0; j < 16; ++j) { const unsigned c = xb_ld(&bar[XB_XCNT(j)]); sum += c; cnt += (c > 0u) ? 1u : 0u; mine = (j == x) ? c : mine; }
        if (sum == G) break;
        __builtin_amdgcn_s_sleep(1);
        if ((++sp & 255u) == 0u) { if (xb_ld(&bar[XB_TMO])) break; if (sp > XB_SPIN_CAP) { atomicAdd(&bar[XB_TMO], 1u); break; } }
    }
    nloc = mine > 0u ? mine : 1u; nx = cnt > 0u ? cnt : 1u;
}

__device__ __forceinline__ void xcd_barrier(const XcdBarrier& b) {
    asm volatile("s_waitcnt vmcnt(0)" ::: "memory");
    __syncthreads();
    if (threadIdx.x == 0) {
        unsigned* bar = b.bar;
        __builtin_amdgcn_s_waitcnt(0);
        unsigned nloc = b.st[0], nx = b.st[1];
        if (nloc == 0u) { xcd_barrier_complete(bar, b.x, nloc, nx); b.st[0] = nloc; b.st[1] = nx; }
        const unsigned old = xb_add(&bar[XB_XSUB(b.x)], 1u);
        const unsigned gen = old / nloc;
        if (old + 1u == (gen + 1u) * nloc) {
            __builtin_amdgcn_fence(__ATOMIC_RELEASE, "agent");
            asm volatile("s_waitcnt vmcnt(0)" ::: "memory");
            const unsigned og = xb_add(&bar[XB_TOP], 1u);
            const unsigned tg = og / nx;
            if (og + 1u == (tg + 1u) * nx) xb_add(&bar[XB_TOPGEN], 1u);
            else XB_SPIN(xb_ld(&bar[XB_TOPGEN]) == tg, bar);
            __builtin_amdgcn_fence(__ATOMIC_ACQUIRE, "agent");
            xb_add(&bar[XB_XGEN(b.x)], 1u);
            asm volatile("s_waitcnt vmcnt(0)" ::: "memory");
        } else {
            XB_SPIN(xb_ld(&bar[XB_XGEN(b.x)]) == gen, bar);
            __builtin_amdgcn_fence(__ATOMIC_ACQUIRE, "agent");
            asm volatile("s_waitcnt vmcnt(0)" ::: "memory");
        }
    }
    __syncthreads();
}

#ifndef PG8_SP2
#define PG8_SP2 true
#endif
#ifndef PG8_ALIGN
#define PG8_ALIGN true
#endif
#ifndef MK_SPLIT
#define MK_SPLIT 0
#endif

constexpr int DM = 2048, NBATCH = 4, SEQ = 4096, NLAYER = 2, M = NBATCH * SEQ, GW = 512, HD = 128, NH = 4, DFF = 5504, DIN = 6152, NP = 6144;
constexpr int NT = 512, NWAVES = 8;
constexpr float EPS = 1e-6f, KSCALE = 0.08838834764831845f;
constexpr int PH_PER_LAYER = 10, N_PHASES = 1 + NLAYER * PH_PER_LAYER;

constexpr size_t MiB = 1u << 20, KiB = 1024;
constexpr size_t WS_CTL = 0, CTL_ZERO_BYTES = 2 * MiB;
constexpr int CW_BAR = 4096, CW_Q = 8192;
constexpr size_t WS_SSQ = 1 * MiB;
constexpr size_t WS_G = 2 * MiB;
constexpr size_t WS_BLAST = 2560 * KiB, WS_MLOC = WS_BLAST + 4096, WS_MRUN = WS_MLOC + 4096;
constexpr size_t WS_DN = 3 * MiB, WS_NST = 3 * MiB + 512 * KiB;
constexpr size_t WS_LSE = 5 * MiB + 512 * KiB;
constexpr size_t WS_LRUW = 7 * MiB;
constexpr size_t WS_WGU1 = 8 * MiB, WS_WD1 = 52 * MiB, WS_WIN = 74 * MiB, WS_WOUT = 98 * MiB, WS_WGU2 = 106 * MiB, WS_WD2 = 149 * MiB;
constexpr size_t WS_XB = 171 * MiB;
constexpr size_t WS_PACT = 235 * MiB;
constexpr size_t WS_MIXED = 427 * MiB;
constexpr size_t WS_DCT = 491 * MiB;
constexpr size_t WS_CST = 555 * MiB;
constexpr size_t WS_CPART = 587 * MiB;
constexpr size_t WS_DOUT = 635 * MiB;
constexpr size_t WS_LAP = 651 * MiB, WS_LHE = 653 * MiB, WS_LCI = 655 * MiB;
constexpr size_t WS_END = 657 * MiB;
static_assert(WS_WGU1 + (size_t)2 * DFF * DM * 2 <= WS_WD1 && WS_WD1 + (size_t)DM * DFF * 2 <= WS_WIN && WS_WIN + (size_t)NP * DM * 2 <= WS_WOUT && WS_WOUT + (size_t)DM * DM * 2 <= WS_WGU2 &&
              WS_WGU2 + (size_t)2 * DFF * DM * 2 <= WS_WD2 && WS_WD2 + (size_t)DM * DFF * 2 <= WS_XB && WS_PACT + (size_t)M * DFF * 2 <= WS_MIXED && WS_PACT + (size_t)12 * M * 512 * 2 <= WS_MIXED, "ws map");
constexpr size_t SEG_STRIDE = (size_t)M * 512;
enum { SEG_LX = 0, SEG_LG, SEG_MQ, SEG_MK, SEG_MV, SEG_MO, SEG_CQ, SEG_CK, SEG_CV, SEG_SQ, SEG_SK, SEG_SV };

constexpr int LDS_MISC_OFF = 152 * 1024, LDS_BYTES = LDS_MISC_OFF + 64;

typedef unsigned short bf16;
typedef short bf16x8 __attribute__((ext_vector_type(8)));
typedef float f32x4 __attribute__((ext_vector_type(4)));
typedef unsigned v4u __attribute__((ext_vector_type(4)));
typedef unsigned v2u __attribute__((ext_vector_type(2)));
typedef float f32x2 __attribute__((ext_vector_type(2)));
__device__ __forceinline__ int opaque_tid_w(int wid) { int t = (wid << 6) | (int)__builtin_amdgcn_mbcnt_hi(~0u, __builtin_amdgcn_mbcnt_lo(~0u, 0u)); asm volatile("" : "+v"(t)); return t; }
#define opaque_tid() opaque_tid_w(p.wid)
#define LDS_WAIT() asm volatile("s_waitcnt lgkmcnt(0)" ::: "memory")
__device__ __forceinline__ unsigned f2bf(float f) { unsigned u = __builtin_bit_cast(unsigned, f); return (u + 0x7fffu + ((u >> 16) & 1u)) >> 16; }
__device__ __forceinline__ unsigned pk2(float lo, float hi) { return f2bf(lo) | (f2bf(hi) << 16); }
__device__ __forceinline__ float bf2f(unsigned b) { return __builtin_bit_cast(float, b << 16); }
__device__ __forceinline__ float bflo(unsigned w) { return __builtin_bit_cast(float, w << 16); }
__device__ __forceinline__ float bfhi(unsigned w) { return __builtin_bit_cast(float, w & 0xffff0000u); }
__device__ __forceinline__ float wave_sum(float v) {
#pragma unroll
    for (int o = 1; o < 64; o <<= 1) v += __shfl_xor(v, o);
    return v;
}
__device__ __forceinline__ float wave_max(float v) {
#pragma unroll
    for (int o = 1; o < 64; o <<= 1) v = fmaxf(v, __shfl_xor(v, o));
    return v;
}
__device__ __forceinline__ float softplusf(float x) { return fmaxf(x, 0.f) + __logf(1.0f + __expf(-fabsf(x))); }
__device__ __forceinline__ float sigmoidf(float x) { return 1.0f / (1.0f + __expf(-x)); }
__device__ __forceinline__ float gelu_tanh(float x) { const float y = 0.7978845608028654f * (x + 0.044715f * x * x * x); const float t = 1.0f - 2.0f / (1.0f + __expf(2.0f * y)); return 0.5f * x * (1.0f + t); }
template <int K> __device__ __forceinline__ void mma_lds(f32x4& acc, const LAS bf16* X, int ldx, const LAS bf16* Y, int ldy, int lane) {
    const LAS bf16* xp = X + (lane & 15) * ldx + (lane >> 4) * 8;
    const LAS bf16* yp = Y + (lane & 15) * ldy + (lane >> 4) * 8;
#pragma unroll
    for (int k = 0; k < K; k += 32) {
        const bf16x8 a = *(const LAS bf16x8*)(xp + k), b = *(const LAS bf16x8*)(yp + k);
        acc = __builtin_amdgcn_mfma_f32_16x16x32_bf16(a, b, acc, 0, 0, 0);
    }
}

typedef short v4i16_t __attribute__((ext_vector_type(4)));
__device__ __forceinline__ bf16x8 tr_frag(const LAS bf16* T, int ks, int c, int lane) {
    const LAS bf16* a0 = T + (32 * ks + 8 * (lane >> 4) + ((lane & 15) >> 2)) * 144 + 16 * c + 4 * (lane & 3);
    const v4i16_t lo = __builtin_amdgcn_ds_read_tr16_b64_v4i16((LAS v4i16_t*)a0), hi = __builtin_amdgcn_ds_read_tr16_b64_v4i16((LAS v4i16_t*)(a0 + 4 * 144));
    return (bf16x8){lo[0], lo[1], lo[2], lo[3], hi[0], hi[1], hi[2], hi[3]};
}

__device__ __forceinline__ void touch_line(const void* ptr) { const unsigned v = *(const volatile unsigned*)ptr; asm volatile("" :: "v"(v)); }
struct Params { const float* in[24]; float* out; unsigned char* ws; int ph_lo, ph_hi; };
typedef __attribute__((address_space(4))) const unsigned char* kptr_t;
template <typename T> __device__ __forceinline__ T karg(kptr_t k, int off) { return *(const __attribute__((address_space(4))) T*)(k + off); }
struct Ctx { kptr_t k; unsigned char* ws; float* out; int wid;
    __device__ __forceinline__ const float* in(int i) const { return karg<const float*>(k, 8 * i); } };
__device__ __forceinline__ Ctx make_ctx(int wid) { Ctx c; c.wid = wid; kptr_t k = (kptr_t)__builtin_amdgcn_kernarg_segment_ptr(); asm volatile("" : "+s"(k)); c.k = k; c.ws = karg<unsigned char*>(k, 200); c.out = karg<float*>(k, 192); return c; }
static_assert(sizeof(Params) == 216, "kernarg layout");

__device__ __forceinline__ int q_next(const Ctx& p, unsigned* ctr, volatile LAS int* slot) {
    __syncthreads();
    if (opaque_tid() == 0) *slot = (int)__hip_atomic_fetch_add(ctr, 1u, __ATOMIC_RELAXED, __HIP_MEMORY_SCOPE_AGENT);
    __syncthreads();
    return *slot;
}
struct TItem { const float* src; const float* gain; bf16* dst; int ldw, K_dst; };
__device__ __forceinline__ TItem titem(const float* W, int ldw, int K_dst, bf16* WT, int dst_row0, int src_col0, int k0, const float* gain, int lane) {
    const int c = lane >> 3, n4 = lane & 7; TItem t;
    t.src = W + (size_t)(k0 + 16 * c) * ldw + src_col0 + 4 * n4; t.gain = gain ? gain + k0 + 16 * c : nullptr; t.dst = WT + (size_t)(dst_row0 + 4 * n4) * K_dst + k0 + 16 * c; t.ldw = ldw; t.K_dst = K_dst; return t;
}
__device__ __forceinline__ TItem decode_item(const Ctx& p, int l, int it, int lane) {
    constexpr int I_GU = 16 * 344, I_D = 43 * 64, I_IN = 16 * 192, I_OUT = 16 * 64;
    unsigned char* ws = p.ws; int r = it;
    if (r < 2 * I_GU) {
        const int f = r >= I_GU; r -= f * I_GU; const int kb = r / 344, nb = r % 344, pn = nb >> 3, jj = nb & 7;
        const float* src = p.in((f ? 21 : 2) + (jj >> 2)) + (size_t)l * DM * DFF;
        return titem(src, DFF, DM, (bf16*)(ws + (f ? WS_WGU2 : WS_WGU1)), 32 * nb, 128 * pn + 32 * (jj & 3), 128 * kb, p.in(f ? 20 : 1) + l * DM, lane); }
    r -= 2 * I_GU;
    if (r < 2 * I_D) {
        const int f = r >= I_D; r -= f * I_D; const int kb = r / 64, nb = r % 64;
        return titem(p.in(f ? 23 : 4) + (size_t)l * DFF * DM, DM, DFF, (bf16*)(ws + (f ? WS_WD2 : WS_WD1)), 32 * nb, 32 * nb, 128 * kb, nullptr, lane); }
    r -= 2 * I_D;
    if (r < I_IN) {
        const int kb = r / 192, nb = r % 192, d0 = 32 * nb;
        return titem(p.in(6) + (size_t)l * DM * DIN, DIN, DM, (bf16*)(ws + WS_WIN), d0, d0 + (d0 >= 3072 ? 8 : 0), 128 * kb, p.in(5) + l * DM, lane); }
    r -= I_IN;
    if (r < I_OUT) { const int kb = r / 64, nb = r % 64;
        return titem(p.in(19) + (size_t)l * DM * DM, DM, DM, (bf16*)(ws + WS_WOUT), 32 * nb, 32 * nb, 128 * kb, nullptr, lane); }
    r -= I_OUT;
    const int mat = r >> 4, n = (r >> 2) & 3, nb = r & 3;
    return titem(p.in(mat ? 11 : 9) + (size_t)l * 65536 + n * 16384, 128, 128, (bf16*)(ws + WS_LRUW) + (mat * 4 + n) * 16384, 32 * nb, 32 * nb, 0, nullptr, lane);
}
__device__ __forceinline__ void convert_layer(const Ctx& p, int l, int part) {
    const int tid = opaque_tid(), lane = tid & 63, w = tid >> 6;
    const int gw = blockIdx.x * NWAVES + w, NGW = gridDim.x * NWAVES;
    constexpr int NITEMS_ALL = 2 * 16 * 344 + 2 * 43 * 64 + 16 * 192 + 16 * 64 + 32, THIRD = (NITEMS_ALL + 2) / 3;
    const int it0 = part < 0 ? 0 : part * THIRD, NITEMS = part < 0 ? NITEMS_ALL : (it0 + THIRD < NITEMS_ALL ? it0 + THIRD : NITEMS_ALL);
    for (int it = it0 + gw; it < NITEMS; it += NGW) {
        const TItem t = decode_item(p, l, it, lane);
        f32x4 v[16];
#pragma unroll
        for (int e = 0; e < 16; ++e) v[e] = *(const f32x4*)(t.src + (size_t)e * t.ldw);
        if (t.gain) {
#pragma unroll
            for (int q = 0; q < 4; ++q) { const f32x4 g = *(const f32x4*)(t.gain + 4 * q);
#pragma unroll
                for (int e = 0; e < 4; ++e) v[4 * q + e] = v[4 * q + e] * g[e]; } }
#pragma unroll
        for (int j = 0; j < 4; ++j) {
            v4u o0, o1; o0.x = pk2(v[0][j], v[1][j]); o0.y = pk2(v[2][j], v[3][j]); o0.z = pk2(v[4][j], v[5][j]); o0.w = pk2(v[6][j], v[7][j]);
            o1.x = pk2(v[8][j], v[9][j]); o1.y = pk2(v[10][j], v[11][j]); o1.z = pk2(v[12][j], v[13][j]); o1.w = pk2(v[14][j], v[15][j]);
            *(v4u*)(t.dst + (size_t)j * t.K_dst) = o0; *(v4u*)(t.dst + (size_t)j * t.K_dst + 8) = o1;
        }
    }
}
__device__ __forceinline__ void prologue_x(const Ctx& p) {
    const int tid = opaque_tid(), lane = tid & 63, w = tid >> 6;
    const int gw = blockIdx.x * NWAVES + w, NGW = gridDim.x * NWAVES;
    bf16* xb = (bf16*)(p.ws + WS_XB); unsigned long long* ssq = (unsigned long long*)(p.ws + WS_SSQ);
    for (int m = gw; m < M; m += NGW) {
        const f32x4* xr = (const f32x4*)(p.in(0) + (size_t)m * DM) + lane; float s = 0.f;
        v2u* o8 = (v2u*)(xb + (size_t)m * DM) + lane;
#pragma unroll
        for (int j = 0; j < 8; ++j) { const f32x4 v = xr[64 * j]; s += (v[0] * v[0] + v[1] * v[1]) + (v[2] * v[2] + v[3] * v[3]); v2u o; o.x = pk2(v[0], v[1]); o.y = pk2(v[2], v[3]); o8[64 * j] = o; }
        s = wave_sum(s);
        if (lane == 0) ssq[m] = (unsigned long long)(s * pg8::SSQ_FX + 0.5f);
    }
}
__device__ __forceinline__ void gates_phase(const Ctx& p, int l, const unsigned long long* ssq, LAS unsigned char* lds) {
    const int tid = opaque_tid(), lane = tid & 63, w = tid >> 6;
    LAS float* WG8 = (LAS float*)lds;
    const float* win = p.in(6) + (size_t)l * DM * DIN; const float* gain = p.in(5) + l * DM;
    for (int idx = tid; idx < DM * 8; idx += NT) { const int k = idx >> 3, c = idx & 7; WG8[k * 8 + (k >> 3) * 4 + c] = win[(size_t)k * DIN + 3072 + c] * gain[k]; }
    __syncthreads();
    const bf16* xb = (const bf16*)(p.ws + WS_XB); float* G = (float*)(p.ws + WS_G);
    for (int rb = blockIdx.x; rb < M / 64; rb += gridDim.x)
        for (int rr = 0; rr < 8; ++rr) {
            const int row = rb * 64 + w * 8 + rr;
            float a8[8];
#pragma unroll
            for (int c = 0; c < 8; ++c) a8[c] = 0.f;
#pragma unroll 1
            for (int it = 0; it < 4; ++it) {
                const int k0 = it * 512 + lane * 8;
                const v4u xv = *(const v4u*)(xb + (size_t)row * DM + k0);
                const float xs[8] = {bflo(xv.x), bfhi(xv.x), bflo(xv.y), bfhi(xv.y), bflo(xv.z), bfhi(xv.z), bflo(xv.w), bfhi(xv.w)};
#pragma unroll
                for (int e = 0; e < 8; ++e) { const int k = k0 + e; const LAS f32x4* wp = (const LAS f32x4*)(WG8 + k * 8 + (k >> 3) * 4); const f32x4 w0 = wp[0], w1 = wp[1];
                    a8[0] += xs[e] * w0[0]; a8[1] += xs[e] * w0[1]; a8[2] += xs[e] * w0[2]; a8[3] += xs[e] * w0[3]; a8[4] += xs[e] * w1[0]; a8[5] += xs[e] * w1[1]; a8[6] += xs[e] * w1[2]; a8[7] += xs[e] * w1[3]; }
            }
            const float rs = __builtin_amdgcn_rsqf((float)ssq[row] * (1.0f / (DM * pg8::SSQ_FX)) + EPS);
            float mine = 0.f;
#pragma unroll
            for (int c = 0; c < 8; ++c) { const float s = wave_sum(a8[c]); if (lane == c) mine = s; }
            if (lane < 8) G[(size_t)row * 8 + lane] = mine * rs;
        }
    __syncthreads();
}

constexpr int LRU_T = 16, LRU_NC = SEQ / LRU_T;
template <int PASS>
__device__ __forceinline__ void lru_unit(const Ctx& p, int l, int u, LAS unsigned char* lds) {
    const int tid = opaque_tid(), lane = tid & 63, w = tid >> 6, fr = lane & 15, fq = lane >> 4;
    const int b = u >> 8, c = u & 255, row0 = b * SEQ + c * LRU_T;
    LAS float* XC = (LAS float*)lds;
    LAS float* AA = (LAS float*)(lds + 32768);
    LAS bf16* XCB = (LAS bf16*)(lds + 65536);
    LAS bf16* Y = (LAS bf16*)(lds + 82176);
    const bf16* xr = (const bf16*)(p.ws + WS_PACT) + SEG_LX * SEG_STRIDE;
    const bf16* gt = (const bf16*)(p.ws + WS_PACT) + SEG_LG * SEG_STRIDE;
    float gate_v[16];
    if (PASS == 3) {
#pragma unroll
        for (int t = 0; t < 16; ++t) gate_v[t] = bf2f(gt[(size_t)(row0 + t) * GW + tid]);
    }
    {
        const int ch = 2 * (tid & 255), th = tid >> 8;
        const float* cw = p.in(7) + l * 4 * GW + ch; const float* cb = p.in(8) + l * GW + ch;
        const f32x2 w0 = *(const f32x2*)cw, w1 = *(const f32x2*)(cw + GW), w2 = *(const f32x2*)(cw + 2 * GW), w3 = *(const f32x2*)(cw + 3 * GW), cbv = *(const f32x2*)cb;
        const bf16* xp = xr + (size_t)(row0 + 8 * th - 3) * GW + ch;
        unsigned xv[11];
#pragma unroll
        for (int i = 0; i < 11; ++i) xv[i] = (c * LRU_T + 8 * th - 3 + i >= 0) ? *(const unsigned*)(xp + (size_t)i * GW) : 0u;
#pragma unroll
        for (int i = 0; i < 8; ++i) {
            const int t = 8 * th + i;
            const float xa = w0.x * bflo(xv[i]) + w1.x * bflo(xv[i + 1]) + w2.x * bflo(xv[i + 2]) + w3.x * bflo(xv[i + 3]) + cbv.x;
            const float xbv = w0.y * bfhi(xv[i]) + w1.y * bfhi(xv[i + 1]) + w2.y * bfhi(xv[i + 2]) + w3.y * bfhi(xv[i + 3]) + cbv.y;
            *(LAS f32x2*)(XC + t * 512 + ch) = (f32x2){xa, xbv}; *(LAS unsigned*)(XCB + t * 520 + ch) = pk2(xa, xbv);
        }
    }
    __syncthreads();
    {
        const int n = w >> 1;
        const float* ba = p.in(10) + l * GW; const float* bx = p.in(12) + l * GW; const float* lam = p.in(13) + l * GW;
        const bf16* WaT = (const bf16*)(p.ws + WS_LRUW); const bf16* WxT = WaT + 4 * 16384;
        const LAS bf16* xp = XCB + fr * 520 + n * 128 + 8 * fq;
        bf16x8 af[4];
#pragma unroll
        for (int k = 0; k < 4; ++k) af[k] = *(const LAS bf16x8*)(xp + 32 * k);
#pragma unroll
        for (int ds = 0; ds < 4; ++ds) {
            const int d0 = 16 * (4 * (w & 1) + ds);
            const bf16* wap = WaT + (size_t)(n * 128 + d0 + fr) * 128 + 8 * fq; const bf16* wxp = WxT + (size_t)(n * 128 + d0 + fr) * 128 + 8 * fq;
            f32x4 za = {0.f, 0.f, 0.f, 0.f}, zx = {0.f, 0.f, 0.f, 0.f};
#pragma unroll
            for (int k = 0; k < 4; ++k) {
                const bf16x8 b1 = *(const bf16x8*)(wap + 32 * k), b2 = *(const bf16x8*)(wxp + 32 * k);
                za = __builtin_amdgcn_mfma_f32_16x16x32_bf16(af[k], b1, za, 0, 0, 0); zx = __builtin_amdgcn_mfma_f32_16x16x32_bf16(af[k], b2, zx, 0, 0, 0);
            }
            const int dg = n * 128 + d0 + fr; const float bav = ba[dg], bxv = bx[dg], spl = 8.0f * softplusf(-lam[dg]);
#pragma unroll
            for (int j = 0; j < 4; ++j) {
                const int t = 4 * fq + j;
                const float r = sigmoidf(za[j] + bav), ii = sigmoidf(zx[j] + bxv), loga = -spl * r, a = __expf(loga), mult = sqrtf(-expm1f(2.0f * loga));
                const float xc = XC[t * 512 + dg]; AA[t * 512 + dg] = a; XC[t * 512 + dg] = mult * ii * xc;
            }
        }
    }
    __syncthreads();
    {
        const int dg = tid; const size_t ci = (size_t)(b * LRU_NC + c) * GW + dg;
        float h = (PASS == 3) ? ((const float*)(p.ws + WS_LCI))[ci] : 0.f, ap = 1.f;
#pragma unroll
        for (int t = 0; t < 16; ++t) { const float a = AA[t * 512 + dg], uu = XC[t * 512 + dg]; h = a * h + uu; ap *= a; if (PASS == 3) Y[t * 520 + dg] = (bf16)f2bf(h * gelu_tanh(gate_v[t])); }
        if (PASS == 1) { ((float*)(p.ws + WS_LAP))[ci] = ap; ((float*)(p.ws + WS_LHE))[ci] = h; }
    }
    if (PASS == 3) {
        __syncthreads();
        const float* ga = p.in(18) + l * DM; bf16* mixed = (bf16*)(p.ws + WS_MIXED);
        float gv[8];
#pragma unroll
        for (int e = 0; e < 8; ++e) gv[e] = ga[lane * 8 + e];
#pragma unroll
        for (int tt = 0; tt < 2; ++tt) {
            const int t = w * 2 + tt; const v4u v = *(const LAS v4u*)(Y + t * 520 + lane * 8);
            float f[8] = {bflo(v.x), bfhi(v.x), bflo(v.y), bfhi(v.y), bflo(v.z), bfhi(v.z), bflo(v.w), bfhi(v.w)}; float ss = 0.f;
#pragma unroll
            for (int e = 0; e < 8; ++e) ss += f[e] * f[e];
            ss = wave_sum(ss); const float rs = __builtin_amdgcn_rsqf(ss * (1.0f / GW) + EPS);
            v4u o; o.x = pk2(f[0] * rs * gv[0], f[1] * rs * gv[1]); o.y = pk2(f[2] * rs * gv[2], f[3] * rs * gv[3]); o.z = pk2(f[4] * rs * gv[4], f[5] * rs * gv[5]); o.w = pk2(f[6] * rs * gv[6], f[7] * rs * gv[7]);
            *(v4u*)(mixed + (size_t)(row0 + t) * DM + lane * 8) = o;
        }
    }
}
__device__ __forceinline__ void lru_carry_unit(const Ctx& p, int b) {
    const int ch = opaque_tid(); const float* LAP = (const float*)(p.ws + WS_LAP); const float* LHE = (const float*)(p.ws + WS_LHE); float* LCI = (float*)(p.ws + WS_LCI);
    float carry = 0.f;
    for (int c0 = 0; c0 < LRU_NC; c0 += 32) {
        float ap[32], he[32];
#pragma unroll
        for (int j = 0; j < 32; ++j) { const size_t o = (size_t)(b * LRU_NC + c0 + j) * GW + ch; ap[j] = LAP[o]; he[j] = LHE[o]; }
#pragma unroll
        for (int j = 0; j < 32; ++j) { LCI[(size_t)(b * LRU_NC + c0 + j) * GW + ch] = carry; carry = ap[j] * carry + he[j]; }
    }
}

__device__ __forceinline__ void mlstm1_unit(const Ctx& p, int l, int u, LAS unsigned char* lds) {
    const int tid = opaque_tid(), lane = tid & 63, w = tid >> 6, fr = lane & 15, fq = lane >> 4;
    const int bh = u >> 6, c = u & 63, b = bh >> 2, h = bh & 3, row0 = b * SEQ + c * 64;
    LAS bf16* VH = (LAS bf16*)lds;
    LAS bf16* KW = (LAS bf16*)(lds + 18432);
    LAS float* WS = (LAS float*)(lds + 36864);
    const float* G = (const float*)(p.ws + WS_G);
    const bf16* Kg = (const bf16*)(p.ws + WS_PACT) + SEG_MK * SEG_STRIDE + h * HD; const bf16* Vg = (const bf16*)(p.ws + WS_PACT) + SEG_MV * SEG_STRIDE + h * HD;
    v4u kvr[2], vvr[2];
#pragma unroll
    for (int i = 0; i < 2; ++i) { const int q = tid + NT * i, s = q >> 4, kc = (q & 15) * 8; kvr[i] = *(const v4u*)(Kg + (size_t)(row0 + s) * GW + kc); vvr[i] = *(const v4u*)(Vg + (size_t)(row0 + s) * GW + kc); }
    if (w == 0) {
        const int s = lane;
        const float ip = G[(size_t)(row0 + s) * 8 + h] + p.in(14)[l * NH + h], fp = G[(size_t)(row0 + s) * 8 + 4 + h] + p.in(15)[l * NH + h];
        float bc = -softplusf(-fp);
#pragma unroll
        for (int o = 1; o < 64; o <<= 1) { const float t = __shfl_up(bc, o); if (lane >= o) bc += t; }
        const float blast = __shfl(bc, 63), logw = blast - bc + ip, mloc = wave_max(logw);
        WS[s] = __expf(logw - mloc);
        if (lane == 0) { ((float*)(p.ws + WS_BLAST))[u] = blast; ((float*)(p.ws + WS_MLOC))[u] = mloc; }
    }
    __syncthreads();
#pragma unroll
    for (int i = 0; i < 2; ++i) {
        const int q = tid + NT * i, s = q >> 4, kc = (q & 15) * 8;
        const v4u kv = kvr[i]; const float ws = WS[s] * KSCALE;
        v4u ko; ko.x = pk2(bflo(kv.x) * ws, bfhi(kv.x) * ws); ko.y = pk2(bflo(kv.y) * ws, bfhi(kv.y) * ws); ko.z = pk2(bflo(kv.z) * ws, bfhi(kv.z) * ws); ko.w = pk2(bflo(kv.w) * ws, bfhi(kv.w) * ws);
        *(LAS v4u*)(KW + s * 144 + kc) = ko; *(LAS v4u*)(VH + s * 144 + kc) = vvr[i];
    }
    __syncthreads();
    float* DCT = (float*)(p.ws + WS_DCT) + (size_t)u * 16384;
    const bf16x8 vb0 = tr_frag(VH, 0, w, lane), vb1 = tr_frag(VH, 1, w, lane);
#pragma unroll
    for (int ki = 0; ki < 8; ++ki) {
        f32x4 acc = {0.f, 0.f, 0.f, 0.f};
        acc = __builtin_amdgcn_mfma_f32_16x16x32_bf16(tr_frag(KW, 0, ki, lane), vb0, acc, 0, 0, 0);
        acc = __builtin_amdgcn_mfma_f32_16x16x32_bf16(tr_frag(KW, 1, ki, lane), vb1, acc, 0, 0, 0);
        *(f32x4*)(DCT + (16 * w + fr) * 128 + 16 * ki + 4 * fq) = acc;
    }
    if (tid < 128) { float s = 0.f;
#pragma unroll 8
        for (int t = 0; t < 64; ++t) s += bf2f(KW[t * 144 + tid]);
        ((float*)(p.ws + WS_DN))[(size_t)u * 128 + tid] = s; }
}
__device__ __forceinline__ void mlstm_scan_unit(const Ctx& p, int su) {
    const int tid = opaque_tid(), bh = su >> 3, slice = su & 7, e0 = slice * 2048 + tid * 4;
    const float* DCT = (const float*)(p.ws + WS_DCT); bf16* CST = (bf16*)(p.ws + WS_CST);
    const float* DN = (const float*)(p.ws + WS_DN); float* NST = (float*)(p.ws + WS_NST);
    const float* BL = (const float*)(p.ws + WS_BLAST); const float* ML = (const float*)(p.ws + WS_MLOC); float* MR = (float*)(p.ws + WS_MRUN);
    f32x4 C = {0.f, 0.f, 0.f, 0.f}, nv = {0.f, 0.f, 0.f, 0.f}; float mrun = 0.f;
    const bool donv = (slice == 0 && tid < 32);
    for (int c0 = 0; c0 < 64; c0 += 16) {
        f32x4 d4[16], n4[16]; float bl[16], ml[16];
#pragma unroll
        for (int j = 0; j < 16; ++j) { const int ui = bh * 64 + c0 + j; d4[j] = *(const f32x4*)(DCT + (size_t)ui * 16384 + e0); bl[j] = BL[ui]; ml[j] = ML[ui];
            n4[j] = donv ? *(const f32x4*)(DN + (size_t)ui * 128 + tid * 4) : (f32x4){0.f, 0.f, 0.f, 0.f}; }
#pragma unroll
        for (int j = 0; j < 16; ++j) {
            const int ui = bh * 64 + c0 + j;
            v2u o; o.x = pk2(C[0], C[1]); o.y = pk2(C[2], C[3]); *(v2u*)(CST + (size_t)ui * 16384 + e0) = o;
            if (donv) *(f32x4*)(NST + (size_t)ui * 128 + tid * 4) = nv;
            if (slice == 0 && tid == 0) MR[ui] = mrun;
            const float mnext = fmaxf(bl[j] + mrun, ml[j]), dec = __expf(bl[j] + mrun - mnext), sc = __expf(ml[j] - mnext);
            C = C * dec + d4[j] * sc; nv = nv * dec + n4[j] * sc; mrun = mnext;
        }
    }
}
__device__ __forceinline__ void mlstm3_unit(const Ctx& p, int l, int u, LAS unsigned char* lds) {
    const int tid = opaque_tid(), lane = tid & 63, w = tid >> 6, fr = lane & 15, fq = lane >> 4;
    const int bh = u >> 6, c = u & 63, b = bh >> 2, h = bh & 3, row0 = b * SEQ + c * 64;
    LAS bf16* Q = (LAS bf16*)lds;
    LAS bf16* KS = (LAS bf16*)(lds + 17408);
    LAS bf16* VH = (LAS bf16*)(lds + 34816);
    LAS bf16* CT = (LAS bf16*)(lds + 53248);
    LAS bf16* SB = (LAS bf16*)(lds + 88064);
    LAS float* HF = (LAS float*)(lds + 97280);
    LAS float* BV = (LAS float*)(lds + 130304);
    LAS float* CV = BV + 64;
    LAS float* MT = BV + 128;
    LAS float* WI = BV + 192;
    LAS float* QN = BV + 256;
    LAS float* NV = BV + 320;
    LAS float* RSP = BV + 448;
    const float* G = (const float*)(p.ws + WS_G);
    const bf16* Qg = (const bf16*)(p.ws + WS_PACT) + SEG_MQ * SEG_STRIDE + h * HD; const bf16* Kg = (const bf16*)(p.ws + WS_PACT) + SEG_MK * SEG_STRIDE + h * HD;
    const bf16* Vg = (const bf16*)(p.ws + WS_PACT) + SEG_MV * SEG_STRIDE + h * HD; const bf16* Cg = (const bf16*)(p.ws + WS_CST) + (size_t)u * 16384;
    const bf16* Og = (const bf16*)(p.ws + WS_PACT) + SEG_MO * SEG_STRIDE + h * HD;
    {
        v4u qv[2], kv[2], vv[2], cv4[4];
#pragma unroll
        for (int i = 0; i < 2; ++i) { const int q = tid + NT * i, s = q >> 4, kc = (q & 15) * 8;
            qv[i] = *(const v4u*)(Qg + (size_t)(row0 + s) * GW + kc); kv[i] = *(const v4u*)(Kg + (size_t)(row0 + s) * GW + kc); vv[i] = *(const v4u*)(Vg + (size_t)(row0 + s) * GW + kc); }
#pragma unroll
        for (int i = 0; i < 4; ++i) { const int q = tid + NT * i, r = q >> 4, kc = (q & 15) * 8; cv4[i] = *(const v4u*)(Cg + r * 128 + kc); }
        if (w == 0) {
            const int s = lane;
            const float ip = G[(size_t)(row0 + s) * 8 + h] + p.in(14)[l * NH + h], fp = G[(size_t)(row0 + s) * 8 + 4 + h] + p.in(15)[l * NH + h];
            float bc = -softplusf(-fp);
#pragma unroll
            for (int o = 1; o < 64; o <<= 1) { const float t = __shfl_up(bc, o); if (lane >= o) bc += t; }
            const float cv = ip - bc; float g = cv;
#pragma unroll
            for (int o = 1; o < 64; o <<= 1) { const float t = __shfl_up(g, o); if (lane >= o) g = fmaxf(g, t); }
            const float mrun = ((const float*)(p.ws + WS_MRUN))[u], mt = bc + fmaxf(mrun, g);
            BV[s] = bc; CV[s] = cv; MT[s] = mt; WI[s] = __expf(bc + mrun - mt);
        }
        if (tid >= 64 && tid < 192) NV[tid - 64] = ((const float*)(p.ws + WS_NST))[(size_t)u * 128 + tid - 64];
#pragma unroll
        for (int i = 0; i < 2; ++i) { const int q = tid + NT * i, s = q >> 4, kc = (q & 15) * 8;
            *(LAS v4u*)(Q + s * 136 + kc) = qv[i];
            v4u ko; ko.x = pk2(bflo(kv[i].x) * KSCALE, bfhi(kv[i].x) * KSCALE); ko.y = pk2(bflo(kv[i].y) * KSCALE, bfhi(kv[i].y) * KSCALE); ko.z = pk2(bflo(kv[i].z) * KSCALE, bfhi(kv[i].z) * KSCALE); ko.w = pk2(bflo(kv[i].w) * KSCALE, bfhi(kv[i].w) * KSCALE);
            *(LAS v4u*)(KS + s * 136 + kc) = ko; *(LAS v4u*)(VH + s * 144 + kc) = vv[i]; }
#pragma unroll
        for (int i = 0; i < 4; ++i) { const int q = tid + NT * i, r = q >> 4, kc = (q & 15) * 8; *(LAS v4u*)(CT + r * 136 + kc) = cv4[i]; }
    }
    float op0[8], op1[8];
#pragma unroll
    for (int tt = 0; tt < 8; ++tt) { op0[tt] = bf2f(Og[(size_t)(row0 + w * 8 + tt) * GW + lane]); op1[tt] = bf2f(Og[(size_t)(row0 + w * 8 + tt) * GW + lane + 64]); }
    __syncthreads();
    const int ti = w >> 1;
    {
#pragma unroll
        for (int x = 0; x < 2; ++x) {
            const int si = 2 * (w & 1) + x;
            f32x4 acc = {0.f, 0.f, 0.f, 0.f};
            if (si <= ti) mma_lds<128>(acc, Q + 16 * ti * 136, 136, KS + 16 * si * 136, 136, lane);
            const int s = 16 * si + fr; const float cvs = CV[s];
#pragma unroll
            for (int j = 0; j < 4; ++j) { const int t = 16 * ti + 4 * fq + j; const float sd = (s <= t) ? acc[j] * __expf(BV[t] + cvs - MT[t]) : 0.f;
                SB[t * 72 + s] = (bf16)f2bf(sd);
                float r = sd; r += __shfl_xor(r, 1); r += __shfl_xor(r, 2); r += __shfl_xor(r, 4); r += __shfl_xor(r, 8);
                if (fr == 0) RSP[t * 4 + si] = r; }
        }
        if (w == 7) { const int t = lane; float qn = 0.f;
#pragma unroll 8
            for (int k = 0; k < 128; ++k) qn += bf2f(Q[t * 136 + k]) * NV[k];
            QN[t] = qn; }
    }
    __syncthreads();
    {
        const bf16x8 sa0 = *(const LAS bf16x8*)(SB + (16 * ti + fr) * 72 + 8 * fq), sa1 = *(const LAS bf16x8*)(SB + (16 * ti + fr) * 72 + 32 + 8 * fq);
        float wi[4], dinv[4];
#pragma unroll
        for (int j = 0; j < 4; ++j) { const int t = 16 * ti + 4 * fq + j; wi[j] = WI[t];
            const float den = (RSP[t * 4] + RSP[t * 4 + 1]) + (RSP[t * 4 + 2] + RSP[t * 4 + 3]) + wi[j] * QN[t];
            dinv[j] = 1.0f / fmaxf(fabsf(den), __expf(-MT[t])); }
#pragma unroll
        for (int x = 0; x < 4; ++x) {
            const int vi = 4 * (w & 1) + x;
            f32x4 a1 = {0.f, 0.f, 0.f, 0.f}, a2 = {0.f, 0.f, 0.f, 0.f};
            a1 = __builtin_amdgcn_mfma_f32_16x16x32_bf16(sa0, tr_frag(VH, 0, vi, lane), a1, 0, 0, 0);
            a1 = __builtin_amdgcn_mfma_f32_16x16x32_bf16(sa1, tr_frag(VH, 1, vi, lane), a1, 0, 0, 0);
            mma_lds<128>(a2, Q + 16 * ti * 136, 136, CT + 16 * vi * 136, 136, lane);
#pragma unroll
            for (int j = 0; j < 4; ++j) HF[(16 * ti + 4 * fq + j) * 129 + 16 * vi + fr] = (a1[j] + wi[j] * a2[j]) * dinv[j];
        }
    }
    __syncthreads();
    {
        const float* gb = p.in(18) + l * DM + GW + h * HD; bf16* mixed = (bf16*)(p.ws + WS_MIXED);
        const float g0 = gb[lane], g1 = gb[lane + 64];
#pragma unroll
        for (int tt = 0; tt < 8; ++tt) {
            const int t = w * 8 + tt; const float h0 = HF[t * 129 + lane], h1 = HF[t * 129 + lane + 64];
            const float ss = wave_sum(h0 * h0 + h1 * h1), rs = __builtin_amdgcn_rsqf(ss * (1.0f / HD) + EPS);
            bf16* mo = mixed + (size_t)(row0 + t) * DM + GW + h * HD;
            mo[lane] = (bf16)f2bf(h0 * rs * g0 * sigmoidf(op0[tt])); mo[lane + 64] = (bf16)f2bf(h1 * rs * g1 * sigmoidf(op1[tt]));
        }
    }
}

template <int NCH> __device__ __forceinline__ void ld_rows(v4u (&r)[NCH], const bf16* src, int gbase, int gstride, int tid) {
#pragma unroll
    for (int i = 0; i < NCH; ++i) { const int q = tid + NT * i, row = q >> 4, kc = (q & 15) * 8; r[i] = *(const v4u*)(src + (size_t)(gbase + row * gstride) * GW + kc); }
}
template <bool NORM, int NCH, int PITCH> __device__ __forceinline__ void st_rows(LAS bf16* dst, const v4u (&r)[NCH], const float (&gain)[8], int tid) {
#pragma unroll
    for (int i = 0; i < NCH; ++i) {
        const int q = tid + NT * i, row = q >> 4, kc = (q & 15) * 8; v4u v = r[i];
        if (NORM) {
            float f[8] = {bflo(v.x), bfhi(v.x), bflo(v.y), bfhi(v.y), bflo(v.z), bfhi(v.z), bflo(v.w), bfhi(v.w)}; float ss = 0.f;
#pragma unroll
            for (int e = 0; e < 8; ++e) ss += f[e] * f[e];
            ss += __shfl_xor(ss, 1); ss += __shfl_xor(ss, 2); ss += __shfl_xor(ss, 4); ss += __shfl_xor(ss, 8);
            const float rs = __builtin_amdgcn_rsqf(ss * (1.0f / HD) + EPS);
            v.x = pk2(f[0] * rs * gain[0], f[1] * rs * gain[1]); v.y = pk2(f[2] * rs * gain[2], f[3] * rs * gain[3]);
            v.z = pk2(f[4] * rs * gain[4], f[5] * rs * gain[5]); v.w = pk2(f[6] * rs * gain[6], f[7] * rs * gain[7]);
        }
        *(LAS v4u*)(dst + row * PITCH + kc) = v;
    }
}
constexpr int ATT_K = 0, ATT_V = 17408, ATT_PL = 35840, ATT_VOTE = 72704, ATT_Q = 73728;
__device__ __forceinline__ void load_qfrags(bf16x8 (&qf)[2][4], const LAS bf16* QH, int w, int lane) {
#pragma unroll
    for (int rt = 0; rt < 2; ++rt)
#pragma unroll
        for (int k = 0; k < 4; ++k) qf[rt][k] = *(const LAS bf16x8*)(QH + (32 * w + 16 * rt + (lane & 15)) * 136 + 32 * k + 8 * (lane >> 4));
}

__device__ __forceinline__ void dilated_unit(const Ctx& p, int l, int u, LAS unsigned char* lds) {
    const int tid = opaque_tid(), lane = tid & 63, w = tid >> 6, fr = lane & 15, fq = lane >> 4;
    const int pat = u >> 8, rem = u & 255, bh = rem >> 4, x = rem & 15, b = bh >> 2, h = bh & 3;
    const int d = pat == 0 ? 1 : (pat == 1 ? 4 : 16);
    const int r = pat == 0 ? 0 : (pat == 1 ? (x >> 2) : x), nbk = pat == 0 ? x : (pat == 1 ? (x & 3) : 0);
    LAS bf16* QH = (LAS bf16*)(lds + ATT_Q); LAS bf16* KH = (LAS bf16*)(lds + ATT_K); LAS bf16* VH = (LAS bf16*)(lds + ATT_V); LAS bf16* PL = (LAS bf16*)(lds + ATT_PL) + w * 32 * 72;
    const bf16* Qg = (const bf16*)(p.ws + WS_PACT) + SEG_CQ * SEG_STRIDE + h * HD; const bf16* Kg = (const bf16*)(p.ws + WS_PACT) + SEG_CK * SEG_STRIDE + h * HD;
    const bf16* Vg = (const bf16*)(p.ws + WS_PACT) + SEG_CV * SEG_STRIDE + h * HD;
    float qgain[8], kgain[8];
#pragma unroll
    for (int e = 0; e < 8; ++e) { qgain[e] = p.in(16)[l * HD + (tid & 15) * 8 + e]; kgain[e] = p.in(17)[l * HD + (tid & 15) * 8 + e]; }
    const float slope_d = exp2f(-2.0f * (float)(h + 1)) * (float)d;
    const int kt0 = (nbk == 0 ? 2 : 0), gk0 = b * SEQ + (nbk * 256 - 128) * d + r;
    v4u kr[2], vr[2];
    { v4u qr[8]; ld_rows<8>(qr, Qg, b * SEQ + (nbk * 256) * d + r, d, tid); ld_rows<2>(kr, Kg, gk0 + kt0 * 64 * d, d, tid); ld_rows<2>(vr, Vg, gk0 + kt0 * 64 * d, d, tid);
      st_rows<true, 8, 136>(QH, qr, qgain, tid); }
    __syncthreads();
    bf16x8 qf[2][4]; load_qfrags(qf, QH, w, lane);
    float m_i[2] = {-1e30f, -1e30f}, l_i[2] = {0.f, 0.f}; f32x4 o[2][8];
#pragma unroll
    for (int rt = 0; rt < 2; ++rt)
#pragma unroll
        for (int ds = 0; ds < 8; ++ds) o[rt][ds] = (f32x4){0.f, 0.f, 0.f, 0.f};
    for (int kt = kt0; kt < 6; ++kt) {
        __syncthreads();
        st_rows<true, 2, 136>(KH, kr, kgain, tid); st_rows<false, 2, 144>(VH, vr, kgain, tid);
        __syncthreads();
        if (kt < 5) { ld_rows<2>(kr, Kg, gk0 + (kt + 1) * 64 * d, d, tid); ld_rows<2>(vr, Vg, gk0 + (kt + 1) * 64 * d, d, tid); }
        if ((64 * kt + 63 >= 32 * w) && (64 * kt <= 32 * w + 31 + 128)) {
            f32x4 s[2][4];
#pragma unroll
            for (int rt = 0; rt < 2; ++rt)
#pragma unroll
                for (int n = 0; n < 4; ++n) s[rt][n] = (f32x4){0.f, 0.f, 0.f, 0.f};
#pragma unroll
            for (int k = 0; k < 4; ++k)
#pragma unroll
                for (int n = 0; n < 4; ++n) { const bf16x8 kf = *(const LAS bf16x8*)(KH + (16 * n + fr) * 136 + 32 * k + 8 * fq);
                    s[0][n] = __builtin_amdgcn_mfma_f32_16x16x32_bf16(kf, qf[0][k], s[0][n], 0, 0, 0); s[1][n] = __builtin_amdgcn_mfma_f32_16x16x32_bf16(kf, qf[1][k], s[1][n], 0, 0, 0); }
            float alpha[2];
#pragma unroll
            for (int rt = 0; rt < 2; ++rt) {
                const int qi = 32 * w + 16 * rt + fr; float mx = -1e30f;
#pragma unroll
                for (int n = 0; n < 4; ++n)
#pragma unroll
                    for (int j = 0; j < 4; ++j) { const int dist = 128 + qi - (64 * kt + 16 * n + 4 * fq + j); const bool valid = dist >= 0 && dist <= 128;
                        const float sc = valid ? s[rt][n][j] * KSCALE - slope_d * (float)dist : -1e30f; s[rt][n][j] = sc; mx = fmaxf(mx, sc); }
                mx = fmaxf(mx, __shfl_xor(mx, 16)); mx = fmaxf(mx, __shfl_xor(mx, 32));
                const float m_new = fmaxf(m_i[rt], mx); alpha[rt] = __expf(m_i[rt] - m_new); float ls = 0.f;
#pragma unroll
                for (int n = 0; n < 4; ++n) {
#pragma unroll
                    for (int j = 0; j < 4; ++j) { const float pv = s[rt][n][j] > -1e29f ? __expf(s[rt][n][j] - m_new) : 0.f; ls += pv; s[rt][n][j] = pv; }
                    v2u pw; pw.x = pk2(s[rt][n][0], s[rt][n][1]); pw.y = pk2(s[rt][n][2], s[rt][n][3]);
                    *(LAS v2u*)(PL + (16 * rt + fr) * 72 + 16 * n + 4 * fq) = pw;
                }
                ls += __shfl_xor(ls, 16); ls += __shfl_xor(ls, 32);
                l_i[rt] = l_i[rt] * alpha[rt] + ls; m_i[rt] = m_new;
            }
            asm volatile("" ::: "memory");
            bf16x8 pf[2][2];
#pragma unroll
            for (int rt = 0; rt < 2; ++rt) { pf[rt][0] = *(const LAS bf16x8*)(PL + (16 * rt + fr) * 72 + 8 * fq); pf[rt][1] = *(const LAS bf16x8*)(PL + (16 * rt + fr) * 72 + 32 + 8 * fq); }
#pragma unroll
            for (int ds = 0; ds < 8; ++ds) { const bf16x8 v0 = tr_frag(VH, 0, ds, lane), v1 = tr_frag(VH, 1, ds, lane);
#pragma unroll
                for (int rt = 0; rt < 2; ++rt) { o[rt][ds] = o[rt][ds] * alpha[rt];
                    o[rt][ds] = __builtin_amdgcn_mfma_f32_16x16x32_bf16(v0, pf[rt][0], o[rt][ds], 0, 0, 0); o[rt][ds] = __builtin_amdgcn_mfma_f32_16x16x32_bf16(v1, pf[rt][1], o[rt][ds], 0, 0, 0); } }
        }
    }
#pragma unroll
    for (int rt = 0; rt < 2; ++rt) {
        const int qi = 32 * w + 16 * rt + fr; const float inv = 1.0f / l_i[rt]; const int grow = b * SEQ + (nbk * 256 + qi) * d + r;
        bf16* og = (bf16*)(p.ws + WS_CPART) + (size_t)pat * SEG_STRIDE + (size_t)grow * GW + h * HD;
#pragma unroll
        for (int ds = 0; ds < 8; ++ds) { v2u ov; ov.x = pk2(o[rt][ds][0] * inv, o[rt][ds][1] * inv); ov.y = pk2(o[rt][ds][2] * inv, o[rt][ds][3] * inv); *(v2u*)(og + 16 * ds + 4 * fq) = ov; }
        if (fq == 0) ((float*)(p.ws + WS_LSE))[((size_t)pat * M + grow) * 4 + h] = m_i[rt] + __logf(l_i[rt]);
    }
}

__device__ __forceinline__ void stick_unit(const Ctx& p, int u, LAS unsigned char* lds) {
    const int tid = opaque_tid(), lane = tid & 63, w = tid >> 6, fr = lane & 15, fq = lane >> 4;
    const int qb = 15 - (u >> 4), bh = u & 15, b = bh >> 2, h = bh & 3;
    LAS bf16* QH = (LAS bf16*)(lds + ATT_Q); LAS bf16* KH = (LAS bf16*)(lds + ATT_K); LAS bf16* VH = (LAS bf16*)(lds + ATT_V); LAS bf16* PL = (LAS bf16*)(lds + ATT_PL) + w * 32 * 72;
    volatile LAS int* vote = (volatile LAS int*)(lds + ATT_VOTE);
    const bf16* Qg = (const bf16*)(p.ws + WS_PACT) + SEG_SQ * SEG_STRIDE + h * HD; const bf16* Kg = (const bf16*)(p.ws + WS_PACT) + SEG_SK * SEG_STRIDE + h * HD;
    const bf16* Vg = (const bf16*)(p.ws + WS_PACT) + SEG_SV * SEG_STRIDE + h * HD;
    const float nogain[8] = {1.f, 1.f, 1.f, 1.f, 1.f, 1.f, 1.f, 1.f};
    const int ktop = 4 * qb + 3;
    v4u kr[2], vr[2];
    { v4u qr[8]; ld_rows<8>(qr, Qg, b * SEQ + qb * 256, 1, tid); ld_rows<2>(kr, Kg, b * SEQ + ktop * 64, 1, tid); ld_rows<2>(vr, Vg, b * SEQ + ktop * 64, 1, tid);
      st_rows<false, 8, 136>(QH, qr, nogain, tid); }
    if (tid < 8) vote[tid] = 0;
    __syncthreads();
    bf16x8 qf[2][4]; load_qfrags(qf, QH, w, lane);
    float R[2] = {0.f, 0.f}; f32x4 o[2][8];
#pragma unroll
    for (int rt = 0; rt < 2; ++rt)
#pragma unroll
        for (int ds = 0; ds < 8; ++ds) o[rt][ds] = (f32x4){0.f, 0.f, 0.f, 0.f};
    for (int kt = ktop; kt >= 0; --kt) {
        __syncthreads();
        { int all = 1;
#pragma unroll
          for (int i = 0; i < 8; ++i) all &= vote[i];
          if (all) break; }
        st_rows<false, 2, 136>(KH, kr, nogain, tid); st_rows<false, 2, 144>(VH, vr, nogain, tid);
        __syncthreads();
        if (kt > 0) { ld_rows<2>(kr, Kg, b * SEQ + (kt - 1) * 64, 1, tid); ld_rows<2>(vr, Vg, b * SEQ + (kt - 1) * 64, 1, tid); }
        if (64 * kt < 256 * qb + 32 * w + 31) {
            f32x4 s[2][4];
#pragma unroll
            for (int rt = 0; rt < 2; ++rt)
#pragma unroll
                for (int n = 0; n < 4; ++n) s[rt][n] = (f32x4){0.f, 0.f, 0.f, 0.f};
#pragma unroll
            for (int k = 0; k < 4; ++k)
#pragma unroll
                for (int n = 0; n < 4; ++n) { const bf16x8 kf = *(const LAS bf16x8*)(KH + (16 * n + fr) * 136 + 32 * k + 8 * fq);
                    s[0][n] = __builtin_amdgcn_mfma_f32_16x16x32_bf16(kf, qf[0][k], s[0][n], 0, 0, 0); s[1][n] = __builtin_amdgcn_mfma_f32_16x16x32_bf16(kf, qf[1][k], s[1][n], 0, 0, 0); }
#pragma unroll
            for (int rt = 0; rt < 2; ++rt) {
                const int qpos = 256 * qb + 32 * w + 16 * rt + fr; float carry = 0.f;
#pragma unroll
                for (int n = 3; n >= 0; --n) {
                    float lk[4], lsg[4];
#pragma unroll
                    for (int j = 0; j < 4; ++j) { const int key = 64 * kt + 16 * n + 4 * fq + j; const float z = s[rt][n][j] * KSCALE, sp = softplusf(z); lk[j] = key < qpos ? -sp : 0.f; lsg[j] = z - sp; }
                    const float s2 = lk[3], s1 = s2 + lk[2], s0 = s1 + lk[1], T = s0 + lk[0];
                    const float t1 = __shfl(T, (lane + 16) & 63), t2 = __shfl(T, (lane + 32) & 63), t3 = __shfl(T, (lane + 48) & 63);
                    const float base = (fq < 3 ? t1 : 0.f) + (fq < 2 ? t2 : 0.f) + (fq < 1 ? t3 : 0.f) + carry + R[rt];
                    const float suf[4] = {s0, s1, s2, 0.f};
                    float wv[4];
#pragma unroll
                    for (int j = 0; j < 4; ++j) { const int key = 64 * kt + 16 * n + 4 * fq + j; wv[j] = key < qpos ? __expf(lsg[j] + suf[j] + base) : 0.f; }
                    v2u pw; pw.x = pk2(wv[0], wv[1]); pw.y = pk2(wv[2], wv[3]);
                    *(LAS v2u*)(PL + (16 * rt + fr) * 72 + 16 * n + 4 * fq) = pw;
                    carry += (T + t1) + (t2 + t3);
                }
                R[rt] += carry;
            }
            asm volatile("" ::: "memory");
            bf16x8 pf[2][2];
#pragma unroll
            for (int rt = 0; rt < 2; ++rt) { pf[rt][0] = *(const LAS bf16x8*)(PL + (16 * rt + fr) * 72 + 8 * fq); pf[rt][1] = *(const LAS bf16x8*)(PL + (16 * rt + fr) * 72 + 32 + 8 * fq); }
#pragma unroll
            for (int ds = 0; ds < 8; ++ds) { const bf16x8 v0 = tr_frag(VH, 0, ds, lane), v1 = tr_frag(VH, 1, ds, lane);
#pragma unroll
                for (int rt = 0; rt < 2; ++rt) { o[rt][ds] = __builtin_amdgcn_mfma_f32_16x16x32_bf16(v0, pf[rt][0], o[rt][ds], 0, 0, 0); o[rt][ds] = __builtin_amdgcn_mfma_f32_16x16x32_bf16(v1, pf[rt][1], o[rt][ds], 0, 0, 0); } }
        }
        { const int done = __all(R[0] <= -104.0f && R[1] <= -104.0f); if (lane == 0) vote[w] = done; }
    }
#pragma unroll
    for (int rt = 0; rt < 2; ++rt) {
        bf16* og = (bf16*)(p.ws + WS_DOUT) + (size_t)(b * SEQ + 256 * qb + 32 * w + 16 * rt + fr) * GW + h * HD;
#pragma unroll
        for (int ds = 0; ds < 8; ++ds) { v2u ov; ov.x = pk2(o[rt][ds][0], o[rt][ds][1]); ov.y = pk2(o[rt][ds][2], o[rt][ds][3]); *(v2u*)(og + 16 * ds + 4 * fq) = ov; }
    }
}

__device__ __forceinline__ void finalize_unit(const Ctx& p, int l, int u) {
    const int tid = opaque_tid(), lane = tid & 63, w = tid >> 6, hd = lane >> 4;
    const bf16* CP = (const bf16*)(p.ws + WS_CPART); const float* LSE = (const float*)(p.ws + WS_LSE); const bf16* DO = (const bf16*)(p.ws + WS_DOUT); bf16* mixed = (bf16*)(p.ws + WS_MIXED);
    const float* gc = p.in(18) + l * DM + 2 * GW + lane * 8; const float* gd = p.in(18) + l * DM + 3 * GW + lane * 8;
    float gcv[8], gdv[8];
#pragma unroll
    for (int e = 0; e < 8; ++e) { gcv[e] = gc[e]; gdv[e] = gd[e]; }
    for (int tb = 0; tb < 8; tb += 4) {
        v4u a[4], bq[4], cq[4], dv[4]; float l0[4], l1[4], l2[4];
#pragma unroll
        for (int tt = 0; tt < 4; ++tt) {
            const int grow = u * 64 + w * 8 + tb + tt;
            l0[tt] = LSE[((size_t)0 * M + grow) * 4 + hd]; l1[tt] = LSE[((size_t)1 * M + grow) * 4 + hd]; l2[tt] = LSE[((size_t)2 * M + grow) * 4 + hd];
            a[tt] = *(const v4u*)(CP + (size_t)grow * GW + lane * 8); bq[tt] = *(const v4u*)(CP + SEG_STRIDE + (size_t)grow * GW + lane * 8); cq[tt] = *(const v4u*)(CP + 2 * SEG_STRIDE + (size_t)grow * GW + lane * 8);
            dv[tt] = *(const v4u*)(DO + (size_t)grow * GW + lane * 8);
        }
#pragma unroll
        for (int tt = 0; tt < 4; ++tt) {
            const int grow = u * 64 + w * 8 + tb + tt;
            const float L = fmaxf(l0[tt], fmaxf(l1[tt], l2[tt])); float w0 = __expf(l0[tt] - L), w1 = __expf(l1[tt] - L), w2 = __expf(l2[tt] - L); const float inv = 1.0f / (w0 + w1 + w2); w0 *= inv; w1 *= inv; w2 *= inv;
            const unsigned aw[4] = {a[tt].x, a[tt].y, a[tt].z, a[tt].w}, bw[4] = {bq[tt].x, bq[tt].y, bq[tt].z, bq[tt].w}, cw[4] = {cq[tt].x, cq[tt].y, cq[tt].z, cq[tt].w};
            float f[8]; float ss = 0.f;
#pragma unroll
            for (int e = 0; e < 4; ++e) { f[2 * e] = w0 * bflo(aw[e]) + w1 * bflo(bw[e]) + w2 * bflo(cw[e]); f[2 * e + 1] = w0 * bfhi(aw[e]) + w1 * bfhi(bw[e]) + w2 * bfhi(cw[e]); ss += f[2 * e] * f[2 * e] + f[2 * e + 1] * f[2 * e + 1]; }
            ss = wave_sum(ss); float rs = __builtin_amdgcn_rsqf(ss * (1.0f / GW) + EPS);
            v4u ov; ov.x = pk2(f[0] * rs * gcv[0], f[1] * rs * gcv[1]); ov.y = pk2(f[2] * rs * gcv[2], f[3] * rs * gcv[3]); ov.z = pk2(f[4] * rs * gcv[4], f[5] * rs * gcv[5]); ov.w = pk2(f[6] * rs * gcv[6], f[7] * rs * gcv[7]);
            *(v4u*)(mixed + (size_t)grow * DM + 2 * GW + lane * 8) = ov;
            const unsigned dw[4] = {dv[tt].x, dv[tt].y, dv[tt].z, dv[tt].w};
            ss = 0.f;
#pragma unroll
            for (int e = 0; e < 4; ++e) { f[2 * e] = bflo(dw[e]); f[2 * e + 1] = bfhi(dw[e]); ss += f[2 * e] * f[2 * e] + f[2 * e + 1] * f[2 * e + 1]; }
            ss = wave_sum(ss); rs = __builtin_amdgcn_rsqf(ss * (1.0f / GW) + EPS);
            ov.x = pk2(f[0] * rs * gdv[0], f[1] * rs * gdv[1]); ov.y = pk2(f[2] * rs * gdv[2], f[3] * rs * gdv[3]); ov.z = pk2(f[4] * rs * gdv[4], f[5] * rs * gdv[5]); ov.w = pk2(f[6] * rs * gdv[6], f[7] * rs * gdv[7]);
            *(v4u*)(mixed + (size_t)grow * DM + 3 * GW + lane * 8) = ov;
        }
    }
}

#ifndef PROBE_REPEAT
#define PROBE_REPEAT 0
#endif
#ifndef K_ROTATE
#define K_ROTATE 1
#endif
#define KROT(K_) (K_ROTATE ? ((((int)blockIdx.x & 7) * ((K_) / 64 / 8)) & ~1) : 0)
#define REP(k) for (int rep_ = 0; rep_ < (((PROBE_REPEAT) >> (k)) & 1) + 1; ++rep_)
__global__ void __launch_bounds__(NT, 2) fwd_kernel(Params kp) {
    extern __shared__ __attribute__((aligned(16))) unsigned char lds_raw[];
    LAS unsigned char* lds = (LAS unsigned char*)lds_raw;
    volatile LAS unsigned* MISC = (volatile LAS unsigned*)(lds + LDS_MISC_OFF);
    volatile LAS int* qslot = (volatile LAS int*)(MISC + 4);
    const int wid0 = __builtin_amdgcn_readfirstlane((int)threadIdx.x >> 6);
    if (threadIdx.x < 16) MISC[threadIdx.x] = 0u;
    __syncthreads();
    XcdBarrier bar; bar.bar = (unsigned*)(kp.ws + WS_CTL) + CW_BAR; bar.x = 0; bar.st = nullptr;
    if (!MK_SPLIT) bar = xcd_barrier_post((unsigned*)(kp.ws + WS_CTL) + CW_BAR, MISC);
    const int lo = kp.ph_lo, hi = kp.ph_hi;
#define IN(k) (lo <= (k) && (k) < hi)
#define SEAM(k) do { if (IN(k) && IN((k) + 1)) { if (!MK_SPLIT) xcd_barrier(bar); } } while (0)
#define CTX() const Ctx p = make_ctx(wid0); unsigned* ctl = (unsigned*)(p.ws + WS_CTL); unsigned long long* ssq = (unsigned long long*)(p.ws + WS_SSQ); bf16* xb = (bf16*)(p.ws + WS_XB); bf16* act = (bf16*)(p.ws + WS_PACT); bf16* mixed = (bf16*)(p.ws + WS_MIXED); \
    unsigned long long* ssqA = ssq + (size_t)(3 * l) * M; unsigned long long* ssqB = ssq + (size_t)(3 * l + 1) * M; unsigned long long* ssqC = ssq + (size_t)(3 * l + 2) * M; unsigned long long* ssqN = ssq + (size_t)(3 * l + 3) * M; \
    (void)ctl; (void)xb; (void)act; (void)mixed; (void)ssqA; (void)ssqB; (void)ssqC; (void)ssqN

    if (IN(0)) { const Ctx p = make_ctx(wid0); prologue_x(p); }
    for (int l = 0; l < NLAYER; ++l) {
        const int pb = 1 + l * PH_PER_LAYER;
        if (IN(pb + 0)) REP(0) { const Ctx p = make_ctx(wid0); convert_layer(p, l, -1); }
        SEAM(pb + 0);
        if (IN(pb + 1)) REP(4) { CTX(); if (rep_) xcd_barrier(bar);
            pg8::Gemm g{xb, (const bf16*)(p.ws + WS_WGU1), M, 2 * DFF, DM, KROT(DM)}; pg8::StaticOrder S; S.init(M, 2 * DFF, (int)gridDim.x, (int)blockIdx.x);
            pg8::EpiSwiglu E{act, DFF, ssqA, 1.0f / (DM * pg8::SSQ_FX)};
            pg8::gemm_phase<pg8::EpiSwiglu, pg8::StaticOrder, PG8_ALIGN, PG8_SP2>(lds, g, S, E, wid0);
        }
        SEAM(pb + 1);
#if (PROBE_REPEAT >> 6) & 1
        if (IN(pb + 2)) { CTX();
            pg8::Gemm g{act, (const bf16*)(p.ws + WS_WD1), M, DM, DFF, KROT(DFF)}; pg8::StaticOrder S; S.init(M, DM, (int)gridDim.x, (int)blockIdx.x);
            pg8::EpiResid E{xb, nullptr, xb, nullptr, DM, 0.25f};
            pg8::gemm_phase<pg8::EpiResid, pg8::StaticOrder, PG8_ALIGN, PG8_SP2>(lds, g, S, E, wid0);
            xcd_barrier(bar);
        }
        if (IN(pb + 2)) { CTX();
            pg8::Gemm g{act, (const bf16*)(p.ws + WS_WD1), M, DM, DFF, KROT(DFF)}; pg8::StaticOrder S; S.init(M, DM, (int)gridDim.x, (int)blockIdx.x);
            pg8::EpiResid E{xb, nullptr, xb, ssqB, DM, 0.25f};
            pg8::gemm_phase<pg8::EpiResid, pg8::StaticOrder, PG8_ALIGN, PG8_SP2>(lds, g, S, E, wid0);
        }
#else
        if (IN(pb + 2)) { CTX();
            pg8::Gemm g{act, (const bf16*)(p.ws + WS_WD1), M, DM, DFF, KROT(DFF)}; pg8::StaticOrder S; S.init(M, DM, (int)gridDim.x, (int)blockIdx.x);
            pg8::EpiResid E{xb, nullptr, xb, ssqB, DM, 0.5f};
            pg8::gemm_phase<pg8::EpiResid, pg8::StaticOrder, PG8_ALIGN, PG8_SP2>(lds, g, S, E, wid0);
        }
#endif
        SEAM(pb + 2);
        if (IN(pb + 3)) REP(5) { CTX(); if (rep_) xcd_barrier(bar);
            pg8::Gemm g{xb, (const bf16*)(p.ws + WS_WIN), M, NP, DM, KROT(DM)}; pg8::StaticOrder S; S.init(M, NP, (int)gridDim.x, (int)blockIdx.x);
            pg8::EpiSplit E{act, SEG_STRIDE, ssqB, 1.0f / (DM * pg8::SSQ_FX)};
            pg8::gemm_phase<pg8::EpiSplit, pg8::StaticOrder, PG8_ALIGN, PG8_SP2>(lds, g, S, E, wid0);
            gates_phase(p, l, ssqB, lds);
        }
        SEAM(pb + 3);
        if (IN(pb + 4)) REP(1) { CTX(); if (rep_) xcd_barrier(bar);
            for (int u = (int)blockIdx.x; u < 768; u += (int)gridDim.x) { __syncthreads(); dilated_unit(p, l, u, lds); }
            for (int u = (int)blockIdx.x; u < 1024; u += (int)gridDim.x) { __syncthreads(); mlstm1_unit(p, l, u, lds); }
            for (int u = (int)blockIdx.x; u < 1024; u += (int)gridDim.x) { __syncthreads(); lru_unit<1>(p, l, u, lds); }
        }
        SEAM(pb + 4);
        if (IN(pb + 5)) REP(2) { CTX(); if (rep_) xcd_barrier(bar);
            unsigned* ctr = ctl + CW_Q + 64 * (pb + 5 + 32 * rep_);
            for (int u = q_next(p, ctr, qslot); u < 132 + 256; u = q_next(p, ctr, qslot)) {
                if (u < 4) lru_carry_unit(p, u);
                else if (u < 132) mlstm_scan_unit(p, u - 4);
                else stick_unit(p, u - 132, lds);
            }
        }
        SEAM(pb + 5);
        if (IN(pb + 6)) REP(3) { CTX(); if (rep_) xcd_barrier(bar);
            for (int u = (int)blockIdx.x; u < 1024; u += (int)gridDim.x) { __syncthreads(); mlstm3_unit(p, l, u, lds); }
            for (int u = (int)blockIdx.x; u < 1024; u += (int)gridDim.x) { __syncthreads(); lru_unit<3>(p, l, u, lds); }
            for (int u = (int)blockIdx.x; u < 256; u += (int)gridDim.x) { __syncthreads(); finalize_unit(p, l, u); }
        }
        SEAM(pb + 6);
#if (PROBE_REPEAT >> 7) & 1
        for (int xb_ = 0; xb_ < 20; ++xb_) xcd_barrier(bar);
#endif
        if (IN(pb + 7)) { CTX();
            pg8::Gemm g{mixed, (const bf16*)(p.ws + WS_WOUT), M, DM, DM, KROT(DM)}; pg8::StaticOrder S; S.init(M, DM, (int)gridDim.x, (int)blockIdx.x);
            pg8::EpiResid E{xb, nullptr, xb, ssqC, DM, 1.0f};
            pg8::gemm_phase<pg8::EpiResid, pg8::StaticOrder, PG8_ALIGN, PG8_SP2>(lds, g, S, E, wid0);
        }
        SEAM(pb + 7);
        if (IN(pb + 8)) { CTX();
            pg8::Gemm g{xb, (const bf16*)(p.ws + WS_WGU2), M, 2 * DFF, DM, KROT(DM)}; pg8::StaticOrder S; S.init(M, 2 * DFF, (int)gridDim.x, (int)blockIdx.x);
            pg8::EpiSwiglu E{act, DFF, ssqC, 1.0f / (DM * pg8::SSQ_FX)};
            pg8::gemm_phase<pg8::EpiSwiglu, pg8::StaticOrder, PG8_ALIGN, PG8_SP2>(lds, g, S, E, wid0);
        }
        SEAM(pb + 8);
        if (IN(pb + 9)) { CTX();
            pg8::Gemm g{act, (const bf16*)(p.ws + WS_WD2), M, DM, DFF, KROT(DFF)}; pg8::StaticOrder S; S.init(M, DM, (int)gridDim.x, (int)blockIdx.x);
            const bool lastl = (l == NLAYER - 1);
            pg8::EpiResid E{xb, lastl ? p.out : nullptr, lastl ? nullptr : xb, lastl ? nullptr : ssqN, DM, 0.5f};
            pg8::gemm_phase<pg8::EpiResid, pg8::StaticOrder, PG8_ALIGN, PG8_SP2>(lds, g, S, E, wid0);
        }
        SEAM(pb + 9);
    }
#undef IN
#undef SEAM
#undef CTX
}

extern "C" void kernel_launch(void* const* d_in, const int* in_sizes, int n_in, void* d_out, int out_size, void* d_ws, size_t ws_size, hipStream_t stream) {
    static int grid = 0;
    if (grid == 0) {
        if (n_in != 24 || in_sizes[0] != M * DM || out_size != M * DM || ws_size < WS_END) { fprintf(stderr, "kernel_launch: unexpected shapes (n_in %d, in0 %d, out %d, ws %zu < %zu)\n", n_in, n_in > 0 ? in_sizes[0] : -1, out_size, ws_size, (size_t)WS_END); grid = -1; return; }
        int dev = 0, cus = 0, per_cu = 0;
        if (hipGetDevice(&dev) != hipSuccess || hipDeviceGetAttribute(&cus, hipDeviceAttributeMultiprocessorCount, dev) != hipSuccess) { grid = -1; return; }
        if (hipFuncSetAttribute((const void*)fwd_kernel, hipFuncAttributeMaxDynamicSharedMemorySize, LDS_BYTES) != hipSuccess) { fprintf(stderr, "kernel_launch: hipFuncSetAttribute failed\n"); grid = -1; return; }
        if (hipOccupancyMaxActiveBlocksPerMultiprocessor(&per_cu, (const void*)fwd_kernel, NT, LDS_BYTES) != hipSuccess || per_cu < 1) { fprintf(stderr, "kernel_launch: occupancy query says %d\n", per_cu); (void)hipGetLastError(); }
        grid = cus;
    }
    if (grid < 0) return;
    (void)hipMemsetAsync((char*)d_ws + WS_CTL, 0, CTL_ZERO_BYTES, stream);
    Params a{};
    for (int i = 0; i < 24; ++i) a.in[i] = (const float*)d_in[i];
    a.out = (float*)d_out; a.ws = (unsigned char*)d_ws;
#if MK_SPLIT
    for (int ph = 0; ph < N_PHASES; ++ph) { a.ph_lo = ph; a.ph_hi = ph + 1; hipLaunchKernelGGL(fwd_kernel, dim3(grid), dim3(NT), LDS_BYTES, stream, a); }
#else
    a.ph_lo = 0; a.ph_hi = N_PHASES;
    hipLaunchKernelGGL(fwd_kernel, dim3(grid), dim3(NT), LDS_BYTES, stream, a);
#endif
}
```

```cpp
#include <hip/hip_runtime.h>
#include <cstdio>
#include <cstdint>
#define LAS __attribute__((address_space(3)))
namespace pg8 {
#define PG8_LAS __attribute__((address_space(3)))
typedef unsigned short bf16_t;
typedef short bf16x8 __attribute__((ext_vector_type(8)));
typedef float f32x4 __attribute__((ext_vector_type(4)));
typedef unsigned u32x4 __attribute__((ext_vector_type(4)));
typedef int i32x4 __attribute__((ext_vector_type(4)));
typedef int i32x8 __attribute__((ext_vector_type(8)));
__device__ __forceinline__ i32x8 cat8(bf16x8 lo, bf16x8 hi) { const i32x4 a = __builtin_bit_cast(i32x4, lo), b = __builtin_bit_cast(i32x4, hi); return __builtin_shufflevector(a, b, 0, 1, 2, 3, 4, 5, 6, 7); }
__device__ __forceinline__ void mfma_f8(f32x4& acc, i32x8 a, i32x8 b) { asm volatile("v_mfma_f32_16x16x128_f8f6f4 %0, %1, %2, %0" : "+v"(acc) : "v"(a), "v"(b)); }
constexpr float F8_ACT_SCALE = 4.0f, F8_W_SCALE = 64.0f;
__host__ __device__ constexpr bool ffn_f8(int l, int f) { return l == 1; }
__host__ __device__ constexpr bool ffn_gu_f8(int l, int f) { return false; }
constexpr int DFF_P = 5632;
constexpr int BM = 256, BK = 64, HALF = 128, HTB = HALF * BK * 2  , STAGE_BYTES = 8 * HTB, NXCD = 8, WGM = 4;

__host__ __device__ __forceinline__ int lds_byte(int r, int c) { const int st = (r >> 4) * 2 + (c >> 5), rr = r & 15, cc = c & 31, ob = rr * 64 + cc * 2; return st * 1024 + (ob ^ (((ob >> 9) & 1) << 5)); }
__host__ __device__ __forceinline__ void stage_rc(int b, int& R, int& C) { const int st = b / 1024, sb = b % 1024, swz = sb ^ (((sb >> 9) & 1) << 5); R = (st >> 1) * 16 + swz / 64; C = (st & 1) * 32 + (swz % 64) / 2; }
__host__ __device__ __forceinline__ int perm32(int rho) { const int n = rho >> 4, i = rho & 15; return 8 * (i >> 2) + 4 * n + (i & 3); }

struct Unit { int pm, pn; };
struct Gemm { const bf16_t* A; const bf16_t* Bt; int M, N, K, rot; };

struct StaticOrder {
    int nM, nN, nwg, G, c;
    __host__ __device__ void init(int M, int N, int G_, int c_) { nM = M / BM; nN = N / BM; nwg = nM * nN; G = G_; c = c_; }
    __host__ __device__ bool next(int i, Unit& u) const {
        const long L = (long)i * G + c; if (L >= nwg) return false;
        int wgid = (int)L; { const int q = nwg / NXCD, r = nwg % NXCD, xcd = wgid % NXCD, off = wgid / NXCD; wgid = (xcd < r ? xcd * (q + 1) : r * (q + 1) + (xcd - r) * q) + off; }
        const int nig = WGM * nN, gid = wgid / nig, fm = gid * WGM, gsz = (nM - fm) < WGM ? (nM - fm) : WGM;
        u.pm = fm + ((wgid % nig) % gsz); u.pn = (wgid % nig) / gsz; return true;
    }
    __device__ __forceinline__ void a_ready(const Unit&) const {}
    __device__ __forceinline__ void done(const Unit&) const {}
};

__device__ __forceinline__ unsigned cvt_pk_bf16(float lo, float hi) { unsigned r; asm volatile("v_cvt_pk_bf16_f32 %0, %1, %2" : "=v"(r) : "v"(lo), "v"(hi)); return r; }

typedef float f32x2 __attribute__((ext_vector_type(2)));
constexpr float RMS_EPS_F = 1e-6f, SSQ_FX = 1048576.0f;
typedef __bf16 bf16x2_cv __attribute__((ext_vector_type(2)));
__device__ __forceinline__ unsigned cvt_pk_bf16_nv(f32x2 v) { return __builtin_bit_cast(unsigned, __builtin_convertvector(v, bf16x2_cv)); }
template <bool F8, bool I8 = false> struct EpiSwigluT {
    static constexpr bool PERM = true, AFTER_DRAIN = false;
    bf16_t* O; int ldc; const unsigned long long* ssq; float inv_d; float in_scale; const float* rowscale; const float* colscale;
    __device__ __forceinline__ void operator()(const f32x4 (&acc)[2][2][4][2], const Unit& u, int wr, int wc, int fr, int fq) const {
        const int row0 = u.pm * BM + wr * 64 + fr, col0 = u.pn * HALF + wc * 32 + 8 * fq;
        f32x2 cg[4], cu[4];
        if constexpr (I8) {
#pragma unroll
            for (int e = 0; e < 4; ++e) { cg[e] = *(const f32x2*)(colscale + u.pn * BM + wc * 32 + 8 * fq + 2 * e); cu[e] = *(const f32x2*)(colscale + u.pn * BM + HALF + wc * 32 + 8 * fq + 2 * e); }
        }
#pragma unroll
        for (int ai = 0; ai < 2; ++ai) {
            float rs[4];
#pragma unroll
            for (int m = 0; m < 4; ++m) { rs[m] = __builtin_amdgcn_rsqf((float)ssq[row0 + ai * HALF + m * 16] * inv_d + RMS_EPS_F) * in_scale; if constexpr (I8) rs[m] *= rowscale[row0 + ai * HALF + m * 16]; }
#pragma unroll
            for (int mp = 0; mp < 4; mp += 2) {
                f32x2 g[8], gu[8], e[8];
#pragma unroll
                for (int q = 0; q < 8; ++q) { const int m = mp + (q >> 2), n = (q >> 1) & 1, hh = q & 1;
                    g[q] = (f32x2){acc[ai][0][m][n][2 * hh], acc[ai][0][m][n][2 * hh + 1]}; gu[q] = (f32x2){acc[ai][1][m][n][2 * hh], acc[ai][1][m][n][2 * hh + 1]};
                    if constexpr (I8) { const i32x4 gi = __builtin_bit_cast(i32x4, acc[ai][0][m][n]), ui = __builtin_bit_cast(i32x4, acc[ai][1][m][n]);
                        g[q] = (f32x2){(float)gi[2 * hh], (float)gi[2 * hh + 1]} * cg[2 * n + hh]; gu[q] = (f32x2){(float)ui[2 * hh], (float)ui[2 * hh + 1]} * cu[2 * n + hh]; } }
#pragma unroll
                for (int q = 0; q < 8; ++q) { const float c = -rs[mp + (q >> 2)] * 1.4426950408889634f; const f32x2 a = g[q] * (f32x2){c, c}; e[q].x = __builtin_amdgcn_exp2f(a.x); e[q].y = __builtin_amdgcn_exp2f(a.y); }
#pragma unroll
                for (int q = 0; q < 8; ++q) { const float c2 = rs[mp + (q >> 2)] * rs[mp + (q >> 2)] * (F8 ? F8_ACT_SCALE : 1.0f); gu[q] = (g[q] * gu[q]) * (f32x2){c2, c2}; }
#pragma unroll
                for (int q = 0; q < 8; ++q) { const f32x2 d = e[q] + (f32x2){1.0f, 1.0f}; e[q].x = __builtin_amdgcn_rcpf(d.x); e[q].y = __builtin_amdgcn_rcpf(d.y); }
#pragma unroll
                for (int mm = 0; mm < 2; ++mm) {
                    if constexpr (F8) {
                        typedef unsigned u32x2v __attribute__((ext_vector_type(2)));
                        const f32x2 h0 = gu[4 * mm + 0] * e[4 * mm + 0], h1 = gu[4 * mm + 1] * e[4 * mm + 1], h2 = gu[4 * mm + 2] * e[4 * mm + 2], h3 = gu[4 * mm + 3] * e[4 * mm + 3];
                        u32x2v w; w.x = (unsigned)__builtin_amdgcn_cvt_pk_fp8_f32(h1.x, h1.y, __builtin_amdgcn_cvt_pk_fp8_f32(h0.x, h0.y, 0, false), true);
                        w.y = (unsigned)__builtin_amdgcn_cvt_pk_fp8_f32(h3.x, h3.y, __builtin_amdgcn_cvt_pk_fp8_f32(h2.x, h2.y, 0, false), true);
                        unsigned char* o8 = (unsigned char*)O + (size_t)(row0 + ai * HALF + (mp + mm) * 16) * ldc + col0;
                        *(u32x2v*)o8 = w;
                        if (u.pn * HALF + HALF == DFF_P - HALF) { unsigned z = 0u; asm("" : "+v"(z)); *(u32x2v*)(o8 + HALF) = (u32x2v){z, z}; }
                        continue;
                    }
                    u32x4 w; w.x = cvt_pk_bf16_nv(gu[4 * mm + 0] * e[4 * mm + 0]); w.y = cvt_pk_bf16_nv(gu[4 * mm + 1] * e[4 * mm + 1]); w.z = cvt_pk_bf16_nv(gu[4 * mm + 2] * e[4 * mm + 2]); w.w = cvt_pk_bf16_nv(gu[4 * mm + 3] * e[4 * mm + 3]);
                    *(u32x4*)(O + (size_t)(row0 + ai * HALF + (mp + mm) * 16) * ldc + col0) = w;
                }
            }
        }
    }
};
typedef EpiSwigluT<false> EpiSwiglu; typedef EpiSwigluT<true> EpiSwigluF8; typedef EpiSwigluT<false, true> EpiSwigluI8; typedef EpiSwigluT<true, true> EpiSwigluF8I8;
struct EpiResid {
    static constexpr bool PERM = false, AFTER_DRAIN = false;
    const bf16_t* base; float* out; bf16_t* xb; unsigned long long* ssq; int ldc; float alpha; unsigned char* x8;
    __device__ __forceinline__ void operator()(const f32x4 (&acc)[2][2][4][2], const Unit& u, int wr, int wc, int fr, int fq) const {
        typedef unsigned u32x2v __attribute__((ext_vector_type(2)));
        const int row0 = u.pm * BM + wr * 64 + fr, col0 = u.pn * BM + wc * 32 + 4 * fq;
#pragma unroll
        for (int ai = 0; ai < 2; ++ai) {
            u32x2v b4[4][2][2];
#pragma unroll
            for (int m = 0; m < 4; ++m)
#pragma unroll
                for (int bj = 0; bj < 2; ++bj)
#pragma unroll
                    for (int n = 0; n < 2; ++n) b4[m][bj][n] = *(const u32x2v*)(base + (size_t)(row0 + ai * HALF + m * 16) * ldc + col0 + bj * HALF + n * 16);
#pragma unroll
            for (int m = 0; m < 4; ++m) {
                const int row = row0 + ai * HALF + m * 16; const size_t off = (size_t)row * ldc + col0; float s = 0.f;
#pragma unroll
                for (int bj = 0; bj < 2; ++bj)
#pragma unroll
                    for (int n = 0; n < 2; ++n) {
                        const u32x2v bb = b4[m][bj][n];
                        const f32x4 bf = {__builtin_bit_cast(float, bb.x << 16), __builtin_bit_cast(float, bb.x & 0xffff0000u), __builtin_bit_cast(float, bb.y << 16), __builtin_bit_cast(float, bb.y & 0xffff0000u)};
                        const f32x4 o = bf + acc[ai][bj][m][n] * alpha;
                        if (out) *(f32x4*)(out + off + bj * HALF + n * 16) = o;
                        if (xb) { u32x2v w; w.x = cvt_pk_bf16(o[0], o[1]); w.y = cvt_pk_bf16(o[2], o[3]); *(u32x2v*)(xb + off + bj * HALF + n * 16) = w; }
                        if (x8) *(unsigned*)(x8 + off + bj * HALF + n * 16) = (unsigned)__builtin_amdgcn_cvt_pk_fp8_f32(o[2], o[3], __builtin_amdgcn_cvt_pk_fp8_f32(o[0], o[1], 0, false), true);
                        s += (o[0] * o[0] + o[1] * o[1]) + (o[2] * o[2] + o[3] * o[3]);
                    }
                if (ssq) { s += __shfl_xor(s, 16); s += __shfl_xor(s, 32); if (fq == 0) atomicAdd(ssq + row, (unsigned long long)(s * SSQ_FX + 0.5f)); }
            }
            asm volatile("" ::: "memory");
        }
    }
};
struct EpiSplit {
    static constexpr bool PERM = true, AFTER_DRAIN = false;
    bf16_t* O; size_t seg_stride; const unsigned long long* ssq; float inv_d;
    __device__ __forceinline__ void operator()(const f32x4 (&acc)[2][2][4][2], const Unit& u, int wr, int wc, int fr, int fq) const {
        const int colt = u.pn * BM, seg = colt >> 9, cin = colt & 511;
        bf16_t* base = O + (size_t)seg * seg_stride;
        const int row0 = u.pm * BM + wr * 64 + fr, col0 = cin + wc * 32 + 8 * fq;
#pragma unroll
        for (int ai = 0; ai < 2; ++ai)
#pragma unroll
            for (int m = 0; m < 4; ++m) {
                const int row = row0 + ai * HALF + m * 16;
                const float rs = __builtin_amdgcn_rsqf((float)ssq[row] * inv_d + RMS_EPS_F);
#pragma unroll
                for (int bj = 0; bj < 2; ++bj) {
                    const f32x4 v0 = acc[ai][bj][m][0] * rs, v1 = acc[ai][bj][m][1] * rs;
                    u32x4 w; w.x = cvt_pk_bf16(v0[0], v0[1]); w.y = cvt_pk_bf16(v0[2], v0[3]); w.z = cvt_pk_bf16(v1[0], v1[1]); w.w = cvt_pk_bf16(v1[2], v1[3]);
                    *(u32x4*)(base + (size_t)row * 512 + col0 + bj * HALF) = w;
                }
            }
    }
};
template <class Epi, class Sched, bool ALIGN_EPI = false, bool SP2 = false, bool F8 = false, bool I8 = false>
__device__ __forceinline__ void gemm_phase(PG8_LAS unsigned char* lds, const Gemm g, const Sched& S, const Epi& E, int wid0) {
    unsigned z_ = 0u; asm volatile("" : "+v"(z_)); int tid_ = (wid0 << 6) | (int)__builtin_amdgcn_mbcnt_hi(~0u, __builtin_amdgcn_mbcnt_lo(~0u, z_)); asm volatile("" : "+v"(tid_));
    const int tid = tid_, wid = __builtin_amdgcn_readfirstlane(tid >> 6), lane = tid & 63, wr = wid >> 2, wc = wid & 3, fr = lane & 15, fq = lane >> 4;
    const int K = g.K, nt = K / BK;
    const int rot = g.rot; const size_t rotoff = (size_t)rot * (size_t)(BK * 2);
    unsigned voffA[2], voffB[2];
#pragma unroll
    for (int i = 0; i < 2; ++i) { int R, C; stage_rc(tid * 16 + i * 8192, R, C); const int Rb = Epi::PERM ? ((R & ~31) + perm32(R & 31)) : R;
        voffA[i] = (unsigned)(R * K + C) * 2u; voffB[i] = (unsigned)(Rb * K + C) * 2u; }
    const size_t kstep = (size_t)(BK * 2);
    const size_t hstep = (size_t)HALF * K * 2;
    const size_t tstep = 2 * hstep;
    const unsigned ldsw = (unsigned)wid * 1024u;
    const int aoff = lds_byte(wr * 64 + fr, fq * 8), boff = lds_byte(wc * 32 + fr, fq * 8);
#define PG8_SA(b, h) (((b) * 2 + (h)) * HTB)
#define PG8_SB(b, h) ((4 + (b) * 2 + (h)) * HTB)
#define PG8_STAGE(bufoff, gbase, voff) do { _Pragma("unroll") for (int _i = 0; _i < 2; ++_i) { \
        asm("" : "+v"((voff)[_i]));     \
        __builtin_amdgcn_global_load_lds((const unsigned*)((const char*)(gbase) + (voff)[_i]), (PG8_LAS unsigned*)(lds + (bufoff) + ldsw + _i * 8192), 16, 0, 0); } } while (0)
#define PG8_LDA(dst, b, h) do { _Pragma("unroll") for (int m = 0; m < 4; ++m) _Pragma("unroll") for (int k = 0; k < 2; ++k) dst[m][k] = *(const PG8_LAS bf16x8*)(lds + PG8_SA(b, h) + aoff + m * 2048 + k * 1024); } while (0)
#define PG8_LDB(dst, b, h) do { _Pragma("unroll") for (int n = 0; n < 2; ++n) _Pragma("unroll") for (int k = 0; k < 2; ++k) dst[n][k] = *(const PG8_LAS bf16x8*)(lds + PG8_SB(b, h) + boff + n * 2048 + k * 1024); } while (0)
#define PG8_MMA(ai, bj, At, Bt) do { __builtin_amdgcn_s_setprio(1); _Pragma("unroll") for (int m = 0; m < 4; ++m) _Pragma("unroll") for (int n = 0; n < 2; ++n) { \
        if constexpr (F8) mfma_f8(acc[ai][bj][m][n], cat8(Bt[n][0], Bt[n][1]), cat8(At[m][0], At[m][1])); \
        else if constexpr (I8) { _Pragma("unroll") for (int k = 0; k < 2; ++k) acc[ai][bj][m][n] = __builtin_bit_cast(f32x4, __builtin_amdgcn_mfma_i32_16x16x64_i8(__builtin_bit_cast(i32x4, Bt[n][k]), __builtin_bit_cast(i32x4, At[m][k]), __builtin_bit_cast(i32x4, acc[ai][bj][m][n]), 0, 0, 0)); } \
        else { _Pragma("unroll") for (int k = 0; k < 2; ++k) acc[ai][bj][m][n] = __builtin_amdgcn_mfma_f32_16x16x32_bf16(Bt[n][k], At[m][k], acc[ai][bj][m][n], 0, 0, 0); } } \
        __builtin_amdgcn_s_setprio(0); } while (0)
#define PG8_WAIT_V(n) asm volatile("s_waitcnt vmcnt(" #n ")" ::: "memory")
#define PG8_WAIT_L(n) asm volatile("s_waitcnt lgkmcnt(" #n ")" ::: "memory")
#define PG8_BAR __builtin_amdgcn_s_barrier()
#define PG8_SCHED __builtin_amdgcn_sched_barrier(0)
    Unit cur, nxt; int ui = 0;
    if (!S.next(0, cur)) return;
    f32x4 acc[2][2][4][2];
#pragma unroll
    for (int a = 0; a < 2; ++a)
#pragma unroll
        for (int b = 0; b < 2; ++b)
#pragma unroll
            for (int m = 0; m < 4; ++m)
#pragma unroll
                for (int n = 0; n < 2; ++n) acc[a][b][m][n] = (f32x4){0.f, 0.f, 0.f, 0.f};
    bf16x8 At[4][2], B0[2][2], B1[2][2];
    const char* cA = (const char*)g.A + (size_t)cur.pm * tstep; const char* cB = (const char*)g.Bt + (size_t)cur.pn * tstep;
    S.a_ready(cur);
    if constexpr (SP2) {
        PG8_STAGE(PG8_SB(0, 0), cB + rotoff, voffB); PG8_STAGE(PG8_SB(0, 1), cB + rotoff + hstep, voffB); PG8_STAGE(PG8_SA(0, 0), cA + rotoff, voffA); PG8_STAGE(PG8_SA(0, 1), cA + rotoff + hstep, voffA);
        if (wr == 1) PG8_BAR;
        PG8_WAIT_V(2); PG8_BAR;
        PG8_STAGE(PG8_SB(1, 0), cB + rotoff + kstep, voffB); PG8_STAGE(PG8_SA(1, 0), cA + rotoff + kstep, voffA); PG8_STAGE(PG8_SB(1, 1), cB + rotoff + hstep + kstep, voffB);
        PG8_WAIT_V(6); PG8_BAR;
    } else {
        PG8_STAGE(PG8_SB(0, 0), cB + rotoff, voffB); PG8_STAGE(PG8_SA(0, 0), cA + rotoff, voffA); PG8_STAGE(PG8_SB(0, 1), cB + rotoff + hstep, voffB); PG8_STAGE(PG8_SA(0, 1), cA + rotoff + hstep, voffA);
        if (wr == 1) PG8_BAR;
        PG8_WAIT_V(4); PG8_BAR;
        PG8_STAGE(PG8_SB(1, 0), cB + rotoff + kstep, voffB); PG8_STAGE(PG8_SA(1, 0), cA + rotoff + kstep, voffA); PG8_STAGE(PG8_SB(1, 1), cB + rotoff + hstep + kstep, voffB);
        PG8_WAIT_V(6); PG8_BAR;
    }
    for (;;) {
        const bool has_next = S.next(ui + 1, nxt);
        const char* nA = has_next ? (const char*)g.A + (size_t)nxt.pm * tstep : cA; const char* nB = has_next ? (const char*)g.Bt + (size_t)nxt.pn * tstep : cB;
        for (int t = 0; t < nt; t += 2) {
            const bool last = (t == nt - 2);
            int pt = t + rot; if (pt >= nt) pt -= nt; int pt2 = pt + 2; if (pt2 >= nt) pt2 -= nt;
            const char* a1 = cA + (size_t)(pt + 1) * kstep;
            const char* a2 = last ? nA + rotoff : cA + (size_t)pt2 * kstep; const char* b2 = last ? nB + rotoff : cB + (size_t)pt2 * kstep;
            const char* a3 = a2 + kstep; const char* b3 = b2 + kstep;
            if (last && has_next) S.a_ready(nxt);
            if constexpr (SP2) {
            PG8_LDB(B0, 0, 0); PG8_LDB(B1, 0, 1); PG8_SCHED; PG8_LDA(At, 0, 0); PG8_STAGE(PG8_SA(1, 1), a1 + hstep, voffA);
            PG8_WAIT_V(8); PG8_WAIT_L(0); PG8_BAR; PG8_MMA(0, 0, At, B0); PG8_MMA(0, 1, At, B1); PG8_BAR; PG8_SCHED;
            PG8_LDA(At, 0, 1); PG8_STAGE(PG8_SB(0, 0), b2, voffB); PG8_STAGE(PG8_SB(0, 1), b2 + hstep, voffB); PG8_STAGE(PG8_SA(0, 0), a2, voffA);
            PG8_WAIT_V(8); PG8_WAIT_L(0); PG8_BAR; PG8_MMA(1, 0, At, B0); PG8_MMA(1, 1, At, B1); PG8_BAR; PG8_SCHED;
            PG8_LDB(B0, 1, 0); PG8_LDB(B1, 1, 1); PG8_SCHED; PG8_LDA(At, 1, 0); PG8_STAGE(PG8_SA(0, 1), a2 + hstep, voffA);
            PG8_WAIT_V(8); PG8_WAIT_L(0); PG8_BAR; PG8_MMA(0, 0, At, B0); PG8_MMA(0, 1, At, B1); PG8_BAR; PG8_SCHED;
            PG8_LDA(At, 1, 1); PG8_STAGE(PG8_SB(1, 0), b3, voffB); PG8_STAGE(PG8_SB(1, 1), b3 + hstep, voffB); PG8_STAGE(PG8_SA(1, 0), a3, voffA);
            PG8_WAIT_V(8); PG8_WAIT_L(0); PG8_BAR; PG8_MMA(1, 0, At, B0); PG8_MMA(1, 1, At, B1); PG8_BAR; PG8_SCHED;
            } else {
            PG8_LDB(B0, 0, 0); PG8_SCHED; PG8_LDA(At, 0, 0); PG8_STAGE(PG8_SA(1, 1), a1 + hstep, voffA);
            PG8_WAIT_L(8); PG8_BAR; PG8_WAIT_L(0); PG8_MMA(0, 0, At, B0); PG8_BAR; PG8_SCHED;
            PG8_LDB(B1, 0, 1); PG8_STAGE(PG8_SB(0, 0), b2, voffB);
            PG8_BAR; PG8_WAIT_L(0); PG8_MMA(0, 1, At, B1); PG8_BAR;
            PG8_LDA(At, 0, 1); PG8_STAGE(PG8_SA(0, 0), a2, voffA);
            PG8_BAR; PG8_WAIT_L(0); PG8_MMA(1, 0, At, B0); PG8_BAR; PG8_SCHED;
            PG8_STAGE(PG8_SB(0, 1), b2 + hstep, voffB);
            PG8_WAIT_V(6); PG8_BAR; PG8_MMA(1, 1, At, B1); PG8_BAR;
            PG8_LDB(B0, 1, 0); PG8_SCHED; PG8_LDA(At, 1, 0); PG8_STAGE(PG8_SA(0, 1), a2 + hstep, voffA);
            PG8_WAIT_L(8); PG8_BAR; PG8_WAIT_L(0); PG8_MMA(0, 0, At, B0); PG8_BAR; PG8_SCHED;
            PG8_LDB(B1, 1, 1); PG8_STAGE(PG8_SB(1, 0), b3, voffB);
            PG8_BAR; PG8_WAIT_L(0); PG8_MMA(0, 1, At, B1); PG8_BAR;
            PG8_LDA(At, 1, 1); PG8_STAGE(PG8_SA(1, 0), a3, voffA);
            PG8_BAR; PG8_WAIT_L(0); PG8_MMA(1, 0, At, B0); PG8_BAR; PG8_SCHED;
            PG8_STAGE(PG8_SB(1, 1), b3 + hstep, voffB);
            PG8_WAIT_V(6); PG8_BAR; PG8_MMA(1, 1, At, B1); PG8_BAR;
            }
        }
        if constexpr (ALIGN_EPI) { if (wr == 0) PG8_BAR; }
        if constexpr (!Epi::AFTER_DRAIN) { E(acc, cur, wr, wc, fr, fq); S.done(cur); }
        if (!has_next) break;
#pragma unroll
        for (int a = 0; a < 2; ++a)
#pragma unroll
            for (int b = 0; b < 2; ++b)
#pragma unroll
                for (int m = 0; m < 4; ++m)
#pragma unroll
                    for (int n = 0; n < 2; ++n) acc[a][b][m][n] = (f32x4){0.f, 0.f, 0.f, 0.f};
        cur = nxt; cA = nA; cB = nB; ++ui;
        if constexpr (ALIGN_EPI) { if (wr == 1) PG8_BAR; }
    }
    PG8_WAIT_V(0);
    if constexpr (!ALIGN_EPI) { if (wr == 0) PG8_BAR; }
    PG8_BAR;
    if constexpr (Epi::AFTER_DRAIN) { E.fused(acc, cur, wr, wc, fr, fq, lds, wid, lane); S.done(cur); }
#undef PG8_SA
#undef PG8_SB
#undef PG8_STAGE
#undef PG8_LDA
#undef PG8_LDB
#undef PG8_MMA
#undef PG8_WAIT_V
#undef PG8_WAIT_L
#undef PG8_BAR
#undef PG8_SCHED
}
}
#define XB_TMO      128
#define XB_XCNT(j)  (256  + 64 * (j))
#define XB_XSUB(j)  (1280 + 64 * (j))
#define XB_XGEN(j)  (2304 + 64 * (j))
#define XB_TOP      3328
#define XB_TOPGEN   3392
#define XCD_BAR_WORDS 3456
#define XB_PTOP(q)  (3456 + 64 * (q))
#define XB_PGEN(q)  (3712 + 64 * (q))
#define XB_SPIN_CAP (1u << 18)

__device__ __forceinline__ unsigned xb_ld(unsigned* p)              { return __hip_atomic_load(p, __ATOMIC_RELAXED, __HIP_MEMORY_SCOPE_AGENT); }
__device__ __forceinline__ unsigned xb_add(unsigned* p, unsigned v) { return __hip_atomic_fetch_add(p, v, __ATOMIC_RELAXED, __HIP_MEMORY_SCOPE_AGENT); }
__device__ __forceinline__ unsigned xb_xcc_id() { return (unsigned)__builtin_amdgcn_s_getreg((3 << 11) | 20) & 0xFu; }
#define XB_SPIN(cond, bar) do { unsigned _sp = 0; while (cond) { __builtin_amdgcn_s_sleep(1); \
    if ((++_sp & 255u) == 0u) { if (xb_ld(&(bar)[XB_TMO])) break; if (_sp > XB_SPIN_CAP) { atomicAdd(&(bar)[XB_TMO], 1u); break; } } } } while (0)

struct XcdBarrier {
    unsigned* bar; unsigned x;
    volatile LAS unsigned* st;
    int wid;
};
__device__ __forceinline__ bool xb_thread0(const XcdBarrier& b) { unsigned z = 0u; asm volatile("" : "+v"(z)); return b.wid == 0 && __builtin_amdgcn_mbcnt_hi(~0u, __builtin_amdgcn_mbcnt_lo(~0u, z)) == 0u; }

__device__ __forceinline__ XcdBarrier xcd_barrier_post(unsigned* bar, volatile LAS unsigned* st) {
    XcdBarrier b; b.bar = bar; b.x = xb_xcc_id(); b.st = st;
    if (threadIdx.x == 0) st[5] = xb_add(&bar[XB_XCNT(b.x)], 1u);
    return b;
}
__device__ __forceinline__ void xcd_barrier_complete(unsigned* bar, unsigned x, unsigned& nloc, unsigned& nx, unsigned& reg) {
    const unsigned G = gridDim.x * gridDim.y * gridDim.z;
    unsigned sum, cnt, mine, sp = 0u;
    for (;;) {
        sum = 0u; cnt = 0u; mine = 0u; unsigned odd = 0u, below = 0u;
#pragma unroll
        for (unsigned j = 0; j < 16; ++j) { const unsigned c = xb_ld(&bar[XB_XCNT(j)]); sum += c; cnt += (c > 0u) ? 1u : 0u; mine = (j == x) ? c : mine; odd |= (c != 0u && c != 32u) ? 1u : 0u; below += (c > 0u && j < x) ? 1u : 0u; }
        reg = (sum == G && G == 256u && cnt == 8u && odd == 0u) ? 1u + below : 0u;
        if (sum == G) break;
        __builtin_amdgcn_s_sleep(1);
        if ((++sp & 255u) == 0u) { if (xb_ld(&bar[XB_TMO])) break; if (sp > XB_SPIN_CAP) { atomicAdd(&bar[XB_TMO], 1u); break; } }
    }
    nloc = mine > 0u ? mine : 1u; nx = cnt > 0u ? cnt : 1u; if (sum != G) reg = 0u;
}

__device__ __forceinline__ void xcd_barrier(const XcdBarrier& b, int mode = 0, unsigned pair = 0u) {
    const bool local = (mode == 1);
    asm volatile("s_waitcnt vmcnt(0)" ::: "memory");
    __syncthreads();
    if (xb_thread0(b)) {
        unsigned* bar = b.bar;
        __builtin_amdgcn_s_waitcnt(0);
        unsigned nloc = b.st[0], nx = b.st[1];
        if (nloc == 0u) { unsigned reg = 0u; xcd_barrier_complete(bar, b.x, nloc, nx, reg); b.st[0] = nloc; b.st[1] = nx; b.st[2] = reg; }
        const unsigned old = xb_add(&bar[XB_XSUB(b.x)], 1u);
        const unsigned gen = old / nloc;
        if (old + 1u == (gen + 1u) * nloc && local) {
            __builtin_amdgcn_fence(__ATOMIC_ACQUIRE, "agent");
            xb_add(&bar[XB_XGEN(b.x)], 1u);
            asm volatile("s_waitcnt vmcnt(0)" ::: "memory");
        } else if (old + 1u == (gen + 1u) * nloc) {
            __builtin_amdgcn_fence(__ATOMIC_RELEASE, "agent");
            asm volatile("s_waitcnt vmcnt(0)" ::: "memory");
            if (mode == 2) {
                const unsigned og = xb_add(&bar[XB_PTOP(pair)], 1u);
                const unsigned tg = og / 2u;
                if (og + 1u == (tg + 1u) * 2u) xb_add(&bar[XB_PGEN(pair)], 1u);
                else XB_SPIN(xb_ld(&bar[XB_PGEN(pair)]) == tg, bar);
            } else {
            const unsigned og = xb_add(&bar[XB_TOP], 1u);
            const unsigned tg = og / nx;
            if (og + 1u == (tg + 1u) * nx) xb_add(&bar[XB_TOPGEN], 1u);
            else XB_SPIN(xb_ld(&bar[XB_TOPGEN]) == tg, bar);
            }
            __builtin_amdgcn_fence(__ATOMIC_ACQUIRE, "agent");
            xb_add(&bar[XB_XGEN(b.x)], 1u);
            asm volatile("s_waitcnt vmcnt(0)" ::: "memory");
        } else {
            XB_SPIN(xb_ld(&bar[XB_XGEN(b.x)]) == gen, bar);
            __builtin_amdgcn_fence(__ATOMIC_ACQUIRE, "agent");
            asm volatile("s_waitcnt vmcnt(0)" ::: "memory");
        }
    }
    __syncthreads();
}

#ifndef PG8_SP2
#define PG8_SP2 true
#endif
#ifndef PG8_ALIGN
#define PG8_ALIGN true
#endif
#ifndef MK_SPLIT
#define MK_SPLIT 0
#endif

constexpr int DM = 2048, NBATCH = 4, SEQ = 4096, NLAYER = 2, M = NBATCH * SEQ, GW = 512, HD = 128, NH = 4, DFF = 5504, DIN = 6152, NP = 6144;
constexpr int NT = 512, NWAVES = 8;
constexpr float EPS = 1e-6f, KSCALE = 0.08838834764831845f;
constexpr int PH_PER_LAYER = 10, N_PHASES = 1 + NLAYER * PH_PER_LAYER;

constexpr size_t MiB = 1u << 20, KiB = 1024;
constexpr size_t WS_CTL = 0, CTL_ZERO_BYTES = 2 * MiB;
constexpr int CW_BAR = 4096, CW_Q = 8192;
constexpr size_t WS_SSQ = 1 * MiB;
constexpr size_t WS_G = 2 * MiB;
constexpr size_t WS_BLAST = 2560 * KiB, WS_MLOC = WS_BLAST + 4096, WS_MRUN = WS_MLOC + 4096;
constexpr size_t WS_DN = 3 * MiB, WS_NST = 3 * MiB + 512 * KiB;
constexpr size_t WS_LSE = 5 * MiB + 512 * KiB;
constexpr size_t WS_GW8 = 7 * MiB + 512 * KiB;
constexpr size_t WS_LRUW = 7 * MiB;
constexpr size_t WS_WGU1 = 8 * MiB, WS_WD1 = 52 * MiB, WS_WIN = 74 * MiB, WS_WOUT = 98 * MiB, WS_WGU2 = 106 * MiB, WS_WD2 = 149 * MiB;
constexpr size_t WS_XB = 171 * MiB;
constexpr size_t WS_PACT = 235 * MiB;
constexpr size_t WS_MIXED = 427 * MiB;
constexpr size_t WS_DCT = 491 * MiB;
constexpr size_t WS_CST = 555 * MiB;
constexpr size_t WS_CPART = 587 * MiB;
constexpr size_t WS_DOUT = 635 * MiB;
constexpr size_t WS_LAP = 651 * MiB, WS_LHE = 653 * MiB, WS_LCI = 655 * MiB;
constexpr size_t WS_LA = 657 * MiB, WS_LU = 689 * MiB;
constexpr size_t WS_END = 721 * MiB;
constexpr size_t WS_X8 = WS_DCT;
constexpr size_t WS_ROWSC = 4 * MiB, WS_COLSC1 = 4 * MiB + 128 * KiB, WS_COLSC2 = 4 * MiB + 192 * KiB;
static_assert(WS_WGU1 + (size_t)2 * DFF * DM * 2 <= WS_WD1 && WS_WD1 + (size_t)DM * DFF * 2 <= WS_WIN && WS_WIN + (size_t)NP * DM * 2 <= WS_WOUT && WS_WOUT + (size_t)DM * DM * 2 <= WS_WGU2 &&
              WS_WGU2 + (size_t)2 * DFF * DM * 2 <= WS_WD2 && WS_WD2 + (size_t)DM * DFF * 2 <= WS_XB && WS_PACT + (size_t)M * DFF * 2 <= WS_MIXED && WS_PACT + (size_t)12 * M * 512 * 2 <= WS_MIXED, "ws map");
constexpr size_t SEG_STRIDE = (size_t)M * 512;
enum { SEG_LX = 0, SEG_LG, SEG_MQ, SEG_MK, SEG_MV, SEG_MO, SEG_CQ, SEG_CK, SEG_CV, SEG_SQ, SEG_SK, SEG_SV };

constexpr int LDS_MISC_OFF = 152 * 1024, LDS_BYTES = LDS_MISC_OFF + 64;

typedef unsigned short bf16;
typedef short bf16x8 __attribute__((ext_vector_type(8)));
typedef float f32x4 __attribute__((ext_vector_type(4)));
typedef unsigned v4u __attribute__((ext_vector_type(4)));
typedef unsigned v2u __attribute__((ext_vector_type(2)));
typedef float f32x2 __attribute__((ext_vector_type(2)));
__device__ __forceinline__ int opaque_tid_w(int wid) { unsigned z = 0u; asm volatile("" : "+v"(z)); int t = (wid << 6) | (int)__builtin_amdgcn_mbcnt_hi(~0u, __builtin_amdgcn_mbcnt_lo(~0u, z)); asm volatile("" : "+v"(t)); return t; }
#define opaque_tid() opaque_tid_w(p.wid)
#define LDS_WAIT() asm volatile("s_waitcnt lgkmcnt(0)" ::: "memory")
typedef __bf16 bf16x2_hw __attribute__((ext_vector_type(2)));
__device__ __forceinline__ unsigned pk2(float lo, float hi) { const f32x2 v = {lo, hi}; return __builtin_bit_cast(unsigned, __builtin_convertvector(v, bf16x2_hw)); }
__device__ __forceinline__ unsigned f2bf(float f) { return pk2(f, 0.f) & 0xffffu; }
__device__ __forceinline__ float bf2f(unsigned b) { return __builtin_bit_cast(float, b << 16); }
__device__ __forceinline__ float bflo(unsigned w) { return __builtin_bit_cast(float, w << 16); }
__device__ __forceinline__ float bfhi(unsigned w) { return __builtin_bit_cast(float, w & 0xffff0000u); }
__device__ __forceinline__ float wave_sum(float v) {
#pragma unroll
    for (int o = 1; o < 64; o <<= 1) v += __shfl_xor(v, o);
    return v;
}
__device__ __forceinline__ float wave_max(float v) {
#pragma unroll
    for (int o = 1; o < 64; o <<= 1) v = fmaxf(v, __shfl_xor(v, o));
    return v;
}
__device__ __forceinline__ float softplusf(float x) { return fmaxf(x, 0.f) + __logf(1.0f + __expf(-fabsf(x))); }
__device__ __forceinline__ float sigmoidf(float x) { return __builtin_amdgcn_rcpf(1.0f + __expf(-x)); }
__device__ __forceinline__ float gelu_tanh(float x) { const float y = 0.7978845608028654f * (x + 0.044715f * x * x * x); const float t = 1.0f - 2.0f * __builtin_amdgcn_rcpf(1.0f + __expf(2.0f * y)); return 0.5f * x * (1.0f + t); }
__device__ __forceinline__ float one_minus_expneg(float x) { const float pl = x * (1.0f + x * (-0.5f + x * (0.16666667f + x * (-0.041666668f + x * 0.0083333338f)))); return x < 0.25f ? pl : 1.0f - __expf(-x); }
template <int K> __device__ __forceinline__ void mma_lds(f32x4& acc, const LAS bf16* X, int ldx, const LAS bf16* Y, int ldy, int lane) {
    const LAS bf16* xp = X + (lane & 15) * ldx + (lane >> 4) * 8;
    const LAS bf16* yp = Y + (lane & 15) * ldy + (lane >> 4) * 8;
#pragma unroll
    for (int k = 0; k < K; k += 32) {
        const bf16x8 a = *(const LAS bf16x8*)(xp + k), b = *(const LAS bf16x8*)(yp + k);
        acc = __builtin_amdgcn_mfma_f32_16x16x32_bf16(a, b, acc, 0, 0, 0);
    }
}

typedef short v4i16_t __attribute__((ext_vector_type(4)));
__device__ __forceinline__ bf16x8 tr_frag(const LAS bf16* T, int ks, int c, int lane) {
    const LAS bf16* a0 = T + (32 * ks + 8 * (lane >> 4) + ((lane & 15) >> 2)) * 144 + 16 * c + 4 * (lane & 3);
    const v4i16_t lo = __builtin_amdgcn_ds_read_tr16_b64_v4i16((LAS v4i16_t*)a0), hi = __builtin_amdgcn_ds_read_tr16_b64_v4i16((LAS v4i16_t*)(a0 + 4 * 144));
    return (bf16x8){lo[0], lo[1], lo[2], lo[3], hi[0], hi[1], hi[2], hi[3]};
}

__device__ __forceinline__ void touch_line(const void* ptr) { const unsigned v = *(const volatile unsigned*)ptr; asm volatile("" :: "v"(v)); }
struct Params { const float* in[24]; float* out; unsigned char* ws; int ph_lo, ph_hi; };
typedef __attribute__((address_space(4))) const unsigned char* kptr_t;
template <typename T> __device__ __forceinline__ T karg(kptr_t k, int off) { return *(const __attribute__((address_space(4))) T*)(k + off); }
struct Ctx { kptr_t k; unsigned char* ws; float* out; int wid;
    __device__ __forceinline__ const float* in(int i) const { return karg<const float*>(k, 8 * i); } };
__device__ __forceinline__ Ctx make_ctx(int wid) { Ctx c; c.wid = wid; kptr_t k = (kptr_t)__builtin_amdgcn_kernarg_segment_ptr(); asm volatile("" : "+s"(k)); c.k = k; c.ws = karg<unsigned char*>(k, 200); c.out = karg<float*>(k, 192); return c; }
static_assert(sizeof(Params) == 216, "kernarg layout");

__device__ __forceinline__ int q_next(const Ctx& p, unsigned* ctr, volatile LAS int* slot) {
    __syncthreads();
    if (opaque_tid() == 0) *slot = (int)__hip_atomic_fetch_add(ctr, 1u, __ATOMIC_RELAXED, __HIP_MEMORY_SCOPE_AGENT);
    __syncthreads();
    return *slot;
}
struct TItem { const float* src; const float* gain; bf16* dst; int ldw, K_dst, f8; };
__device__ __forceinline__ TItem titem(const float* W, int ldw, int K_dst, bf16* WT, int dst_row0, int src_col0, int k0, const float* gain, int lane) {
    const int c = lane >> 3, n4 = lane & 7; TItem t;
    t.src = W + (size_t)(k0 + 16 * c) * ldw + src_col0 + 4 * n4; t.gain = gain ? gain + k0 + 16 * c : nullptr; t.dst = WT + (size_t)(dst_row0 + 4 * n4) * K_dst + k0 + 16 * c; t.ldw = ldw; t.K_dst = K_dst; t.f8 = 0; return t;
}
__device__ __forceinline__ TItem decode_item(const Ctx& p, int l, int it, int lane) {
    constexpr int I_D = 43 * 64, I_IN = 16 * 192, I_OUT = 16 * 64;
    unsigned char* ws = p.ws; int r = it;
    if (r < 2 * I_D) {
        const int f = r >= I_D; r -= f * I_D; const int kb = r / 64, nb = r % 64;
        if (!pg8::ffn_f8(l, f)) return titem(p.in(f ? 23 : 4) + (size_t)l * DFF * DM, DM, DFF, (bf16*)(ws + (f ? WS_WD2 : WS_WD1)), 32 * nb, 32 * nb, 128 * kb, nullptr, lane);
        TItem t = titem(p.in(f ? 23 : 4) + (size_t)l * DFF * DM, DM, 0, nullptr, 0, 32 * nb, 128 * kb, nullptr, lane);
        t.dst = (bf16*)(ws + (f ? WS_WD2 : WS_WD1) + (size_t)(32 * nb + 4 * (lane & 7)) * pg8::DFF_P + 128 * kb + 16 * (lane >> 3)); t.K_dst = pg8::DFF_P; t.f8 = 1; return t; }
    r -= 2 * I_D;
    if (r < I_IN) {
        const int kb = r / 192, nb = r % 192, d0 = 32 * nb;
        return titem(p.in(6) + (size_t)l * DM * DIN, DIN, DM, (bf16*)(ws + WS_WIN), d0, d0 + (d0 >= 3072 ? 8 : 0), 128 * kb, p.in(5) + l * DM, lane); }
    r -= I_IN;
    if (r < I_OUT) { const int kb = r / 64, nb = r % 64;
        return titem(p.in(19) + (size_t)l * DM * DM, DM, DM, (bf16*)(ws + WS_WOUT), 32 * nb, 32 * nb, 128 * kb, nullptr, lane); }
    r -= I_OUT;
    const int mat = r >> 4, n = (r >> 2) & 3, nb = r & 3;
    return titem(p.in(mat ? 11 : 9) + (size_t)l * 65536 + n * 16384, 128, 128, (bf16*)(ws + WS_LRUW) + (mat * 4 + n) * 16384, 32 * nb, 32 * nb, 0, nullptr, lane);
}
__device__ __forceinline__ unsigned pack_i8x4(float a, float b, float c, float d) {
    return ((unsigned)(int)__builtin_rintf(a) & 255u) | (((unsigned)(int)__builtin_rintf(b) & 255u) << 8) | (((unsigned)(int)__builtin_rintf(c) & 255u) << 16) | ((unsigned)(int)__builtin_rintf(d) << 24);
}
__device__ __forceinline__ void convert_gu_i8(const Ctx& p, int l, LAS unsigned char* lds) {
    const int tid = opaque_tid(), lane = tid & 63, w = tid >> 6, c = lane >> 3, n4 = lane & 7;
    LAS float* MX = (LAS float*)lds;
    for (int it = (int)blockIdx.x; it < 2 * 344; it += (int)gridDim.x) {
        const int f = it >= 344, nb = it - f * 344, pn = nb >> 3, jj = nb & 7;
        const float* src = p.in((f ? 21 : 2) + (jj >> 2)) + (size_t)l * DM * DFF + (size_t)(256 * w + 16 * c) * DFF + 128 * pn + 32 * (jj & 3) + 4 * n4;
        const float* gain = p.in(f ? 20 : 1) + l * DM + 256 * w + 16 * c;
        f32x4 v[2][16];
#pragma unroll
        for (int s2 = 0; s2 < 2; ++s2)
#pragma unroll
            for (int e = 0; e < 16; ++e) v[s2][e] = __builtin_nontemporal_load((const f32x4*)(src + (size_t)(128 * s2 + e) * DFF));
        f32x4 m = {0.f, 0.f, 0.f, 0.f};
#pragma unroll
        for (int s2 = 0; s2 < 2; ++s2)
#pragma unroll
            for (int q = 0; q < 4; ++q) { const f32x4 g = *(const f32x4*)(gain + 128 * s2 + 4 * q);
#pragma unroll
                for (int e = 0; e < 4; ++e) { v[s2][4 * q + e] = v[s2][4 * q + e] * g[e];
#pragma unroll
                    for (int j = 0; j < 4; ++j) m[j] = fmaxf(m[j], fabsf(v[s2][4 * q + e][j])); } }
#pragma unroll
        for (int j = 0; j < 4; ++j) { m[j] = fmaxf(m[j], __shfl_xor(m[j], 8)); m[j] = fmaxf(m[j], __shfl_xor(m[j], 16)); m[j] = fmaxf(m[j], __shfl_xor(m[j], 32)); }
        if (c == 0) *(LAS f32x4*)(MX + w * 32 + 4 * n4) = m;
        __syncthreads();
        f32x4 mm = *(const LAS f32x4*)(MX + 4 * n4);
#pragma unroll
        for (int ww = 1; ww < 8; ++ww) { const f32x4 o = *(const LAS f32x4*)(MX + ww * 32 + 4 * n4);
#pragma unroll
            for (int j = 0; j < 4; ++j) mm[j] = fmaxf(mm[j], o[j]); }
        __syncthreads();
        unsigned char* dst = p.ws + (f ? WS_WGU2 : WS_WGU1) + (size_t)(32 * nb + 4 * n4) * DM + 256 * w + 16 * c;
#pragma unroll
        for (int j = 0; j < 4; ++j) { mm[j] = fmaxf(mm[j], 1e-30f); const float inv = 127.0f / mm[j];
#pragma unroll
            for (int s2 = 0; s2 < 2; ++s2) { v4u o;
#pragma unroll
                for (int q = 0; q < 4; ++q) o[q] = pack_i8x4(v[s2][4 * q][j] * inv, v[s2][4 * q + 1][j] * inv, v[s2][4 * q + 2][j] * inv, v[s2][4 * q + 3][j] * inv);
                *(v4u*)(dst + (size_t)j * DM + 128 * s2) = o; } }
        if (w == 0 && c == 0) *(f32x4*)((float*)(p.ws + (f ? WS_COLSC2 : WS_COLSC1)) + 32 * nb + 4 * n4) = mm * (1.0f / 127.0f);
    }
}
__device__ __forceinline__ void convert_layer(const Ctx& p, int l, int part) {
    const int tid = opaque_tid(), lane = tid & 63, w = tid >> 6;
    const int gw = blockIdx.x * NWAVES + w, NGW = gridDim.x * NWAVES;
    constexpr int NITEMS_ALL = 2 * 43 * 64 + 16 * 192 + 16 * 64 + 32, THIRD = (NITEMS_ALL + 2) / 3;
    const int it0 = part < 0 ? 0 : part * THIRD, NITEMS = part < 0 ? NITEMS_ALL : (it0 + THIRD < NITEMS_ALL ? it0 + THIRD : NITEMS_ALL);
    for (int it = it0 + gw; it < NITEMS; it += NGW) {
        const TItem t = decode_item(p, l, it, lane);
        f32x4 v[16];
#pragma unroll
        for (int e = 0; e < 16; ++e) v[e] = __builtin_nontemporal_load((const f32x4*)(t.src + (size_t)e * t.ldw));
        if (t.gain) {
#pragma unroll
            for (int q = 0; q < 4; ++q) { const f32x4 g = *(const f32x4*)(t.gain + 4 * q);
#pragma unroll
                for (int e = 0; e < 4; ++e) v[4 * q + e] = v[4 * q + e] * g[e]; } }
        if (t.f8) {
#pragma unroll
            for (int j = 0; j < 4; ++j) { v4u o;
#pragma unroll
                for (int q = 0; q < 4; ++q) o[q] = (unsigned)__builtin_amdgcn_cvt_pk_fp8_f32(v[4 * q + 2][j] * pg8::F8_W_SCALE, v[4 * q + 3][j] * pg8::F8_W_SCALE, __builtin_amdgcn_cvt_pk_fp8_f32(v[4 * q][j] * pg8::F8_W_SCALE, v[4 * q + 1][j] * pg8::F8_W_SCALE, 0, false), true);
                *(v4u*)((unsigned char*)t.dst + (size_t)j * t.K_dst) = o; }
            continue;
        }
#pragma unroll
        for (int j = 0; j < 4; ++j) {
            v4u o0, o1; o0.x = pk2(v[0][j], v[1][j]); o0.y = pk2(v[2][j], v[3][j]); o0.z = pk2(v[4][j], v[5][j]); o0.w = pk2(v[6][j], v[7][j]);
            o1.x = pk2(v[8][j], v[9][j]); o1.y = pk2(v[10][j], v[11][j]); o1.z = pk2(v[12][j], v[13][j]); o1.w = pk2(v[14][j], v[15][j]);
            *(v4u*)(t.dst + (size_t)j * t.K_dst) = o0; *(v4u*)(t.dst + (size_t)j * t.K_dst + 8) = o1;
        }
    }
    if (part <= 0) {
        for (int i = (int)blockIdx.x * NT + tid; i < 2 * DM * 8; i += (int)gridDim.x * NT)
            if (pg8::ffn_f8(l, i >> 14)) *(v4u*)(p.ws + ((i >> 14) ? WS_WD2 : WS_WD1) + (size_t)((i >> 3) & (DM - 1)) * pg8::DFF_P + DFF + 16 * (i & 7)) = (v4u){0u, 0u, 0u, 0u};
    }
    if (part <= 0) {
        const float* win = p.in(6) + (size_t)l * DM * DIN; const float* gain = p.in(5) + l * DM; bf16* g8 = (bf16*)(p.ws + WS_GW8);
        for (int k = (int)blockIdx.x * NT + tid; k < DM; k += (int)gridDim.x * NT) {
            const f32x4 w0 = *(const f32x4*)(win + (size_t)k * DIN + 3072), w1 = *(const f32x4*)(win + (size_t)k * DIN + 3076); const float g = gain[k];
#pragma unroll
            for (int c = 0; c < 4; ++c) { g8[c * DM + k] = (bf16)f2bf(w0[c] * g); g8[(c + 4) * DM + k] = (bf16)f2bf(w1[c] * g); }
        }
    }
}
__device__ __forceinline__ void prologue_x(const Ctx& p) {
    const int tid = opaque_tid(), lane = tid & 63, w = tid >> 6;
    const int gw = blockIdx.x * NWAVES + w, NGW = gridDim.x * NWAVES;
    bf16* xb = (bf16*)(p.ws + WS_XB); unsigned long long* ssq = (unsigned long long*)(p.ws + WS_SSQ); float* rowsc = (float*)(p.ws + WS_ROWSC);
    for (int m = gw; m < M; m += NGW) {
        const f32x4* xr = (const f32x4*)(p.in(0) + (size_t)m * DM) + lane; float s = 0.f, mx = 0.f;
        v2u* o8 = (v2u*)(xb + (size_t)m * DM) + lane;
        f32x4 v[8];
#pragma unroll
        for (int j = 0; j < 8; ++j) v[j] = xr[64 * j];
#pragma unroll
        for (int j = 0; j < 8; ++j) { s += (v[j][0] * v[j][0] + v[j][1] * v[j][1]) + (v[j][2] * v[j][2] + v[j][3] * v[j][3]); v2u o; o.x = pk2(v[j][0], v[j][1]); o.y = pk2(v[j][2], v[j][3]); o8[64 * j] = o;
            mx = fmaxf(mx, fmaxf(fmaxf(fabsf(v[j][0]), fabsf(v[j][1])), fmaxf(fabsf(v[j][2]), fabsf(v[j][3])))); }
        s = wave_sum(s); mx = fmaxf(wave_max(mx), 1e-30f);
        const float inv = 127.0f / mx;
        unsigned* q8 = (unsigned*)(p.ws + WS_X8 + (size_t)m * DM) + lane;
#pragma unroll
        for (int j = 0; j < 8; ++j) q8[64 * j] = pack_i8x4(v[j][0] * inv, v[j][1] * inv, v[j][2] * inv, v[j][3] * inv);
        if (lane == 0) { ssq[m] = (unsigned long long)(s * pg8::SSQ_FX + 0.5f); rowsc[m] = mx * (1.0f / 127.0f); }
    }
}
__device__ __forceinline__ void quant_rows_i8(const Ctx& p, const bf16* src, int nrows, unsigned char* dst, float* scale, int vb = -1) {
    const int tid = opaque_tid(), lane = tid & 63, w = tid >> 6;
    const int gw = blockIdx.x * NWAVES + w, NGW = gridDim.x * NWAVES;
    const int first = vb < 0 ? 2 * gw : 2048 * (vb & 7) + 2 * (NWAVES * (vb >> 3) + w), step = vb < 0 ? 2 * NGW : 512, end = vb < 0 ? nrows : 2048 * (vb & 7) + 2048;
    for (int r0 = first; r0 < end; r0 += step) {
        v4u v[2][4];
#pragma unroll
        for (int rr = 0; rr < 2; ++rr) { const v4u* sp = (const v4u*)(src + (size_t)(r0 + rr) * DM) + lane;
#pragma unroll
            for (int j = 0; j < 4; ++j) v[rr][j] = sp[64 * j]; }
#pragma unroll
        for (int rr = 0; rr < 2; ++rr) {
            float mx = 0.f;
#pragma unroll
            for (int j = 0; j < 4; ++j)
#pragma unroll
                for (int e = 0; e < 4; ++e) mx = fmaxf(mx, fmaxf(fabsf(bflo(v[rr][j][e])), fabsf(bfhi(v[rr][j][e]))));
            mx = fmaxf(wave_max(mx), 1e-30f);
            const float inv = 127.0f / mx;
            v2u* dp = (v2u*)(dst + (size_t)(r0 + rr) * DM) + lane;
#pragma unroll
            for (int j = 0; j < 4; ++j) { v2u o;
#pragma unroll
                for (int h2 = 0; h2 < 2; ++h2) { const unsigned w0 = v[rr][j][2 * h2], w1 = v[rr][j][2 * h2 + 1];
                    o[h2] = ((unsigned)(int)__builtin_rintf(bflo(w0) * inv) & 255u) | (((unsigned)(int)__builtin_rintf(bfhi(w0) * inv) & 255u) << 8) | (((unsigned)(int)__builtin_rintf(bflo(w1) * inv) & 255u) << 16) | ((unsigned)(int)__builtin_rintf(bfhi(w1) * inv) << 24); }
                dp[64 * j] = o; }
            if (lane == 0) scale[r0 + rr] = mx * (1.0f / 127.0f);
        }
    }
}
__device__ __forceinline__ void gates_phase(const Ctx& p, int l, const unsigned long long* ssq, LAS unsigned char* lds, int vb) {
    const int tid = opaque_tid(), lane = tid & 63, w = tid >> 6, fr = lane & 15, fq = lane >> 4, tile = w & 3, kh = w >> 2;
    const bf16* xb = (const bf16*)(p.ws + WS_XB); const bf16* g8 = (const bf16*)(p.ws + WS_GW8); float* G = (float*)(p.ws + WS_G);
    LAS f32x4* XCH = (LAS f32x4*)lds;
    for (int rb = (vb & 7) * 32 + (vb >> 3); rb < M / 64; rb += M / 64) {
        const int row = rb * 64 + tile * 16 + fr;
        const bf16* xp = xb + (size_t)row * DM + kh * 1024 + 8 * fq; const bf16* wp = g8 + (size_t)(fr & 7) * DM + kh * 1024 + 8 * fq;
        f32x4 acc = {0.f, 0.f, 0.f, 0.f};
#pragma unroll
        for (int b0 = 0; b0 < 32; b0 += 8) {
            bf16x8 xf[8], wf[8];
#pragma unroll
            for (int i = 0; i < 8; ++i) { xf[i] = *(const bf16x8*)(xp + 32 * (b0 + i)); wf[i] = *(const bf16x8*)(wp + 32 * (b0 + i)); }
#pragma unroll
            for (int i = 0; i < 8; ++i) { const bf16x8 wz = fr < 8 ? wf[i] : (bf16x8){0, 0, 0, 0, 0, 0, 0, 0}; acc = __builtin_amdgcn_mfma_f32_16x16x32_bf16(wz, xf[i], acc, 0, 0, 0); }
        }
        __syncthreads();
        if (kh == 1) XCH[tile * 64 + lane] = acc;
        __syncthreads();
        if (kh == 0 && fq < 2) {
            const f32x4 o = (acc + XCH[tile * 64 + lane]) * __builtin_amdgcn_rsqf((float)ssq[row] * (1.0f / (DM * pg8::SSQ_FX)) + EPS);
            *(f32x4*)(G + (size_t)row * 8 + 4 * fq) = o;
        }
    }
    __syncthreads();
}

constexpr int LRU_T = 16, LRU_NC = SEQ / LRU_T;
struct LruC { f32x2 w0, w1, w2, w3, cbv; float bav[4], bxv[4], spl[4], ga[8]; };
__device__ __forceinline__ void lru_cload(const Ctx& p, int l, int tid, LruC& C) {
    const int lane = tid & 63, w = tid >> 6, fr = lane & 15, ch = 2 * (tid & 255), n = w >> 1;
    const float* cw = p.in(7) + l * 4 * GW + ch; const float* cb = p.in(8) + l * GW + ch;
    C.w0 = *(const f32x2*)cw; C.w1 = *(const f32x2*)(cw + GW); C.w2 = *(const f32x2*)(cw + 2 * GW); C.w3 = *(const f32x2*)(cw + 3 * GW); C.cbv = *(const f32x2*)cb;
    const float* ba = p.in(10) + l * GW; const float* bx = p.in(12) + l * GW; const float* lam = p.in(13) + l * GW; const float* ga = p.in(18) + l * DM;
#pragma unroll
    for (int ds = 0; ds < 4; ++ds) { const int dg = n * 128 + 16 * (4 * (w & 1) + ds) + fr; C.bav[ds] = ba[dg]; C.bxv[ds] = bx[dg]; C.spl[ds] = 8.0f * softplusf(-lam[dg]); }
#pragma unroll
    for (int e = 0; e < 8; ++e) C.ga[e] = ga[lane * 8 + e];
}
template <int PASS> __device__ __forceinline__ void lru_ld(const Ctx& p, int u, int tid, unsigned (&xv)[11], float& lci) {
    const int b = u >> 8, c = u & 255, row0 = b * SEQ + c * 16, ch = 2 * (tid & 255), th = tid >> 8;
    lci = (PASS == 3) ? ((const float*)(p.ws + WS_LCI))[(size_t)u * GW + tid] : 0.f;
    const bf16* xp = (const bf16*)(p.ws + WS_PACT) + SEG_LX * SEG_STRIDE + (size_t)(row0 + 8 * th - 3) * GW + ch;
#pragma unroll
    for (int i = 0; i < 11; ++i) xv[i] = (c * 16 + 8 * th - 3 + i >= 0) ? *(const unsigned*)(xp + (size_t)i * GW) : 0u;
}
template <int PASS>
__device__ __forceinline__ void lru_unit(const Ctx& p, int l, int u, int un, unsigned (&xv)[11], float& lci, const LruC& C, LAS unsigned char* lds) {
    const int tid = opaque_tid(), lane = tid & 63, w = tid >> 6, fr = lane & 15, fq = lane >> 4;
    const int b = u >> 8, c = u & 255, row0 = b * SEQ + c * LRU_T;
    LAS float* XC = (LAS float*)lds;
    LAS float* AA = (LAS float*)(lds + 32768);
    LAS bf16* XCB = (LAS bf16*)(lds + 65536);
    LAS bf16* Y = (LAS bf16*)(lds + 82176);
    const bf16* xr = (const bf16*)(p.ws + WS_PACT) + SEG_LX * SEG_STRIDE;
    const bf16* gt = (const bf16*)(p.ws + WS_PACT) + SEG_LG * SEG_STRIDE;
    bf16x8 wa[4][4], wx[4][4];
    {
        const bf16* WaT = (const bf16*)(p.ws + WS_LRUW); const bf16* WxT = WaT + 4 * 16384; const int n = w >> 1;
#pragma unroll
        for (int ds = 0; ds < 4; ++ds) {
            const size_t ro = (size_t)(n * 128 + 16 * (4 * (w & 1) + ds) + fr) * 128 + 8 * fq;
#pragma unroll
            for (int k = 0; k < 4; ++k) { wa[ds][k] = *(const bf16x8*)(WaT + ro + 32 * k); wx[ds][k] = *(const bf16x8*)(WxT + ro + 32 * k); }
        }
        asm volatile("" ::: "memory");
    }
    float gate_v[16];
    if (PASS == 3) {
#pragma unroll
        for (int t = 0; t < 16; ++t) gate_v[t] = bf2f(gt[(size_t)(row0 + t) * GW + tid]);
    }
    float lci_keep;
    {
        const int ch = 2 * (tid & 255), th = tid >> 8;
        const f32x2 w0 = C.w0, w1 = C.w1, w2 = C.w2, w3 = C.w3, cbv = C.cbv;
        const float lci_cur = lci;
#pragma unroll
        for (int i = 0; i < 8; ++i) {
            const int t = 8 * th + i;
            const float xa = w0.x * bflo(xv[i]) + w1.x * bflo(xv[i + 1]) + w2.x * bflo(xv[i + 2]) + w3.x * bflo(xv[i + 3]) + cbv.x;
            const float xbv = w0.y * bfhi(xv[i]) + w1.y * bfhi(xv[i + 1]) + w2.y * bfhi(xv[i + 2]) + w3.y * bfhi(xv[i + 3]) + cbv.y;
            *(LAS f32x2*)(XC + t * 512 + ch) = (f32x2){xa, xbv}; *(LAS unsigned*)(XCB + t * 520 + ch) = pk2(xa, xbv);
        }
        lru_ld<PASS>(p, un < NBATCH * LRU_NC ? un : u, tid, xv, lci);
        lci_keep = lci_cur;
    }
    __syncthreads();
    {
        const int n = w >> 1;
        const LAS bf16* xp = XCB + fr * 520 + n * 128 + 8 * fq;
        bf16x8 af[4];
#pragma unroll
        for (int k = 0; k < 4; ++k) af[k] = *(const LAS bf16x8*)(xp + 32 * k);
#pragma unroll
        for (int ds = 0; ds < 4; ++ds) {
            const int d0 = 16 * (4 * (w & 1) + ds);
            f32x4 za = {0.f, 0.f, 0.f, 0.f}, zx = {0.f, 0.f, 0.f, 0.f};
#pragma unroll
            for (int k = 0; k < 4; ++k) { za = __builtin_amdgcn_mfma_f32_16x16x32_bf16(af[k], wa[ds][k], za, 0, 0, 0); zx = __builtin_amdgcn_mfma_f32_16x16x32_bf16(af[k], wx[ds][k], zx, 0, 0, 0); }
            const int dg = n * 128 + d0 + fr; const float bav = C.bav[ds], bxv = C.bxv[ds], spl = C.spl[ds];
#pragma unroll
            for (int j = 0; j < 4; ++j) {
                const int t = 4 * fq + j;
                const float r = sigmoidf(za[j] + bav), ii = sigmoidf(zx[j] + bxv), loga = -spl * r, a = __expf(loga), mult = __builtin_amdgcn_sqrtf(one_minus_expneg(-2.0f * loga));
                const float xc = XC[t * 512 + dg]; AA[t * 512 + dg] = a; XC[t * 512 + dg] = mult * ii * xc;
            }
        }
    }
    __syncthreads();
    {
        const int dg = tid; const size_t ci = (size_t)(b * LRU_NC + c) * GW + dg;
        float h = (PASS == 3) ? lci_keep : 0.f, ap = 1.f;
#pragma unroll
        for (int t = 0; t < 16; ++t) { const float a = AA[t * 512 + dg], uu = XC[t * 512 + dg]; h = a * h + uu; ap *= a; if (PASS == 3) Y[t * 520 + dg] = (bf16)f2bf(h * gelu_tanh(gate_v[t]));
            if (PASS == 1) { ((float*)(p.ws + WS_LA))[(size_t)(row0 + t) * GW + dg] = a; ((float*)(p.ws + WS_LU))[(size_t)(row0 + t) * GW + dg] = uu; } }
        if (PASS == 1) { ((float*)(p.ws + WS_LAP))[ci] = ap; ((float*)(p.ws + WS_LHE))[ci] = h; }
    }
    if (PASS == 3) {
        __syncthreads();
        bf16* mixed = (bf16*)(p.ws + WS_MIXED);
        float gv[8];
#pragma unroll
        for (int e = 0; e < 8; ++e) gv[e] = C.ga[e];
#pragma unroll
        for (int tt = 0; tt < 2; ++tt) {
            const int t = w * 2 + tt; const v4u v = *(const LAS v4u*)(Y + t * 520 + lane * 8);
            float f[8] = {bflo(v.x), bfhi(v.x), bflo(v.y), bfhi(v.y), bflo(v.z), bfhi(v.z), bflo(v.w), bfhi(v.w)}; float ss = 0.f;
#pragma unroll
            for (int e = 0; e < 8; ++e) ss += f[e] * f[e];
            ss = wave_sum(ss); const float rs = __builtin_amdgcn_rsqf(ss * (1.0f / GW) + EPS);
            v4u o; o.x = pk2(f[0] * rs * gv[0], f[1] * rs * gv[1]); o.y = pk2(f[2] * rs * gv[2], f[3] * rs * gv[3]); o.z = pk2(f[4] * rs * gv[4], f[5] * rs * gv[5]); o.w = pk2(f[6] * rs * gv[6], f[7] * rs * gv[7]);
            *(v4u*)(mixed + (size_t)(row0 + t) * DM + lane * 8) = o;
        }
    }
}
__device__ __forceinline__ void lru3_ld(const Ctx& p, int u, int tid, float (&pa)[16], float (&pu)[16], float (&pg)[16], float& lci) {
    const int row0 = (u >> 8) * SEQ + (u & 255) * LRU_T;
    const float* AG = (const float*)(p.ws + WS_LA) + (size_t)row0 * GW + tid; const float* UG = (const float*)(p.ws + WS_LU) + (size_t)row0 * GW + tid;
    const bf16* gt = (const bf16*)(p.ws + WS_PACT) + SEG_LG * SEG_STRIDE + (size_t)row0 * GW + tid;
    lci = ((const float*)(p.ws + WS_LCI))[(size_t)u * GW + tid];
#pragma unroll
    for (int t = 0; t < 16; ++t) { pa[t] = AG[t * GW]; pu[t] = UG[t * GW]; pg[t] = bf2f(gt[t * GW]); }
}
__device__ __forceinline__ void lru3_unit(const Ctx& p, int u, int un, float (&pa)[16], float (&pu)[16], float (&pg)[16], float& lci, const LruC& C, LAS unsigned char* lds) {
    const int tid = opaque_tid(), lane = tid & 63, w = tid >> 6;
    const int row0 = (u >> 8) * SEQ + (u & 255) * LRU_T;
    LAS bf16* Y = (LAS bf16*)lds;
    float h = lci;
#pragma unroll
    for (int t = 0; t < 16; ++t) { h = pa[t] * h + pu[t]; Y[t * 520 + tid] = (bf16)f2bf(h * gelu_tanh(pg[t])); }
    lru3_ld(p, un < NBATCH * LRU_NC ? un : u, tid, pa, pu, pg, lci);
    __syncthreads();
    bf16* mixed = (bf16*)(p.ws + WS_MIXED);
    float gv[8];
#pragma unroll
    for (int e = 0; e < 8; ++e) gv[e] = C.ga[e];
#pragma unroll
    for (int tt = 0; tt < 2; ++tt) {
        const int t = w * 2 + tt; const v4u v = *(const LAS v4u*)(Y + t * 520 + lane * 8);
        float f[8] = {bflo(v.x), bfhi(v.x), bflo(v.y), bfhi(v.y), bflo(v.z), bfhi(v.z), bflo(v.w), bfhi(v.w)}; float ss = 0.f;
#pragma unroll
        for (int e = 0; e < 8; ++e) ss += f[e] * f[e];
        ss = wave_sum(ss); const float rs = __builtin_amdgcn_rsqf(ss * (1.0f / GW) + EPS);
        v4u o; o.x = pk2(f[0] * rs * gv[0], f[1] * rs * gv[1]); o.y = pk2(f[2] * rs * gv[2], f[3] * rs * gv[3]); o.z = pk2(f[4] * rs * gv[4], f[5] * rs * gv[5]); o.w = pk2(f[6] * rs * gv[6], f[7] * rs * gv[7]);
        *(v4u*)(mixed + (size_t)(row0 + t) * DM + lane * 8) = o;
    }
}
__device__ __forceinline__ void lru_carry_unit(const Ctx& p, int u, LAS unsigned char* lds) {
    const int tid = opaque_tid(), ch = tid & 63, seg = tid >> 6, b = u >> 3, chg = (u & 7) * 64 + ch;
    const float* LAP = (const float*)(p.ws + WS_LAP); const float* LHE = (const float*)(p.ws + WS_LHE); float* LCI = (float*)(p.ws + WS_LCI);
    LAS float* TA = (LAS float*)lds; LAS float* TH = TA + 512;
    float ap[32], he[32];
#pragma unroll
    for (int j = 0; j < 32; ++j) { const size_t o = (size_t)(b * LRU_NC + 32 * seg + j) * GW + chg; ap[j] = LAP[o]; he[j] = LHE[o]; }
    float at = 1.f, ht = 0.f;
#pragma unroll
    for (int j = 0; j < 32; ++j) { ht = ap[j] * ht + he[j]; at *= ap[j]; }
    TA[seg * 64 + ch] = at; TH[seg * 64 + ch] = ht;
    __syncthreads();
    float carry = 0.f;
    for (int s2 = 0; s2 < seg; ++s2) carry = TA[s2 * 64 + ch] * carry + TH[s2 * 64 + ch];
#pragma unroll
    for (int j = 0; j < 32; ++j) { LCI[(size_t)(b * LRU_NC + 32 * seg + j) * GW + chg] = carry; carry = ap[j] * carry + he[j]; }
}

__device__ __forceinline__ void mlstm_ld_g(const Ctx& p, int u, int tid, float& gi, float& gf) {
    const int bh = u >> 6, row0 = (bh >> 2) * SEQ + (u & 63) * 64, h = bh & 3; const float* G = (const float*)(p.ws + WS_G);
    gi = G[(size_t)(row0 + (tid & 63)) * 8 + h]; gf = G[(size_t)(row0 + (tid & 63)) * 8 + 4 + h];
}
__device__ __forceinline__ void mlstm_ld_kv(const Ctx& p, int u, int tid, v4u (&kvr)[2], v4u (&vvr)[2]) {
    const int bh = u >> 6, row0 = (bh >> 2) * SEQ + (u & 63) * 64, h = bh & 3;
    const bf16* Kg = (const bf16*)(p.ws + WS_PACT) + SEG_MK * SEG_STRIDE + h * HD; const bf16* Vg = (const bf16*)(p.ws + WS_PACT) + SEG_MV * SEG_STRIDE + h * HD;
#pragma unroll
    for (int i = 0; i < 2; ++i) { const int q = tid + NT * i, s = q >> 4, kc = (q & 15) * 8; kvr[i] = *(const v4u*)(Kg + (size_t)(row0 + s) * GW + kc); vvr[i] = *(const v4u*)(Vg + (size_t)(row0 + s) * GW + kc); }
}
__device__ __forceinline__ void mlstm1_unit(const Ctx& p, int l, int u, int un, v4u (&kvr)[2], v4u (&vvr)[2], float& gi, float& gf, LAS unsigned char* lds) {
    const int tid = opaque_tid(), lane = tid & 63, w = tid >> 6, fr = lane & 15, fq = lane >> 4;
    const int bh = u >> 6, c = u & 63, b = bh >> 2, h = bh & 3, row0 = b * SEQ + c * 64;
    LAS bf16* VH = (LAS bf16*)lds;
    LAS bf16* KW = (LAS bf16*)(lds + 18432);
    LAS float* WS = (LAS float*)(lds + 36864);
    if (w == 0) {
        const int s = lane;
        const float ip = gi + p.in(14)[l * NH + h], fp = gf + p.in(15)[l * NH + h];
        float bc = -softplusf(-fp);
#pragma unroll
        for (int o = 1; o < 64; o <<= 1) { const float t = __shfl_up(bc, o); if (lane >= o) bc += t; }
        const float blast = __shfl(bc, 63), logw = blast - bc + ip, mloc = wave_max(logw);
        WS[s] = __expf(logw - mloc);
        if (lane == 0) { ((float*)(p.ws + WS_BLAST))[u] = blast; ((float*)(p.ws + WS_MLOC))[u] = mloc; }
    }
    __syncthreads();
#pragma unroll
    for (int i = 0; i < 2; ++i) {
        const int q = tid + NT * i, s = q >> 4, kc = (q & 15) * 8;
        const v4u kv = kvr[i]; const float ws = WS[s] * KSCALE;
        v4u ko; ko.x = pk2(bflo(kv.x) * ws, bfhi(kv.x) * ws); ko.y = pk2(bflo(kv.y) * ws, bfhi(kv.y) * ws); ko.z = pk2(bflo(kv.z) * ws, bfhi(kv.z) * ws); ko.w = pk2(bflo(kv.w) * ws, bfhi(kv.w) * ws);
        *(LAS v4u*)(KW + s * 144 + kc) = ko; *(LAS v4u*)(VH + s * 144 + kc) = vvr[i];
    }
    mlstm_ld_kv(p, un < 1024 ? un : u, tid, kvr, vvr); mlstm_ld_g(p, un < 1024 ? un : u, tid, gi, gf);
    __syncthreads();
    float* DCT = (float*)(p.ws + WS_DCT) + (size_t)u * 16384;
    const bf16x8 vb0 = tr_frag(VH, 0, w, lane), vb1 = tr_frag(VH, 1, w, lane);
#pragma unroll
    for (int ki = 0; ki < 8; ++ki) {
        f32x4 acc = {0.f, 0.f, 0.f, 0.f};
        acc = __builtin_amdgcn_mfma_f32_16x16x32_bf16(tr_frag(KW, 0, ki, lane), vb0, acc, 0, 0, 0);
        acc = __builtin_amdgcn_mfma_f32_16x16x32_bf16(tr_frag(KW, 1, ki, lane), vb1, acc, 0, 0, 0);
        *(f32x4*)(DCT + (16 * w + fr) * 128 + 16 * ki + 4 * fq) = acc;
    }
    if (tid < 128) { float s = 0.f;
#pragma unroll 8
        for (int t = 0; t < 64; ++t) s += bf2f(KW[t * 144 + tid]);
        ((float*)(p.ws + WS_DN))[(size_t)u * 128 + tid] = s; }
}
__device__ __forceinline__ void mlstm_scan_unit(const Ctx& p, int su, LAS unsigned char* lds) {
    const int tid = opaque_tid(), lane = tid & 63, bh = su >> 5, slice = su & 31, seg = tid >> 7, grp = tid & 127, e0 = slice * 512 + grp * 4;
    const float* DCT = (const float*)(p.ws + WS_DCT); bf16* CST = (bf16*)(p.ws + WS_CST);
    const float* DN = (const float*)(p.ws + WS_DN); float* NST = (float*)(p.ws + WS_NST);
    LAS float* DEC = (LAS float*)lds; LAS float* SC = DEC + 64; LAS float* PFX = DEC + 128;
    LAS f32x4* TOT = (LAS f32x4*)(lds + 1024);
    LAS f32x4* TOTN = (LAS f32x4*)(lds + 1024 + 8192);
    LAS float* PT = (LAS float*)(lds + 1024 + 8192 + 2048);
    f32x4 d4[16];
#pragma unroll
    for (int j = 0; j < 16; ++j) { const int ui = bh * 64 + 16 * seg + j; d4[j] = *(const f32x4*)(DCT + (size_t)ui * 16384 + e0); }
    if (tid < 64) {
        const int c = lane; const float bl = ((const float*)(p.ws + WS_BLAST))[bh * 64 + c], ml = ((const float*)(p.ws + WS_MLOC))[bh * 64 + c];
        float mrun = 0.f, mine_run = 0.f, mine_next = 0.f;
        for (int i = 0; i < 64; ++i) { const float bli = __shfl(bl, i), mli = __shfl(ml, i), mnext = fmaxf(bli + mrun, mli); if (c == i) { mine_run = mrun; mine_next = mnext; } mrun = mnext; }
        const float dec = __expf(bl + mine_run - mine_next), sc = __expf(ml - mine_next);
        DEC[c] = dec; SC[c] = sc;
        float pf = dec;
#pragma unroll
        for (int o = 1; o < 16; o <<= 1) { const float t = __shfl_up(pf, o); if ((c & 15) >= o) pf *= t; }
        const float ex = __shfl_up(pf, 1); PFX[c] = (c & 15) ? ex : 1.f;
        if ((c & 15) == 15) PT[c >> 4] = pf;
        if (slice == 0) ((float*)(p.ws + WS_MRUN))[bh * 64 + c] = mine_run;
    }
    __syncthreads();
    {
        f32x4 L = {0.f, 0.f, 0.f, 0.f};
#pragma unroll
        for (int j = 0; j < 16; ++j) { const float dec = DEC[16 * seg + j], sc = SC[16 * seg + j]; const f32x4 d = d4[j]; d4[j] = L; L = L * dec + d * sc; }
        TOT[seg * 128 + grp] = L;
    }
    __syncthreads();
    {
        f32x4 I = {0.f, 0.f, 0.f, 0.f};
        for (int s2 = 0; s2 < 3; ++s2) if (s2 < seg) I = I * PT[s2] + TOT[s2 * 128 + grp];
#pragma unroll
        for (int j = 0; j < 16; ++j) {
            const int ui = bh * 64 + 16 * seg + j; const f32x4 C = d4[j] + I * PFX[16 * seg + j];
            v2u o; o.x = pk2(C[0], C[1]); o.y = pk2(C[2], C[3]); *(v2u*)(CST + (size_t)ui * 16384 + e0) = o;
        }
    }
    if (slice == 0 && tid < 128) {
        const int sg = tid >> 5, g4 = tid & 31; f32x4 n4[16];
#pragma unroll
        for (int j = 0; j < 16; ++j) n4[j] = *(const f32x4*)(DN + (size_t)(bh * 64 + 16 * sg + j) * 128 + g4 * 4);
        f32x4 L = {0.f, 0.f, 0.f, 0.f};
#pragma unroll
        for (int j = 0; j < 16; ++j) { const float dec = DEC[16 * sg + j], sc = SC[16 * sg + j]; const f32x4 d = n4[j]; n4[j] = L; L = L * dec + d * sc; }
        TOTN[sg * 32 + g4] = L;
        __builtin_amdgcn_s_waitcnt(0xC07F); __builtin_amdgcn_wave_barrier();
    }
    __syncthreads();
    if (slice == 0 && tid < 128) {
        const int sg = tid >> 5, g4 = tid & 31; f32x4 In = {0.f, 0.f, 0.f, 0.f};
        for (int s2 = 0; s2 < 3; ++s2) if (s2 < sg) In = In * PT[s2] + TOTN[s2 * 32 + g4];
        f32x4 L = {0.f, 0.f, 0.f, 0.f};
#pragma unroll
        for (int j = 0; j < 16; ++j) { const int ui = bh * 64 + 16 * sg + j; const float dec = DEC[16 * sg + j], sc = SC[16 * sg + j];
            *(f32x4*)(NST + (size_t)ui * 128 + g4 * 4) = L + In * PFX[16 * sg + j];
            const f32x4 d = *(const f32x4*)(DN + (size_t)ui * 128 + g4 * 4); L = L * dec + d * sc; }
    }
}
__device__ __forceinline__ void mlstm3_ld(const Ctx& p, int u, int tid, v4u (&pre)[10]) {
    const int bh = u >> 6, row0 = (bh >> 2) * SEQ + (u & 63) * 64, h = bh & 3;
    const bf16* Qg = (const bf16*)(p.ws + WS_PACT) + SEG_MQ * SEG_STRIDE + h * HD; const bf16* Kg = (const bf16*)(p.ws + WS_PACT) + SEG_MK * SEG_STRIDE + h * HD;
    const bf16* Vg = (const bf16*)(p.ws + WS_PACT) + SEG_MV * SEG_STRIDE + h * HD; const bf16* Cg = (const bf16*)(p.ws + WS_CST) + (size_t)u * 16384;
#pragma unroll
    for (int i = 0; i < 2; ++i) { const int q = tid + NT * i, s = q >> 4, kc = (q & 15) * 8;
        pre[i] = *(const v4u*)(Qg + (size_t)(row0 + s) * GW + kc); pre[2 + i] = *(const v4u*)(Kg + (size_t)(row0 + s) * GW + kc); pre[4 + i] = *(const v4u*)(Vg + (size_t)(row0 + s) * GW + kc); }
#pragma unroll
    for (int i = 0; i < 4; ++i) { const int q = tid + NT * i, r = q >> 4, kc = (q & 15) * 8; pre[6 + i] = *(const v4u*)(Cg + r * 128 + kc); }
}
__device__ __forceinline__ void mlstm3_unit(const Ctx& p, int l, int u, int un, v4u (&pre)[10], float& gi, float& gf, float& mrun_pf, float& nv_pf, LAS unsigned char* lds) {
    const int tid = opaque_tid(), lane = tid & 63, w = tid >> 6, fr = lane & 15, fq = lane >> 4;
    const int bh = u >> 6, c = u & 63, b = bh >> 2, h = bh & 3, row0 = b * SEQ + c * 64;
    LAS bf16* Q = (LAS bf16*)lds;
    LAS bf16* KS = (LAS bf16*)(lds + 17408);
    LAS bf16* VH = (LAS bf16*)(lds + 34816);
    LAS bf16* CT = (LAS bf16*)(lds + 53248);
    LAS bf16* SB = (LAS bf16*)(lds + 88064);
    LAS float* HF = (LAS float*)(lds + 97280);
    LAS float* BV = (LAS float*)(lds + 130304);
    LAS float* CV = BV + 64;
    LAS float* MT = BV + 128;
    LAS float* WI = BV + 192;
    LAS float* QN = BV + 256;
    LAS float* NV = BV + 320;
    LAS float* RSP = BV + 448;
    const float* G = (const float*)(p.ws + WS_G);
    const bf16* Og = (const bf16*)(p.ws + WS_PACT) + SEG_MO * SEG_STRIDE + h * HD;
    {
        if (w == 0) {
            const int s = lane;
            const float ip = gi + p.in(14)[l * NH + h], fp = gf + p.in(15)[l * NH + h];
            float bc = -softplusf(-fp);
#pragma unroll
            for (int o = 1; o < 64; o <<= 1) { const float t = __shfl_up(bc, o); if (lane >= o) bc += t; }
            const float cv = ip - bc; float g = cv;
#pragma unroll
            for (int o = 1; o < 64; o <<= 1) { const float t = __shfl_up(g, o); if (lane >= o) g = fmaxf(g, t); }
            const float mrun = mrun_pf, mt = bc + fmaxf(mrun, g);
            BV[s] = bc; CV[s] = cv; MT[s] = mt; WI[s] = __expf(bc + mrun - mt);
        }
        if (tid >= 64 && tid < 192) NV[tid - 64] = nv_pf;
#pragma unroll
        for (int i = 0; i < 2; ++i) { const int q = tid + NT * i, s = q >> 4, kc = (q & 15) * 8; const v4u kv = pre[2 + i];
            *(LAS v4u*)(Q + s * 136 + kc) = pre[i];
            v4u ko; ko.x = pk2(bflo(kv.x) * KSCALE, bfhi(kv.x) * KSCALE); ko.y = pk2(bflo(kv.y) * KSCALE, bfhi(kv.y) * KSCALE); ko.z = pk2(bflo(kv.z) * KSCALE, bfhi(kv.z) * KSCALE); ko.w = pk2(bflo(kv.w) * KSCALE, bfhi(kv.w) * KSCALE);
            *(LAS v4u*)(KS + s * 136 + kc) = ko; *(LAS v4u*)(VH + s * 144 + kc) = pre[4 + i]; }
#pragma unroll
        for (int i = 0; i < 4; ++i) { const int q = tid + NT * i, r = q >> 4, kc = (q & 15) * 8; *(LAS v4u*)(CT + r * 136 + kc) = pre[6 + i]; }
        { const int uq = un < 1024 ? un : u;
          mlstm3_ld(p, uq, tid, pre); mlstm_ld_g(p, uq, tid, gi, gf); mrun_pf = ((const float*)(p.ws + WS_MRUN))[uq]; nv_pf = ((const float*)(p.ws + WS_NST))[(size_t)uq * 128 + ((tid - 64) & 127)]; }
    }
    float op0[8], op1[8];
#pragma unroll
    for (int tt = 0; tt < 8; ++tt) { op0[tt] = bf2f(Og[(size_t)(row0 + w * 8 + tt) * GW + lane]); op1[tt] = bf2f(Og[(size_t)(row0 + w * 8 + tt) * GW + lane + 64]); }
    __syncthreads();
    const int ti = w >> 1;
    {
#pragma unroll
        for (int x = 0; x < 2; ++x) {
            const int si = 2 * (w & 1) + x;
            f32x4 acc = {0.f, 0.f, 0.f, 0.f};
            if (si <= ti) mma_lds<128>(acc, Q + 16 * ti * 136, 136, KS + 16 * si * 136, 136, lane);
            const int s = 16 * si + fr; const float cvs = CV[s];
#pragma unroll
            for (int j = 0; j < 4; ++j) { const int t = 16 * ti + 4 * fq + j; const float sd = (s <= t) ? acc[j] * __expf(BV[t] + cvs - MT[t]) : 0.f;
                SB[t * 72 + s] = (bf16)f2bf(sd);
                float r = sd; r += __shfl_xor(r, 1); r += __shfl_xor(r, 2); r += __shfl_xor(r, 4); r += __shfl_xor(r, 8);
                if (fr == 0) RSP[t * 4 + si] = r; }
        }
        if (w == 7) { const int t = lane; float qn = 0.f;
#pragma unroll 8
            for (int k = 0; k < 128; ++k) qn += bf2f(Q[t * 136 + k]) * NV[k];
            QN[t] = qn; }
    }
    __syncthreads();
    {
        const bf16x8 sa0 = *(const LAS bf16x8*)(SB + (16 * ti + fr) * 72 + 8 * fq), sa1 = *(const LAS bf16x8*)(SB + (16 * ti + fr) * 72 + 32 + 8 * fq);
        float wi[4], dinv[4];
#pragma unroll
        for (int j = 0; j < 4; ++j) { const int t = 16 * ti + 4 * fq + j; wi[j] = WI[t];
            const float den = (RSP[t * 4] + RSP[t * 4 + 1]) + (RSP[t * 4 + 2] + RSP[t * 4 + 3]) + wi[j] * QN[t];
            dinv[j] = 1.0f / fmaxf(fabsf(den), __expf(-MT[t])); }
#pragma unroll
        for (int x = 0; x < 4; ++x) {
            const int vi = 4 * (w & 1) + x;
            f32x4 a1 = {0.f, 0.f, 0.f, 0.f}, a2 = {0.f, 0.f, 0.f, 0.f};
            a1 = __builtin_amdgcn_mfma_f32_16x16x32_bf16(sa0, tr_frag(VH, 0, vi, lane), a1, 0, 0, 0);
            a1 = __builtin_amdgcn_mfma_f32_16x16x32_bf16(sa1, tr_frag(VH, 1, vi, lane), a1, 0, 0, 0);
            mma_lds<128>(a2, Q + 16 * ti * 136, 136, CT + 16 * vi * 136, 136, lane);
#pragma unroll
            for (int j = 0; j < 4; ++j) HF[(16 * ti + 4 * fq + j) * 129 + 16 * vi + fr] = (a1[j] + wi[j] * a2[j]) * dinv[j];
        }
    }
    __syncthreads();
    {
        const float* gb = p.in(18) + l * DM + GW + h * HD; bf16* mixed = (bf16*)(p.ws + WS_MIXED);
        const float g0 = gb[lane], g1 = gb[lane + 64];
#pragma unroll
        for (int tt = 0; tt < 8; ++tt) {
            const int t = w * 8 + tt; const float h0 = HF[t * 129 + lane], h1 = HF[t * 129 + lane + 64];
            const float ss = wave_sum(h0 * h0 + h1 * h1), rs = __builtin_amdgcn_rsqf(ss * (1.0f / HD) + EPS);
            bf16* mo = mixed + (size_t)(row0 + t) * DM + GW + h * HD;
            mo[lane] = (bf16)f2bf(h0 * rs * g0 * sigmoidf(op0[tt])); mo[lane + 64] = (bf16)f2bf(h1 * rs * g1 * sigmoidf(op1[tt]));
        }
    }
}

template <int NCH> __device__ __forceinline__ void ld_rows(v4u (&r)[NCH], const bf16* src, int gbase, int gstride, int tid) {
#pragma unroll
    for (int i = 0; i < NCH; ++i) { const int q = tid + NT * i, row = q >> 4, kc = (q & 15) * 8; r[i] = *(const v4u*)(src + (size_t)(gbase + row * gstride) * GW + kc); }
}
template <bool NORM, int NCH, int PITCH> __device__ __forceinline__ void st_rows(LAS bf16* dst, const v4u (&r)[NCH], const float (&gain)[8], int tid) {
#pragma unroll
    for (int i = 0; i < NCH; ++i) {
        const int q = tid + NT * i, row = q >> 4, kc = (q & 15) * 8; v4u v = r[i];
        if (NORM) {
            float f[8] = {bflo(v.x), bfhi(v.x), bflo(v.y), bfhi(v.y), bflo(v.z), bfhi(v.z), bflo(v.w), bfhi(v.w)}; float ss = 0.f;
#pragma unroll
            for (int e = 0; e < 8; ++e) ss += f[e] * f[e];
            ss += __shfl_xor(ss, 1); ss += __shfl_xor(ss, 2); ss += __shfl_xor(ss, 4); ss += __shfl_xor(ss, 8);
            const float rs = __builtin_amdgcn_rsqf(ss * (1.0f / HD) + EPS);
            v.x = pk2(f[0] * rs * gain[0], f[1] * rs * gain[1]); v.y = pk2(f[2] * rs * gain[2], f[3] * rs * gain[3]);
            v.z = pk2(f[4] * rs * gain[4], f[5] * rs * gain[5]); v.w = pk2(f[6] * rs * gain[6], f[7] * rs * gain[7]);
        }
        *(LAS v4u*)(dst + row * PITCH + kc) = v;
    }
}
constexpr int ATT_K = 0, ATT_V = 17408, ATT_PL = 35840, ATT_VOTE = 72704, ATT_Q = 73728;
__device__ __forceinline__ void load_qfrags(bf16x8 (&qf)[2][4], const LAS bf16* QH, int w, int lane) {
#pragma unroll
    for (int rt = 0; rt < 2; ++rt)
#pragma unroll
        for (int k = 0; k < 4; ++k) qf[rt][k] = *(const LAS bf16x8*)(QH + (32 * w + 16 * rt + (lane & 15)) * 136 + 32 * k + 8 * (lane >> 4));
}

__device__ __forceinline__ void dilated_unit(const Ctx& p, int l, int u, LAS unsigned char* lds) {
    const int tid = opaque_tid(), lane = tid & 63, w = tid >> 6, fr = lane & 15, fq = lane >> 4;
    const int pat = u >> 8, rem = u & 255, bh = rem >> 4, x = rem & 15, b = bh >> 2, h = bh & 3;
    const int d = pat == 0 ? 1 : (pat == 1 ? 4 : 16);
    const int r = pat == 0 ? 0 : (pat == 1 ? (x >> 2) : x), nbk = pat == 0 ? x : (pat == 1 ? (x & 3) : 0);
    LAS bf16* QH = (LAS bf16*)(lds + ATT_Q); LAS bf16* KH = (LAS bf16*)(lds + ATT_K); LAS bf16* VH = (LAS bf16*)(lds + ATT_V); LAS bf16* PL = (LAS bf16*)(lds + ATT_PL) + w * 32 * 72;
    const bf16* Qg = (const bf16*)(p.ws + WS_PACT) + SEG_CQ * SEG_STRIDE + h * HD; const bf16* Kg = (const bf16*)(p.ws + WS_PACT) + SEG_CK * SEG_STRIDE + h * HD;
    const bf16* Vg = (const bf16*)(p.ws + WS_PACT) + SEG_CV * SEG_STRIDE + h * HD;
    float qgain[8], kgain[8];
#pragma unroll
    for (int e = 0; e < 8; ++e) { qgain[e] = p.in(16)[l * HD + (tid & 15) * 8 + e]; kgain[e] = p.in(17)[l * HD + (tid & 15) * 8 + e]; }
    const float slope2 = exp2f(-2.0f * (float)(h + 1)) * (float)d * 1.4426950408889634f; constexpr float QK2 = KSCALE * 1.4426950408889634f;
    const int kt0 = (nbk == 0 ? 2 : 0), gk0 = b * SEQ + (nbk * 256 - 128) * d + r;
    v4u kr[2], vr[2];
    { v4u qr[8]; ld_rows<8>(qr, Qg, b * SEQ + (nbk * 256) * d + r, d, tid); ld_rows<2>(kr, Kg, gk0 + kt0 * 64 * d, d, tid); ld_rows<2>(vr, Vg, gk0 + kt0 * 64 * d, d, tid);
      st_rows<true, 8, 136>(QH, qr, qgain, tid); }
    __syncthreads();
    bf16x8 qf[2][4]; load_qfrags(qf, QH, w, lane);
    float m_i[2] = {-1e30f, -1e30f}, l_i[2] = {0.f, 0.f}; f32x4 o[2][8];
#pragma unroll
    for (int rt = 0; rt < 2; ++rt)
#pragma unroll
        for (int ds = 0; ds < 8; ++ds) o[rt][ds] = (f32x4){0.f, 0.f, 0.f, 0.f};
    for (int kt = kt0; kt < 6; ++kt) {
        __syncthreads();
        st_rows<true, 2, 136>(KH, kr, kgain, tid); st_rows<false, 2, 144>(VH, vr, kgain, tid);
        __syncthreads();
        if (kt < 5) { ld_rows<2>(kr, Kg, gk0 + (kt + 1) * 64 * d, d, tid); ld_rows<2>(vr, Vg, gk0 + (kt + 1) * 64 * d, d, tid); }
        if ((64 * kt + 63 >= 32 * w) && (64 * kt <= 32 * w + 31 + 128)) {
            f32x4 s[2][4];
#pragma unroll
            for (int rt = 0; rt < 2; ++rt)
#pragma unroll
                for (int n = 0; n < 4; ++n) s[rt][n] = (f32x4){0.f, 0.f, 0.f, 0.f};
#pragma unroll
            for (int k = 0; k < 4; ++k)
#pragma unroll
                for (int n = 0; n < 4; ++n) { const bf16x8 kf = *(const LAS bf16x8*)(KH + (16 * n + fr) * 136 + 32 * k + 8 * fq);
                    s[0][n] = __builtin_amdgcn_mfma_f32_16x16x32_bf16(kf, qf[0][k], s[0][n], 0, 0, 0); s[1][n] = __builtin_amdgcn_mfma_f32_16x16x32_bf16(kf, qf[1][k], s[1][n], 0, 0, 0); }
            float alpha[2];
#pragma unroll
            for (int rt = 0; rt < 2; ++rt) {
                const int D0 = 128 + (32 * w + 16 * rt + fr) - 64 * kt - 4 * fq; const float b0 = -slope2 * (float)D0; float mx = -1e30f;
#pragma unroll
                for (int n = 0; n < 4; ++n)
#pragma unroll
                    for (int j = 0; j < 4; ++j) { const bool valid = (unsigned)(D0 - (16 * n + j)) <= 128u;
                        const float sc = valid ? __builtin_fmaf(s[rt][n][j], QK2, __builtin_fmaf(slope2, (float)(16 * n + j), b0)) : -__builtin_inff(); s[rt][n][j] = sc; mx = fmaxf(mx, sc); }
                mx = fmaxf(mx, __shfl_xor(mx, 16)); mx = fmaxf(mx, __shfl_xor(mx, 32));
                const float m_new = fmaxf(m_i[rt], mx); alpha[rt] = __builtin_amdgcn_exp2f(m_i[rt] - m_new); float ls = 0.f;
#pragma unroll
                for (int n = 0; n < 4; ++n) {
#pragma unroll
                    for (int j = 0; j < 4; ++j) { const float pv = __builtin_amdgcn_exp2f(s[rt][n][j] - m_new); ls += pv; s[rt][n][j] = pv; }
                    v2u pw; pw.x = pk2(s[rt][n][0], s[rt][n][1]); pw.y = pk2(s[rt][n][2], s[rt][n][3]);
                    *(LAS v2u*)(PL + (16 * rt + fr) * 72 + 16 * n + 4 * fq) = pw;
                }
                ls += __shfl_xor(ls, 16); ls += __shfl_xor(ls, 32);
                l_i[rt] = l_i[rt] * alpha[rt] + ls; m_i[rt] = m_new;
            }
            asm volatile("" ::: "memory");
            bf16x8 pf[2][2];
#pragma unroll
            for (int rt = 0; rt < 2; ++rt) { pf[rt][0] = *(const LAS bf16x8*)(PL + (16 * rt + fr) * 72 + 8 * fq); pf[rt][1] = *(const LAS bf16x8*)(PL + (16 * rt + fr) * 72 + 32 + 8 * fq); }
#pragma unroll
            for (int ds = 0; ds < 8; ++ds) { const bf16x8 v0 = tr_frag(VH, 0, ds, lane), v1 = tr_frag(VH, 1, ds, lane);
#pragma unroll
                for (int rt = 0; rt < 2; ++rt) { o[rt][ds] = o[rt][ds] * alpha[rt];
                    o[rt][ds] = __builtin_amdgcn_mfma_f32_16x16x32_bf16(v0, pf[rt][0], o[rt][ds], 0, 0, 0); o[rt][ds] = __builtin_amdgcn_mfma_f32_16x16x32_bf16(v1, pf[rt][1], o[rt][ds], 0, 0, 0); } }
        }
    }
#pragma unroll
    for (int rt = 0; rt < 2; ++rt) {
        const int qi = 32 * w + 16 * rt + fr; const float inv = 1.0f / l_i[rt]; const int grow = b * SEQ + (nbk * 256 + qi) * d + r;
        bf16* og = (bf16*)(p.ws + WS_CPART) + (size_t)pat * SEG_STRIDE + (size_t)grow * GW + h * HD;
#pragma unroll
        for (int ds = 0; ds < 8; ++ds) { v2u ov; ov.x = pk2(o[rt][ds][0] * inv, o[rt][ds][1] * inv); ov.y = pk2(o[rt][ds][2] * inv, o[rt][ds][3] * inv); *(v2u*)(og + 16 * ds + 4 * fq) = ov; }
        if (fq == 0) ((float*)(p.ws + WS_LSE))[((size_t)pat * M + grow) * 4 + h] = m_i[rt] * 0.6931471805599453f + __logf(l_i[rt]);
    }
}

__device__ __forceinline__ void stick_unit(const Ctx& p, int u, LAS unsigned char* lds) {
    const int tid = opaque_tid(), lane = tid & 63, w = tid >> 6, fr = lane & 15, fq = lane >> 4;
    const int qb = 15 - (u >> 4), bh = u & 15, b = bh >> 2, h = bh & 3;
    LAS bf16* QH = (LAS bf16*)(lds + ATT_Q); LAS bf16* KH = (LAS bf16*)(lds + ATT_K); LAS bf16* VH = (LAS bf16*)(lds + ATT_V); LAS bf16* PL = (LAS bf16*)(lds + ATT_PL) + w * 32 * 72;
    volatile LAS int* vote = (volatile LAS int*)(lds + ATT_VOTE);
    const bf16* Qg = (const bf16*)(p.ws + WS_PACT) + SEG_SQ * SEG_STRIDE + h * HD; const bf16* Kg = (const bf16*)(p.ws + WS_PACT) + SEG_SK * SEG_STRIDE + h * HD;
    const bf16* Vg = (const bf16*)(p.ws + WS_PACT) + SEG_SV * SEG_STRIDE + h * HD;
    const float nogain[8] = {1.f, 1.f, 1.f, 1.f, 1.f, 1.f, 1.f, 1.f};
    const int ktop = 4 * qb + 3;
    v4u kr[2], vr[2];
    { v4u qr[8]; ld_rows<8>(qr, Qg, b * SEQ + qb * 256, 1, tid); ld_rows<2>(kr, Kg, b * SEQ + ktop * 64, 1, tid); ld_rows<2>(vr, Vg, b * SEQ + ktop * 64, 1, tid);
      st_rows<false, 8, 136>(QH, qr, nogain, tid); }
    if (tid < 8) vote[tid] = 0;
    __syncthreads();
    bf16x8 qf[2][4]; load_qfrags(qf, QH, w, lane);
    float R[2] = {0.f, 0.f}; f32x4 o[2][8];
#pragma unroll
    for (int rt = 0; rt < 2; ++rt)
#pragma unroll
        for (int ds = 0; ds < 8; ++ds) o[rt][ds] = (f32x4){0.f, 0.f, 0.f, 0.f};
    for (int kt = ktop; kt >= 0; --kt) {
        __syncthreads();
        { int all = 1;
#pragma unroll
          for (int i = 0; i < 8; ++i) all &= vote[i];
          if (all) break; }
        st_rows<false, 2, 136>(KH, kr, nogain, tid); st_rows<false, 2, 144>(VH, vr, nogain, tid);
        __syncthreads();
        if (kt > 0) { ld_rows<2>(kr, Kg, b * SEQ + (kt - 1) * 64, 1, tid); ld_rows<2>(vr, Vg, b * SEQ + (kt - 1) * 64, 1, tid); }
        if (64 * kt < 256 * qb + 32 * w + 31) {
            f32x4 s[2][4];
#pragma unroll
            for (int rt = 0; rt < 2; ++rt)
#pragma unroll
                for (int n = 0; n < 4; ++n) s[rt][n] = (f32x4){0.f, 0.f, 0.f, 0.f};
#pragma unroll
            for (int k = 0; k < 4; ++k)
#pragma unroll
                for (int n = 0; n < 4; ++n) { const bf16x8 kf = *(const LAS bf16x8*)(KH + (16 * n + fr) * 136 + 32 * k + 8 * fq);
                    s[0][n] = __builtin_amdgcn_mfma_f32_16x16x32_bf16(kf, qf[0][k], s[0][n], 0, 0, 0); s[1][n] = __builtin_amdgcn_mfma_f32_16x16x32_bf16(kf, qf[1][k], s[1][n], 0, 0, 0); }
#pragma unroll
            for (int rt = 0; rt < 2; ++rt) {
                const int Q0 = (256 * qb + 32 * w + 16 * rt + fr) - 64 * kt - 4 * fq; float carry = 0.f;
#pragma unroll
                for (int n = 3; n >= 0; --n) {
                    float lk[4], lsg[4];
#pragma unroll
                    for (int j = 0; j < 4; ++j) { const bool live = (16 * n + j) < Q0; const float z2 = s[rt][n][j] * (KSCALE * 1.4426950408889634f);
                        const float sp2 = fmaxf(z2, 0.f) + __builtin_amdgcn_logf(1.0f + __builtin_amdgcn_exp2f(-fabsf(z2)));
                        lk[j] = live ? -sp2 : 0.f; lsg[j] = live ? z2 - sp2 : -__builtin_inff(); }
                    const float s2 = lk[3], s1 = s2 + lk[2], s0 = s1 + lk[1], T = s0 + lk[0];
                    const float t1 = __shfl(T, (lane + 16) & 63), t2 = __shfl(T, (lane + 32) & 63), t3 = __shfl(T, (lane + 48) & 63);
                    const float base = (fq < 3 ? t1 : 0.f) + (fq < 2 ? t2 : 0.f) + (fq < 1 ? t3 : 0.f) + carry + R[rt];
                    const float w0 = __builtin_amdgcn_exp2f(lsg[0] + (s0 + base)), w1 = __builtin_amdgcn_exp2f(lsg[1] + (s1 + base)), w2 = __builtin_amdgcn_exp2f(lsg[2] + (s2 + base)), w3 = __builtin_amdgcn_exp2f(lsg[3] + base);
                    v2u pw; pw.x = pk2(w0, w1); pw.y = pk2(w2, w3);
                    *(LAS v2u*)(PL + (16 * rt + fr) * 72 + 16 * n + 4 * fq) = pw;
                    carry += (T + t1) + (t2 + t3);
                }
                R[rt] += carry;
            }
            asm volatile("" ::: "memory");
            bf16x8 pf[2][2];
#pragma unroll
            for (int rt = 0; rt < 2; ++rt) { pf[rt][0] = *(const LAS bf16x8*)(PL + (16 * rt + fr) * 72 + 8 * fq); pf[rt][1] = *(const LAS bf16x8*)(PL + (16 * rt + fr) * 72 + 32 + 8 * fq); }
#pragma unroll
            for (int ds = 0; ds < 8; ++ds) { const bf16x8 v0 = tr_frag(VH, 0, ds, lane), v1 = tr_frag(VH, 1, ds, lane);
#pragma unroll
                for (int rt = 0; rt < 2; ++rt) { o[rt][ds] = __builtin_amdgcn_mfma_f32_16x16x32_bf16(v0, pf[rt][0], o[rt][ds], 0, 0, 0); o[rt][ds] = __builtin_amdgcn_mfma_f32_16x16x32_bf16(v1, pf[rt][1], o[rt][ds], 0, 0, 0); } }
        }
        { const int done = __all(R[0] <= -150.5f && R[1] <= -150.5f); if (lane == 0) vote[w] = done; }
    }
#pragma unroll
    for (int rt = 0; rt < 2; ++rt) {
        bf16* og = (bf16*)(p.ws + WS_DOUT) + (size_t)(b * SEQ + 256 * qb + 32 * w + 16 * rt + fr) * GW + h * HD;
#pragma unroll
        for (int ds = 0; ds < 8; ++ds) { v2u ov; ov.x = pk2(o[rt][ds][0], o[rt][ds][1]); ov.y = pk2(o[rt][ds][2], o[rt][ds][3]); *(v2u*)(og + 16 * ds + 4 * fq) = ov; }
    }
}

__device__ __forceinline__ void finalize_unit(const Ctx& p, int l, int u) {
    const int tid = opaque_tid(), lane = tid & 63, w = tid >> 6, hd = lane >> 4;
    const bf16* CP = (const bf16*)(p.ws + WS_CPART); const float* LSE = (const float*)(p.ws + WS_LSE); const bf16* DO = (const bf16*)(p.ws + WS_DOUT); bf16* mixed = (bf16*)(p.ws + WS_MIXED);
    const float* gc = p.in(18) + l * DM + 2 * GW + lane * 8; const float* gd = p.in(18) + l * DM + 3 * GW + lane * 8;
    float gcv[8], gdv[8];
#pragma unroll
    for (int e = 0; e < 8; ++e) { gcv[e] = gc[e]; gdv[e] = gd[e]; }
    for (int tb = 0; tb < 8; tb += 4) {
        v4u a[4], bq[4], cq[4], dv[4]; float l0[4], l1[4], l2[4];
#pragma unroll
        for (int tt = 0; tt < 4; ++tt) {
            const int grow = u * 64 + w * 8 + tb + tt;
            l0[tt] = LSE[((size_t)0 * M + grow) * 4 + hd]; l1[tt] = LSE[((size_t)1 * M + grow) * 4 + hd]; l2[tt] = LSE[((size_t)2 * M + grow) * 4 + hd];
            a[tt] = *(const v4u*)(CP + (size_t)grow * GW + lane * 8); bq[tt] = *(const v4u*)(CP + SEG_STRIDE + (size_t)grow * GW + lane * 8); cq[tt] = *(const v4u*)(CP + 2 * SEG_STRIDE + (size_t)grow * GW + lane * 8);
            dv[tt] = *(const v4u*)(DO + (size_t)grow * GW + lane * 8);
        }
#pragma unroll
        for (int tt = 0; tt < 4; ++tt) {
            const int grow = u * 64 + w * 8 + tb + tt;
            const float L = fmaxf(l0[tt], fmaxf(l1[tt], l2[tt])); float w0 = __expf(l0[tt] - L), w1 = __expf(l1[tt] - L), w2 = __expf(l2[tt] - L); const float inv = 1.0f / (w0 + w1 + w2); w0 *= inv; w1 *= inv; w2 *= inv;
            const unsigned aw[4] = {a[tt].x, a[tt].y, a[tt].z, a[tt].w}, bw[4] = {bq[tt].x, bq[tt].y, bq[tt].z, bq[tt].w}, cw[4] = {cq[tt].x, cq[tt].y, cq[tt].z, cq[tt].w};
            float f[8]; float ss = 0.f;
#pragma unroll
            for (int e = 0; e < 4; ++e) { f[2 * e] = w0 * bflo(aw[e]) + w1 * bflo(bw[e]) + w2 * bflo(cw[e]); f[2 * e + 1] = w0 * bfhi(aw[e]) + w1 * bfhi(bw[e]) + w2 * bfhi(cw[e]); ss += f[2 * e] * f[2 * e] + f[2 * e + 1] * f[2 * e + 1]; }
            ss = wave_sum(ss); float rs = __builtin_amdgcn_rsqf(ss * (1.0f / GW) + EPS);
            v4u ov; ov.x = pk2(f[0] * rs * gcv[0], f[1] * rs * gcv[1]); ov.y = pk2(f[2] * rs * gcv[2], f[3] * rs * gcv[3]); ov.z = pk2(f[4] * rs * gcv[4], f[5] * rs * gcv[5]); ov.w = pk2(f[6] * rs * gcv[6], f[7] * rs * gcv[7]);
            *(v4u*)(mixed + (size_t)grow * DM + 2 * GW + lane * 8) = ov;
            const unsigned dw[4] = {dv[tt].x, dv[tt].y, dv[tt].z, dv[tt].w};
            ss = 0.f;
#pragma unroll
            for (int e = 0; e < 4; ++e) { f[2 * e] = bflo(dw[e]); f[2 * e + 1] = bfhi(dw[e]); ss += f[2 * e] * f[2 * e] + f[2 * e + 1] * f[2 * e + 1]; }
            ss = wave_sum(ss); rs = __builtin_amdgcn_rsqf(ss * (1.0f / GW) + EPS);
            ov.x = pk2(f[0] * rs * gdv[0], f[1] * rs * gdv[1]); ov.y = pk2(f[2] * rs * gdv[2], f[3] * rs * gdv[3]); ov.z = pk2(f[4] * rs * gdv[4], f[5] * rs * gdv[5]); ov.w = pk2(f[6] * rs * gdv[6], f[7] * rs * gdv[7]);
            *(v4u*)(mixed + (size_t)grow * DM + 3 * GW + lane * 8) = ov;
        }
    }
}

#ifndef PROBE_REPEAT
#define PROBE_REPEAT 0
#endif
#ifndef K_ROTATE
#define K_ROTATE 0
#endif
#define KROT(K_) (K_ROTATE ? ((((int)blockIdx.x & 7) * ((K_) / 64 / 8)) & ~1) : 0)
#ifndef PROBE_STAMP
#define PROBE_STAMP_DIV 10000.0f
#define PROBE_STAMP 0
#endif
#define REP(k) for (int rep_ = 0; rep_ < (((PROBE_REPEAT) >> (k)) & 1) + 1; ++rep_)
__global__ void __launch_bounds__(NT, 2) fwd_kernel(Params kp) {
    extern __shared__ __attribute__((aligned(16))) unsigned char lds_raw[];
    LAS unsigned char* lds = (LAS unsigned char*)lds_raw;
    volatile LAS unsigned* MISC = (volatile LAS unsigned*)(lds + LDS_MISC_OFF);
    volatile LAS int* qslot = (volatile LAS int*)(MISC + 4);
    const int wid0 = __builtin_amdgcn_readfirstlane((int)threadIdx.x >> 6);
    if (threadIdx.x < 16) MISC[threadIdx.x] = 0u;
    __syncthreads();
    XcdBarrier bar; bar.bar = (unsigned*)(kp.ws + WS_CTL) + CW_BAR; bar.x = 0; bar.st = nullptr;
    if (!MK_SPLIT) bar = xcd_barrier_post((unsigned*)(kp.ws + WS_CTL) + CW_BAR, MISC);
    bar.wid = wid0;
    const int lo = kp.ph_lo, hi = kp.ph_hi;
    unsigned long long stamp_acc = 0ull, stamp_t0 = 0ull;
#define ST_BEGIN(bit) do { if ((PROBE_STAMP >> (bit)) & 1) { __syncthreads(); stamp_t0 = wall_clock64(); } } while (0)
#define ST_END(bit) do { if ((PROBE_STAMP >> (bit)) & 1) { __syncthreads(); stamp_acc += wall_clock64() - stamp_t0; } } while (0)
#define IN(k) (lo <= (k) && (k) < hi)
#define SEAM(k) do { if (IN(k) && IN((k) + 1)) { if (!MK_SPLIT) xcd_barrier(bar); } } while (0)
#define SEAML(k) do { if (IN(k) && IN((k) + 1)) { if (!MK_SPLIT) xcd_barrier(bar, MISC[2] != 0u ? 1 : 0); } } while (0)
#define SEAMP(k) do { if (IN(k) && IN((k) + 1)) { if (!MK_SPLIT) xcd_barrier(bar, MISC[2] != 0u ? 2 : 0, (unsigned)PAIRQ()); } } while (0)
#define PAIRQ() ((VB() & 7) >> 1)
#define PAIRJ() ((VB() & 1) * 32 + (VB() >> 3))
#define VB() (MISC[2] != 0u ? (int)(MISC[5] * 8u + MISC[2] - 1u) : (int)blockIdx.x)
#define CTX() const Ctx p = make_ctx(wid0); unsigned* ctl = (unsigned*)(p.ws + WS_CTL); unsigned long long* ssq = (unsigned long long*)(p.ws + WS_SSQ); bf16* xb = (bf16*)(p.ws + WS_XB); bf16* act = (bf16*)(p.ws + WS_PACT); bf16* mixed = (bf16*)(p.ws + WS_MIXED); \
    unsigned long long* ssqA = ssq + (size_t)(3 * l) * M; unsigned long long* ssqB = ssq + (size_t)(3 * l + 1) * M; unsigned long long* ssqC = ssq + (size_t)(3 * l + 2) * M; unsigned long long* ssqN = ssq + (size_t)(3 * l + 3) * M; \
    (void)ctl; (void)xb; (void)act; (void)mixed; (void)ssqA; (void)ssqB; (void)ssqC; (void)ssqN

    ST_BEGIN(2);
    if (IN(0)) { const Ctx p = make_ctx(wid0); prologue_x(p); }
    for (int l = 0; l < NLAYER; ++l) {
        const int pb = 1 + l * PH_PER_LAYER;
        if (l > 0) ST_BEGIN(2);
        if (IN(pb + 0)) REP(0) { const Ctx p = make_ctx(wid0); convert_gu_i8(p, l, lds); __syncthreads(); convert_layer(p, l, -1);
            if (l > 0) quant_rows_i8(p, (const bf16*)(p.ws + WS_XB), M, p.ws + WS_X8, (float*)(p.ws + WS_ROWSC)); }
        SEAM(pb + 0);
        ST_END(2);
        ST_BEGIN(0);
        if (IN(pb + 1)) REP(4) { CTX(); if (rep_) xcd_barrier(bar);
            float* rowsc = (float*)(p.ws + WS_ROWSC); float* colsc = (float*)(p.ws + WS_COLSC1);
            pg8::Gemm g{(const bf16*)(p.ws + WS_X8), (const bf16*)(p.ws + WS_WGU1), M, 2 * DFF, DM / 2, 0}; pg8::StaticOrder S; S.init(M, 2 * DFF, (int)gridDim.x, VB());
            if (pg8::ffn_f8(l, 0)) { pg8::EpiSwigluF8I8 E{act, pg8::DFF_P, ssqA, 1.0f / (DM * pg8::SSQ_FX), 1.0f, rowsc, colsc};
                pg8::gemm_phase<pg8::EpiSwigluF8I8, pg8::StaticOrder, PG8_ALIGN, PG8_SP2, false, true>(lds, g, S, E, wid0); }
            else { pg8::EpiSwigluI8 E{act, DFF, ssqA, 1.0f / (DM * pg8::SSQ_FX), 1.0f, rowsc, colsc};
                pg8::gemm_phase<pg8::EpiSwigluI8, pg8::StaticOrder, PG8_ALIGN, PG8_SP2, false, true>(lds, g, S, E, wid0); }
        }
        SEAML(pb + 1);
        if (IN(pb + 2)) { CTX();
            pg8::StaticOrder S; S.init(M, DM, (int)gridDim.x, VB());
            if (pg8::ffn_f8(l, 0)) { pg8::Gemm g{act, (const bf16*)(p.ws + WS_WD1), M, DM, pg8::DFF_P / 2, 0};
                pg8::EpiResid E{xb, nullptr, xb, ssqB, DM, 0.5f / (pg8::F8_ACT_SCALE * pg8::F8_W_SCALE), nullptr};
                pg8::gemm_phase<pg8::EpiResid, pg8::StaticOrder, PG8_ALIGN, PG8_SP2, true>(lds, g, S, E, wid0); }
            else { pg8::Gemm g{act, (const bf16*)(p.ws + WS_WD1), M, DM, DFF, 0};
                pg8::EpiResid E{xb, nullptr, xb, ssqB, DM, 0.5f, nullptr};
                pg8::gemm_phase<pg8::EpiResid, pg8::StaticOrder, PG8_ALIGN, PG8_SP2>(lds, g, S, E, wid0); }
        }
        SEAM(pb + 2);
        if (IN(pb + 3)) REP(5) { CTX(); if (rep_) xcd_barrier(bar);
            pg8::Gemm g{xb, (const bf16*)(p.ws + WS_WIN), M, NP, DM, KROT(DM)}; pg8::StaticOrder S; S.init(M, NP, (int)gridDim.x, VB());
            pg8::EpiSplit E{act, SEG_STRIDE, ssqB, 1.0f / (DM * pg8::SSQ_FX)};
            pg8::gemm_phase<pg8::EpiSplit, pg8::StaticOrder, PG8_ALIGN, PG8_SP2>(lds, g, S, E, wid0);
            gates_phase(p, l, ssqB, lds, VB());
        }
        SEAMP(pb + 3);
        ST_END(0);
        ST_BEGIN(1);
        if (IN(pb + 4)) REP(1) { CTX(); if (rep_) xcd_barrier(bar);
            const int pq = PAIRQ(), pj = PAIRJ();
            for (int k = 0; k < 3; ++k) { __syncthreads(); dilated_unit(p, l, 256 * k + 64 * pq + pj, lds); }
            {
                const int tid_ = opaque_tid(), u0 = 256 * pq + pj; v4u kvr[2], vvr[2]; float gi, gf; mlstm_ld_kv(p, u0, tid_, kvr, vvr); mlstm_ld_g(p, u0, tid_, gi, gf);
                for (int u = u0; u < 256 * pq + 256; u += 64) { __syncthreads(); mlstm1_unit(p, l, u, u + 64, kvr, vvr, gi, gf, lds); }
            }
            {
                const int tid_ = opaque_tid(), u0 = 256 * pq + pj; unsigned xv[11]; float lci; lru_ld<1>(p, u0, tid_, xv, lci); LruC C; lru_cload(p, l, tid_, C);
                for (int u = u0; u < 256 * pq + 256; u += 64) { __syncthreads(); lru_unit<1>(p, l, u, u + 64, xv, lci, C, lds); }
            }
        }
        SEAMP(pb + 4);
        if (IN(pb + 5)) REP(2) { CTX(); if (rep_) xcd_barrier(bar);
            const int pq = PAIRQ();
            unsigned* ctr = ctl + CW_Q + 64 * (pb + 5 + 32 * rep_) + 16 * pq;
            for (int s = q_next(p, ctr, qslot); s < 64 + 8 + 128; s = q_next(p, ctr, qslot)) {
                if (s < 64) stick_unit(p, 16 * (s >> 2) + 4 * pq + (s & 3), lds);
                else if (s < 64 + 8) lru_carry_unit(p, 8 * pq + s - 64, lds);
                else mlstm_scan_unit(p, 128 * pq + s - 72, lds);
            }
        }
        SEAMP(pb + 5);
        if (IN(pb + 6)) REP(3) { CTX(); if (rep_) xcd_barrier(bar);
            {
                const int tid_ = opaque_tid(), u0 = 256 * PAIRQ() + PAIRJ(); v4u pre[10]; float gi, gf, mrun_pf, nv_pf; mlstm3_ld(p, u0, tid_, pre); mlstm_ld_g(p, u0, tid_, gi, gf);
                mrun_pf = ((const float*)(p.ws + WS_MRUN))[u0]; nv_pf = ((const float*)(p.ws + WS_NST))[(size_t)u0 * 128 + ((tid_ - 64) & 127)];
                for (int u = u0; u < (u0 | 255) + 1; u += 64) { __syncthreads(); mlstm3_unit(p, l, u, u + 64, pre, gi, gf, mrun_pf, nv_pf, lds); }
            }
            {
                const int tid_ = opaque_tid(), u0 = 256 * PAIRQ() + PAIRJ(); float pa[16], pu[16], pg[16]; float lci; lru3_ld(p, u0, tid_, pa, pu, pg, lci); LruC C; lru_cload(p, l, tid_, C);
                for (int u = u0; u < (u0 | 255) + 1; u += 64) { __syncthreads(); lru3_unit(p, u, u + 64, pa, pu, pg, lci, C, lds); }
            }
            { __syncthreads(); finalize_unit(p, l, 64 * PAIRQ() + PAIRJ()); }
        }
        SEAM(pb + 6);
        ST_END(1);
        ST_BEGIN(0);
#if (PROBE_REPEAT >> 7) & 1
        for (int xb_ = 0; xb_ < 20; ++xb_) xcd_barrier(bar);
#endif
        if (IN(pb + 7)) { CTX();
            pg8::Gemm g{mixed, (const bf16*)(p.ws + WS_WOUT), M, DM, DM, KROT(DM)}; pg8::StaticOrder S; S.init(M, DM, (int)gridDim.x, VB());
            pg8::EpiResid E{xb, nullptr, xb, ssqC, DM, 1.0f, pg8::ffn_gu_f8(l, 1) ? p.ws + WS_X8 : nullptr};
            pg8::gemm_phase<pg8::EpiResid, pg8::StaticOrder, PG8_ALIGN, PG8_SP2>(lds, g, S, E, wid0);
        }
        SEAML(pb + 7);
        if (IN(pb + 8)) { CTX();
            float* rowsc = (float*)(p.ws + WS_ROWSC); float* colsc = (float*)(p.ws + WS_COLSC2);
            quant_rows_i8(p, xb, M, p.ws + WS_X8, rowsc, VB());
            xcd_barrier(bar, MISC[2] != 0u ? 1 : 0);
            pg8::Gemm g{(const bf16*)(p.ws + WS_X8), (const bf16*)(p.ws + WS_WGU2), M, 2 * DFF, DM / 2, 0}; pg8::StaticOrder S; S.init(M, 2 * DFF, (int)gridDim.x, VB());
            if (pg8::ffn_f8(l, 1)) { pg8::EpiSwigluF8I8 E{act, pg8::DFF_P, ssqC, 1.0f / (DM * pg8::SSQ_FX), 1.0f, rowsc, colsc};
                pg8::gemm_phase<pg8::EpiSwigluF8I8, pg8::StaticOrder, PG8_ALIGN, PG8_SP2, false, true>(lds, g, S, E, wid0); }
            else { pg8::EpiSwigluI8 E{act, DFF, ssqC, 1.0f / (DM * pg8::SSQ_FX), 1.0f, rowsc, colsc};
                pg8::gemm_phase<pg8::EpiSwigluI8, pg8::StaticOrder, PG8_ALIGN, PG8_SP2, false, true>(lds, g, S, E, wid0); }
        }
        SEAML(pb + 8);
        if (IN(pb + 9)) { CTX();
            pg8::StaticOrder S; S.init(M, DM, (int)gridDim.x, VB());
            const bool lastl = (l == NLAYER - 1);
            if (pg8::ffn_f8(l, 1)) { pg8::Gemm g{act, (const bf16*)(p.ws + WS_WD2), M, DM, pg8::DFF_P / 2, 0};
                pg8::EpiResid E{xb, lastl ? p.out : nullptr, lastl ? nullptr : xb, lastl ? nullptr : ssqN, DM, 0.5f / (pg8::F8_ACT_SCALE * pg8::F8_W_SCALE), nullptr};
                pg8::gemm_phase<pg8::EpiResid, pg8::StaticOrder, PG8_ALIGN, PG8_SP2, true>(lds, g, S, E, wid0); }
            else { pg8::Gemm g{act, (const bf16*)(p.ws + WS_WD2), M, DM, DFF, 0};
                pg8::EpiResid E{xb, lastl ? p.out : nullptr, lastl ? nullptr : xb, lastl ? nullptr : ssqN, DM, 0.5f, nullptr};
                pg8::gemm_phase<pg8::EpiResid, pg8::StaticOrder, PG8_ALIGN, PG8_SP2>(lds, g, S, E, wid0); }
        }
        SEAM(pb + 9);
        ST_END(0);
    }
#if PROBE_STAMP
    {
        const Ctx p = make_ctx(wid0); float* tw = (float*)(p.ws + WS_G);
        xcd_barrier(bar);
        if (blockIdx.x == 0 && threadIdx.x == 0) { __hip_atomic_store(tw, (float)stamp_acc * 0.01f, __ATOMIC_RELAXED, __HIP_MEMORY_SCOPE_AGENT); }
        xcd_barrier(bar);
        const float sc = 1.0f + __hip_atomic_load(tw, __ATOMIC_RELAXED, __HIP_MEMORY_SCOPE_AGENT) * (1.0f / PROBE_STAMP_DIV);
        for (size_t i = (size_t)blockIdx.x * NT + threadIdx.x; i < (size_t)M * DM; i += (size_t)gridDim.x * NT) p.out[i] *= sc;
    }
#endif
#undef IN
#undef SEAM
#undef CTX
}

extern "C" void kernel_launch(void* const* d_in, const int* in_sizes, int n_in, void* d_out, int out_size, void* d_ws, size_t ws_size, hipStream_t stream) {
    static int grid = 0;
    if (grid == 0) {
        if (n_in != 24 || in_sizes[0] != M * DM || out_size != M * DM || ws_size < WS_END) { fprintf(stderr, "kernel_launch: unexpected shapes (n_in %d, in0 %d, out %d, ws %zu < %zu)\n", n_in, n_in > 0 ? in_sizes[0] : -1, out_size, ws_size, (size_t)WS_END); grid = -1; return; }
        int dev = 0, cus = 0, per_cu = 0;
        if (hipGetDevice(&dev) != hipSuccess || hipDeviceGetAttribute(&cus, hipDeviceAttributeMultiprocessorCount, dev) != hipSuccess) { grid = -1; return; }
        if (hipFuncSetAttribute((const void*)fwd_kernel, hipFuncAttributeMaxDynamicSharedMemorySize, LDS_BYTES) != hipSuccess) { fprintf(stderr, "kernel_launch: hipFuncSetAttribute failed\n"); grid = -1; return; }
        if (hipOccupancyMaxActiveBlocksPerMultiprocessor(&per_cu, (const void*)fwd_kernel, NT, LDS_BYTES) != hipSuccess || per_cu < 1) { fprintf(stderr, "kernel_launch: occupancy query says %d\n", per_cu); (void)hipGetLastError(); }
        grid = cus;
    }
    if (grid < 0) return;
    (void)hipMemsetAsync((char*)d_ws + WS_CTL, 0, CTL_ZERO_BYTES, stream);
    Params a{};
    for (int i = 0; i < 24; ++i) a.in[i] = (const float*)d_in[i];
    a.out = (float*)d_out; a.ws = (unsigned char*)d_ws;
#if MK_SPLIT
    for (int ph = 0; ph < N_PHASES; ++ph) { a.ph_lo = ph; a.ph_hi = ph + 1; hipLaunchKernelGGL(fwd_kernel, dim3(grid), dim3(NT), LDS_BYTES, stream, a); }
#else
    a.ph_lo = 0; a.ph_hi = N_PHASES;
    hipLaunchKernelGGL(fwd_kernel, dim3(grid), dim3(NT), LDS_BYTES, stream, a);
#endif
}
```

```cpp
#include <hip/hip_runtime.h>
#include <cstdio>
#include <cstdint>
#define LAS __attribute__((address_space(3)))
namespace pg8 {
#define PG8_LAS __attribute__((address_space(3)))
typedef unsigned short bf16_t;
typedef short bf16x8 __attribute__((ext_vector_type(8)));
typedef float f32x4 __attribute__((ext_vector_type(4)));
typedef unsigned u32x4 __attribute__((ext_vector_type(4)));
typedef int i32x4 __attribute__((ext_vector_type(4)));
typedef int i32x8 __attribute__((ext_vector_type(8)));
__device__ __forceinline__ i32x8 cat8(bf16x8 lo, bf16x8 hi) { const i32x4 a = __builtin_bit_cast(i32x4, lo), b = __builtin_bit_cast(i32x4, hi); return __builtin_shufflevector(a, b, 0, 1, 2, 3, 4, 5, 6, 7); }
__device__ __forceinline__ void mfma_f8(f32x4& acc, i32x8 a, i32x8 b) { asm volatile("v_mfma_f32_16x16x128_f8f6f4 %0, %1, %2, %0" : "+v"(acc) : "v"(a), "v"(b)); }
constexpr float F8_ACT_SCALE = 4.0f, F8_W_SCALE = 64.0f;
__host__ __device__ constexpr bool ffn_f8(int l, int f) { return !(l == 0 && f == 0); }
__host__ __device__ constexpr bool ffn_gu_f8(int l, int f) { return false; }
constexpr int DFF_P = 5632;
constexpr int BM = 256, BK = 64, HALF = 128, HTB = HALF * BK * 2  , STAGE_BYTES = 8 * HTB, NXCD = 8, WGM = 4;

__host__ __device__ __forceinline__ int lds_byte(int r, int c) { const int st = (r >> 4) * 2 + (c >> 5), rr = r & 15, cc = c & 31, ob = rr * 64 + cc * 2; return st * 1024 + (ob ^ (((ob >> 9) & 1) << 5)); }
__host__ __device__ __forceinline__ void stage_rc(int b, int& R, int& C) { const int st = b / 1024, sb = b % 1024, swz = sb ^ (((sb >> 9) & 1) << 5); R = (st >> 1) * 16 + swz / 64; C = (st & 1) * 32 + (swz % 64) / 2; }
__host__ __device__ __forceinline__ int perm32(int rho) { const int n = rho >> 4, i = rho & 15; return 8 * (i >> 2) + 4 * n + (i & 3); }

struct Unit { int pm, pn; };
struct Gemm { const bf16_t* A; const bf16_t* Bt; int M, N, K, rot; };

struct StaticOrder {
    int nM, nN, nwg, G, c;
    __host__ __device__ void init(int M, int N, int G_, int c_) { nM = M / BM; nN = N / BM; nwg = nM * nN; G = G_; c = c_; }
    __host__ __device__ bool next(int i, Unit& u) const {
        const long L = (long)i * G + c; if (L >= nwg) return false;
        int wgid = (int)L; { const int q = nwg / NXCD, r = nwg % NXCD, xcd = wgid % NXCD, off = wgid / NXCD; wgid = (xcd < r ? xcd * (q + 1) : r * (q + 1) + (xcd - r) * q) + off; }
        const int nig = WGM * nN, gid = wgid / nig, fm = gid * WGM, gsz = (nM - fm) < WGM ? (nM - fm) : WGM;
        u.pm = fm + ((wgid % nig) % gsz); u.pn = (wgid % nig) / gsz; return true;
    }
    __device__ __forceinline__ void a_ready(const Unit&) const {}
    __device__ __forceinline__ void done(const Unit&) const {}
};

__device__ __forceinline__ unsigned cvt_pk_bf16(float lo, float hi) { unsigned r; asm volatile("v_cvt_pk_bf16_f32 %0, %1, %2" : "=v"(r) : "v"(lo), "v"(hi)); return r; }

typedef float f32x2 __attribute__((ext_vector_type(2)));
constexpr float RMS_EPS_F = 1e-6f, SSQ_FX = 1048576.0f;
typedef __bf16 bf16x2_cv __attribute__((ext_vector_type(2)));
__device__ __forceinline__ unsigned cvt_pk_bf16_nv(f32x2 v) { return __builtin_bit_cast(unsigned, __builtin_convertvector(v, bf16x2_cv)); }
template <bool F8, bool I8 = false> struct EpiSwigluT {
    static constexpr bool PERM = true, AFTER_DRAIN = false;
    bf16_t* O; int ldc; const unsigned long long* ssq; float inv_d; float in_scale; const float* rowscale; const float* colscale;
    __device__ __forceinline__ void operator()(const f32x4 (&acc)[2][2][4][2], const Unit& u, int wr, int wc, int fr, int fq) const {
        const int row0 = u.pm * BM + wr * 64 + fr, col0 = u.pn * HALF + wc * 32 + 8 * fq;
        f32x2 cg[4], cu[4];
        if constexpr (I8) {
#pragma unroll
            for (int e = 0; e < 4; ++e) { cg[e] = *(const f32x2*)(colscale + u.pn * BM + wc * 32 + 8 * fq + 2 * e); cu[e] = *(const f32x2*)(colscale + u.pn * BM + HALF + wc * 32 + 8 * fq + 2 * e); }
        }
#pragma unroll
        for (int ai = 0; ai < 2; ++ai) {
            float rs[4];
#pragma unroll
            for (int m = 0; m < 4; ++m) { rs[m] = __builtin_amdgcn_rsqf((float)ssq[row0 + ai * HALF + m * 16] * inv_d + RMS_EPS_F) * in_scale; if constexpr (I8) rs[m] *= rowscale[row0 + ai * HALF + m * 16]; }
#pragma unroll
            for (int mp = 0; mp < 4; mp += 2) {
                f32x2 g[8], gu[8], e[8];
#pragma unroll
                for (int q = 0; q < 8; ++q) { const int m = mp + (q >> 2), n = (q >> 1) & 1, hh = q & 1;
                    g[q] = (f32x2){acc[ai][0][m][n][2 * hh], acc[ai][0][m][n][2 * hh + 1]}; gu[q] = (f32x2){acc[ai][1][m][n][2 * hh], acc[ai][1][m][n][2 * hh + 1]};
                    if constexpr (I8) { const i32x4 gi = __builtin_bit_cast(i32x4, acc[ai][0][m][n]), ui = __builtin_bit_cast(i32x4, acc[ai][1][m][n]);
                        g[q] = (f32x2){(float)gi[2 * hh], (float)gi[2 * hh + 1]} * cg[2 * n + hh]; gu[q] = (f32x2){(float)ui[2 * hh], (float)ui[2 * hh + 1]} * cu[2 * n + hh]; } }
#pragma unroll
                for (int q = 0; q < 8; ++q) { const float c = -rs[mp + (q >> 2)] * 1.4426950408889634f; const f32x2 a = g[q] * (f32x2){c, c}; e[q].x = __builtin_amdgcn_exp2f(a.x); e[q].y = __builtin_amdgcn_exp2f(a.y); }
#pragma unroll
                for (int q = 0; q < 8; ++q) { const float c2 = rs[mp + (q >> 2)] * rs[mp + (q >> 2)] * (F8 ? F8_ACT_SCALE : 1.0f); gu[q] = (g[q] * gu[q]) * (f32x2){c2, c2}; }
#pragma unroll
                for (int q = 0; q < 8; ++q) { const f32x2 d = e[q] + (f32x2){1.0f, 1.0f}; e[q].x = __builtin_amdgcn_rcpf(d.x); e[q].y = __builtin_amdgcn_rcpf(d.y); }
#pragma unroll
                for (int mm = 0; mm < 2; ++mm) {
                    if constexpr (F8) {
                        typedef unsigned u32x2v __attribute__((ext_vector_type(2)));
                        const f32x2 h0 = gu[4 * mm + 0] * e[4 * mm + 0], h1 = gu[4 * mm + 1] * e[4 * mm + 1], h2 = gu[4 * mm + 2] * e[4 * mm + 2], h3 = gu[4 * mm + 3] * e[4 * mm + 3];
                        u32x2v w; w.x = (unsigned)__builtin_amdgcn_cvt_pk_fp8_f32(h1.x, h1.y, __builtin_amdgcn_cvt_pk_fp8_f32(h0.x, h0.y, 0, false), true);
                        w.y = (unsigned)__builtin_amdgcn_cvt_pk_fp8_f32(h3.x, h3.y, __builtin_amdgcn_cvt_pk_fp8_f32(h2.x, h2.y, 0, false), true);
                        unsigned char* o8 = (unsigned char*)O + (size_t)(row0 + ai * HALF + (mp + mm) * 16) * ldc + col0;
                        *(u32x2v*)o8 = w;
                        if (u.pn * HALF + HALF == DFF_P - HALF) { unsigned z = 0u; asm("" : "+v"(z)); *(u32x2v*)(o8 + HALF) = (u32x2v){z, z}; }
                        continue;
                    }
                    u32x4 w; w.x = cvt_pk_bf16_nv(gu[4 * mm + 0] * e[4 * mm + 0]); w.y = cvt_pk_bf16_nv(gu[4 * mm + 1] * e[4 * mm + 1]); w.z = cvt_pk_bf16_nv(gu[4 * mm + 2] * e[4 * mm + 2]); w.w = cvt_pk_bf16_nv(gu[4 * mm + 3] * e[4 * mm + 3]);
                    *(u32x4*)(O + (size_t)(row0 + ai * HALF + (mp + mm) * 16) * ldc + col0) = w;
                }
            }
        }
    }
};
typedef EpiSwigluT<false> EpiSwiglu; typedef EpiSwigluT<true> EpiSwigluF8; typedef EpiSwigluT<false, true> EpiSwigluI8; typedef EpiSwigluT<true, true> EpiSwigluF8I8;
struct EpiResid {
    static constexpr bool PERM = false, AFTER_DRAIN = false;
    const bf16_t* base; float* out; bf16_t* xb; unsigned long long* ssq; int ldc; float alpha; unsigned char* x8;
    __device__ __forceinline__ void operator()(const f32x4 (&acc)[2][2][4][2], const Unit& u, int wr, int wc, int fr, int fq) const {
        typedef unsigned u32x2v __attribute__((ext_vector_type(2)));
        const int row0 = u.pm * BM + wr * 64 + fr, col0 = u.pn * BM + wc * 32 + 4 * fq;
#pragma unroll
        for (int ai = 0; ai < 2; ++ai) {
            u32x2v b4[4][2][2];
#pragma unroll
            for (int m = 0; m < 4; ++m)
#pragma unroll
                for (int bj = 0; bj < 2; ++bj)
#pragma unroll
                    for (int n = 0; n < 2; ++n) b4[m][bj][n] = *(const u32x2v*)(base + (size_t)(row0 + ai * HALF + m * 16) * ldc + col0 + bj * HALF + n * 16);
#pragma unroll
            for (int m = 0; m < 4; ++m) {
                const int row = row0 + ai * HALF + m * 16; const size_t off = (size_t)row * ldc + col0; float s = 0.f;
#pragma unroll
                for (int bj = 0; bj < 2; ++bj)
#pragma unroll
                    for (int n = 0; n < 2; ++n) {
                        const u32x2v bb = b4[m][bj][n];
                        const f32x4 bf = {__builtin_bit_cast(float, bb.x << 16), __builtin_bit_cast(float, bb.x & 0xffff0000u), __builtin_bit_cast(float, bb.y << 16), __builtin_bit_cast(float, bb.y & 0xffff0000u)};
                        const f32x4 o = bf + acc[ai][bj][m][n] * alpha;
                        if (out) *(f32x4*)(out + off + bj * HALF + n * 16) = o;
                        if (xb) { u32x2v w; w.x = cvt_pk_bf16(o[0], o[1]); w.y = cvt_pk_bf16(o[2], o[3]); *(u32x2v*)(xb + off + bj * HALF + n * 16) = w; }
                        if (x8) *(unsigned*)(x8 + off + bj * HALF + n * 16) = (unsigned)__builtin_amdgcn_cvt_pk_fp8_f32(o[2], o[3], __builtin_amdgcn_cvt_pk_fp8_f32(o[0], o[1], 0, false), true);
                        s += (o[0] * o[0] + o[1] * o[1]) + (o[2] * o[2] + o[3] * o[3]);
                    }
                if (ssq) { s += __shfl_xor(s, 16); s += __shfl_xor(s, 32); if (fq == 0) atomicAdd(ssq + row, (unsigned long long)(s * SSQ_FX + 0.5f)); }
            }
            asm volatile("" ::: "memory");
        }
    }
};
struct EpiSplit {
    static constexpr bool PERM = true, AFTER_DRAIN = false;
    bf16_t* O; size_t seg_stride; const unsigned long long* ssq; float inv_d;
    __device__ __forceinline__ void operator()(const f32x4 (&acc)[2][2][4][2], const Unit& u, int wr, int wc, int fr, int fq) const {
        const int colt = u.pn * BM, seg = colt >> 9, cin = colt & 511;
        bf16_t* base = O + (size_t)seg * seg_stride;
        const int row0 = u.pm * BM + wr * 64 + fr, col0 = cin + wc * 32 + 8 * fq;
#pragma unroll
        for (int ai = 0; ai < 2; ++ai)
#pragma unroll
            for (int m = 0; m < 4; ++m) {
                const int row = row0 + ai * HALF + m * 16;
                const float rs = __builtin_amdgcn_rsqf((float)ssq[row] * inv_d + RMS_EPS_F);
#pragma unroll
                for (int bj = 0; bj < 2; ++bj) {
                    const f32x4 v0 = acc[ai][bj][m][0] * rs, v1 = acc[ai][bj][m][1] * rs;
                    u32x4 w; w.x = cvt_pk_bf16(v0[0], v0[1]); w.y = cvt_pk_bf16(v0[2], v0[3]); w.z = cvt_pk_bf16(v1[0], v1[1]); w.w = cvt_pk_bf16(v1[2], v1[3]);
                    *(u32x4*)(base + (size_t)row * 512 + col0 + bj * HALF) = w;
                }
            }
    }
};
template <class Epi, class Sched, bool ALIGN_EPI = false, bool SP2 = false, bool F8 = false, bool I8 = false>
__device__ __forceinline__ void gemm_phase(PG8_LAS unsigned char* lds, const Gemm g, const Sched& S, const Epi& E, int wid0) {
    unsigned z_ = 0u; asm volatile("" : "+v"(z_)); int tid_ = (wid0 << 6) | (int)__builtin_amdgcn_mbcnt_hi(~0u, __builtin_amdgcn_mbcnt_lo(~0u, z_)); asm volatile("" : "+v"(tid_));
    const int tid = tid_, wid = __builtin_amdgcn_readfirstlane(tid >> 6), lane = tid & 63, wr = wid >> 2, wc = wid & 3, fr = lane & 15, fq = lane >> 4;
    const int K = g.K, nt = K / BK;
    const int rot = g.rot; const size_t rotoff = (size_t)rot * (size_t)(BK * 2);
    unsigned voffA[2], voffB[2];
#pragma unroll
    for (int i = 0; i < 2; ++i) { int R, C; stage_rc(tid * 16 + i * 8192, R, C); const int Rb = Epi::PERM ? ((R & ~31) + perm32(R & 31)) : R;
        voffA[i] = (unsigned)(R * K + C) * 2u; voffB[i] = (unsigned)(Rb * K + C) * 2u; }
    const size_t kstep = (size_t)(BK * 2);
    const size_t hstep = (size_t)HALF * K * 2;
    const size_t tstep = 2 * hstep;
    const unsigned ldsw = (unsigned)wid * 1024u;
    const int aoff = lds_byte(wr * 64 + fr, fq * 8), boff = lds_byte(wc * 32 + fr, fq * 8);
#define PG8_SA(b, h) (((b) * 2 + (h)) * HTB)
#define PG8_SB(b, h) ((4 + (b) * 2 + (h)) * HTB)
#define PG8_STAGE(bufoff, gbase, voff) do { _Pragma("unroll") for (int _i = 0; _i < 2; ++_i) { \
        asm("" : "+v"((voff)[_i]));     \
        __builtin_amdgcn_global_load_lds((const unsigned*)((const char*)(gbase) + (voff)[_i]), (PG8_LAS unsigned*)(lds + (bufoff) + ldsw + _i * 8192), 16, 0, 0); } } while (0)
#define PG8_LDA(dst, b, h) do { _Pragma("unroll") for (int m = 0; m < 4; ++m) _Pragma("unroll") for (int k = 0; k < 2; ++k) dst[m][k] = *(const PG8_LAS bf16x8*)(lds + PG8_SA(b, h) + aoff + m * 2048 + k * 1024); } while (0)
#define PG8_LDB(dst, b, h) do { _Pragma("unroll") for (int n = 0; n < 2; ++n) _Pragma("unroll") for (int k = 0; k < 2; ++k) dst[n][k] = *(const PG8_LAS bf16x8*)(lds + PG8_SB(b, h) + boff + n * 2048 + k * 1024); } while (0)
#define PG8_MMA(ai, bj, At, Bt) do { __builtin_amdgcn_s_setprio(1); _Pragma("unroll") for (int m = 0; m < 4; ++m) _Pragma("unroll") for (int n = 0; n < 2; ++n) { \
        if constexpr (F8) mfma_f8(acc[ai][bj][m][n], cat8(Bt[n][0], Bt[n][1]), cat8(At[m][0], At[m][1])); \
        else if constexpr (I8) { _Pragma("unroll") for (int k = 0; k < 2; ++k) acc[ai][bj][m][n] = __builtin_bit_cast(f32x4, __builtin_amdgcn_mfma_i32_16x16x64_i8(__builtin_bit_cast(i32x4, Bt[n][k]), __builtin_bit_cast(i32x4, At[m][k]), __builtin_bit_cast(i32x4, acc[ai][bj][m][n]), 0, 0, 0)); } \
        else { _Pragma("unroll") for (int k = 0; k < 2; ++k) acc[ai][bj][m][n] = __builtin_amdgcn_mfma_f32_16x16x32_bf16(Bt[n][k], At[m][k], acc[ai][bj][m][n], 0, 0, 0); } } \
        __builtin_amdgcn_s_setprio(0); } while (0)
#define PG8_WAIT_V(n) asm volatile("s_waitcnt vmcnt(" #n ")" ::: "memory")
#define PG8_WAIT_L(n) asm volatile("s_waitcnt lgkmcnt(" #n ")" ::: "memory")
#define PG8_BAR __builtin_amdgcn_s_barrier()
#define PG8_SCHED __builtin_amdgcn_sched_barrier(0)
    Unit cur, nxt; int ui = 0;
    if (!S.next(0, cur)) return;
    f32x4 acc[2][2][4][2];
#pragma unroll
    for (int a = 0; a < 2; ++a)
#pragma unroll
        for (int b = 0; b < 2; ++b)
#pragma unroll
            for (int m = 0; m < 4; ++m)
#pragma unroll
                for (int n = 0; n < 2; ++n) acc[a][b][m][n] = (f32x4){0.f, 0.f, 0.f, 0.f};
    bf16x8 At[4][2], B0[2][2], B1[2][2];
    const char* cA = (const char*)g.A + (size_t)cur.pm * tstep; const char* cB = (const char*)g.Bt + (size_t)cur.pn * tstep;
    S.a_ready(cur);
    if constexpr (SP2) {
        PG8_STAGE(PG8_SB(0, 0), cB + rotoff, voffB); PG8_STAGE(PG8_SB(0, 1), cB + rotoff + hstep, voffB); PG8_STAGE(PG8_SA(0, 0), cA + rotoff, voffA); PG8_STAGE(PG8_SA(0, 1), cA + rotoff + hstep, voffA);
        if (wr == 1) PG8_BAR;
        PG8_WAIT_V(2); PG8_BAR;
        PG8_STAGE(PG8_SB(1, 0), cB + rotoff + kstep, voffB); PG8_STAGE(PG8_SA(1, 0), cA + rotoff + kstep, voffA); PG8_STAGE(PG8_SB(1, 1), cB + rotoff + hstep + kstep, voffB);
        PG8_WAIT_V(6); PG8_BAR;
    } else {
        PG8_STAGE(PG8_SB(0, 0), cB + rotoff, voffB); PG8_STAGE(PG8_SA(0, 0), cA + rotoff, voffA); PG8_STAGE(PG8_SB(0, 1), cB + rotoff + hstep, voffB); PG8_STAGE(PG8_SA(0, 1), cA + rotoff + hstep, voffA);
        if (wr == 1) PG8_BAR;
        PG8_WAIT_V(4); PG8_BAR;
        PG8_STAGE(PG8_SB(1, 0), cB + rotoff + kstep, voffB); PG8_STAGE(PG8_SA(1, 0), cA + rotoff + kstep, voffA); PG8_STAGE(PG8_SB(1, 1), cB + rotoff + hstep + kstep, voffB);
        PG8_WAIT_V(6); PG8_BAR;
    }
    for (;;) {
        const bool has_next = S.next(ui + 1, nxt);
        const char* nA = has_next ? (const char*)g.A + (size_t)nxt.pm * tstep : cA; const char* nB = has_next ? (const char*)g.Bt + (size_t)nxt.pn * tstep : cB;
        for (int t = 0; t < nt; t += 2) {
            const bool last = (t == nt - 2);
            int pt = t + rot; if (pt >= nt) pt -= nt; int pt2 = pt + 2; if (pt2 >= nt) pt2 -= nt;
            const char* a1 = cA + (size_t)(pt + 1) * kstep;
            const char* a2 = last ? nA + rotoff : cA + (size_t)pt2 * kstep; const char* b2 = last ? nB + rotoff : cB + (size_t)pt2 * kstep;
            const char* a3 = a2 + kstep; const char* b3 = b2 + kstep;
            if (last && has_next) S.a_ready(nxt);
            if constexpr (SP2) {
            PG8_LDB(B0, 0, 0); PG8_LDB(B1, 0, 1); PG8_SCHED; PG8_LDA(At, 0, 0); PG8_STAGE(PG8_SA(1, 1), a1 + hstep, voffA);
            PG8_WAIT_V(8); PG8_WAIT_L(0); PG8_BAR; PG8_MMA(0, 0, At, B0); PG8_MMA(0, 1, At, B1); PG8_BAR; PG8_SCHED;
            PG8_LDA(At, 0, 1); PG8_STAGE(PG8_SB(0, 0), b2, voffB); PG8_STAGE(PG8_SB(0, 1), b2 + hstep, voffB); PG8_STAGE(PG8_SA(0, 0), a2, voffA);
            PG8_WAIT_V(8); PG8_WAIT_L(0); PG8_BAR; PG8_MMA(1, 0, At, B0); PG8_MMA(1, 1, At, B1); PG8_BAR; PG8_SCHED;
            PG8_LDB(B0, 1, 0); PG8_LDB(B1, 1, 1); PG8_SCHED; PG8_LDA(At, 1, 0); PG8_STAGE(PG8_SA(0, 1), a2 + hstep, voffA);
            PG8_WAIT_V(8); PG8_WAIT_L(0); PG8_BAR; PG8_MMA(0, 0, At, B0); PG8_MMA(0, 1, At, B1); PG8_BAR; PG8_SCHED;
            PG8_LDA(At, 1, 1); PG8_STAGE(PG8_SB(1, 0), b3, voffB); PG8_STAGE(PG8_SB(1, 1), b3 + hstep, voffB); PG8_STAGE(PG8_SA(1, 0), a3, voffA);
            PG8_WAIT_V(8); PG8_WAIT_L(0); PG8_BAR; PG8_MMA(1, 0, At, B0); PG8_MMA(1, 1, At, B1); PG8_BAR; PG8_SCHED;
            } else {
            PG8_LDB(B0, 0, 0); PG8_SCHED; PG8_LDA(At, 0, 0); PG8_STAGE(PG8_SA(1, 1), a1 + hstep, voffA);
            PG8_WAIT_L(8); PG8_BAR; PG8_WAIT_L(0); PG8_MMA(0, 0, At, B0); PG8_BAR; PG8_SCHED;
            PG8_LDB(B1, 0, 1); PG8_STAGE(PG8_SB(0, 0), b2, voffB);
            PG8_BAR; PG8_WAIT_L(0); PG8_MMA(0, 1, At, B1); PG8_BAR;
            PG8_LDA(At, 0, 1); PG8_STAGE(PG8_SA(0, 0), a2, voffA);
            PG8_BAR; PG8_WAIT_L(0); PG8_MMA(1, 0, At, B0); PG8_BAR; PG8_SCHED;
            PG8_STAGE(PG8_SB(0, 1), b2 + hstep, voffB);
            PG8_WAIT_V(6); PG8_BAR; PG8_MMA(1, 1, At, B1); PG8_BAR;
            PG8_LDB(B0, 1, 0); PG8_SCHED; PG8_LDA(At, 1, 0); PG8_STAGE(PG8_SA(0, 1), a2 + hstep, voffA);
            PG8_WAIT_L(8); PG8_BAR; PG8_WAIT_L(0); PG8_MMA(0, 0, At, B0); PG8_BAR; PG8_SCHED;
            PG8_LDB(B1, 1, 1); PG8_STAGE(PG8_SB(1, 0), b3, voffB);
            PG8_BAR; PG8_WAIT_L(0); PG8_MMA(0, 1, At, B1); PG8_BAR;
            PG8_LDA(At, 1, 1); PG8_STAGE(PG8_SA(1, 0), a3, voffA);
            PG8_BAR; PG8_WAIT_L(0); PG8_MMA(1, 0, At, B0); PG8_BAR; PG8_SCHED;
            PG8_STAGE(PG8_SB(1, 1), b3 + hstep, voffB);
            PG8_WAIT_V(6); PG8_BAR; PG8_MMA(1, 1, At, B1); PG8_BAR;
            }
        }
        if constexpr (ALIGN_EPI) { if (wr == 0) PG8_BAR; }
        if constexpr (!Epi::AFTER_DRAIN) { E(acc, cur, wr, wc, fr, fq); S.done(cur); }
        if (!has_next) break;
#pragma unroll
        for (int a = 0; a < 2; ++a)
#pragma unroll
            for (int b = 0; b < 2; ++b)
#pragma unroll
                for (int m = 0; m < 4; ++m)
#pragma unroll
                    for (int n = 0; n < 2; ++n) acc[a][b][m][n] = (f32x4){0.f, 0.f, 0.f, 0.f};
        cur = nxt; cA = nA; cB = nB; ++ui;
        if constexpr (ALIGN_EPI) { if (wr == 1) PG8_BAR; }
    }
    PG8_WAIT_V(0);
    if constexpr (!ALIGN_EPI) { if (wr == 0) PG8_BAR; }
    PG8_BAR;
    if constexpr (Epi::AFTER_DRAIN) { E.fused(acc, cur, wr, wc, fr, fq, lds, wid, lane); S.done(cur); }
#undef PG8_SA
#undef PG8_SB
#undef PG8_STAGE
#undef PG8_LDA
#undef PG8_LDB
#undef PG8_MMA
#undef PG8_WAIT_V
#undef PG8_WAIT_L
#undef PG8_BAR
#undef PG8_SCHED
}
}
#define XB_TMO      128
#define XB_XCNT(j)  (256  + 64 * (j))
#define XB_XSUB(j)  (1280 + 64 * (j))
#define XB_XGEN(j)  (2304 + 64 * (j))
#define XB_TOP      3328
#define XB_TOPGEN   3392
#define XCD_BAR_WORDS 3456
#define XB_PTOP(q)  (3456 + 64 * (q))
#define XB_PGEN(q)  (3712 + 64 * (q))
#define XB_SPIN_CAP (1u << 18)

__device__ __forceinline__ unsigned xb_ld(unsigned* p)              { return __hip_atomic_load(p, __ATOMIC_RELAXED, __HIP_MEMORY_SCOPE_AGENT); }
__device__ __forceinline__ unsigned xb_add(unsigned* p, unsigned v) { return __hip_atomic_fetch_add(p, v, __ATOMIC_RELAXED, __HIP_MEMORY_SCOPE_AGENT); }
__device__ __forceinline__ unsigned xb_xcc_id() { return (unsigned)__builtin_amdgcn_s_getreg((3 << 11) | 20) & 0xFu; }
#define XB_SPIN(cond, bar) do { unsigned _sp = 0; while (cond) { __builtin_amdgcn_s_sleep(1); \
    if ((++_sp & 255u) == 0u) { if (xb_ld(&(bar)[XB_TMO])) break; if (_sp > XB_SPIN_CAP) { atomicAdd(&(bar)[XB_TMO], 1u); break; } } } } while (0)

struct XcdBarrier {
    unsigned* bar; unsigned x;
    volatile LAS unsigned* st;
    int wid;
};
__device__ __forceinline__ bool xb_thread0(const XcdBarrier& b) { unsigned z = 0u; asm volatile("" : "+v"(z)); return b.wid == 0 && __builtin_amdgcn_mbcnt_hi(~0u, __builtin_amdgcn_mbcnt_lo(~0u, z)) == 0u; }

__device__ __forceinline__ XcdBarrier xcd_barrier_post(unsigned* bar, volatile LAS unsigned* st) {
    XcdBarrier b; b.bar = bar; b.x = xb_xcc_id(); b.st = st;
    if (threadIdx.x == 0) st[5] = xb_add(&bar[XB_XCNT(b.x)], 1u);
    return b;
}
__device__ __forceinline__ void xcd_barrier_complete(unsigned* bar, unsigned x, unsigned& nloc, unsigned& nx, unsigned& reg) {
    const unsigned G = gridDim.x * gridDim.y * gridDim.z;
    unsigned sum, cnt, mine, sp = 0u;
    for (;;) {
        sum = 0u; cnt = 0u; mine = 0u; unsigned odd = 0u, below = 0u;
#pragma unroll
        for (unsigned j = 0; j < 16; ++j) { const unsigned c = xb_ld(&bar[XB_XCNT(j)]); sum += c; cnt += (c > 0u) ? 1u : 0u; mine = (j == x) ? c : mine; odd |= (c != 0u && c != 32u) ? 1u : 0u; below += (c > 0u && j < x) ? 1u : 0u; }
        reg = (sum == G && G == 256u && cnt == 8u && odd == 0u) ? 1u + below : 0u;
        if (sum == G) break;
        __builtin_amdgcn_s_sleep(1);
        if ((++sp & 255u) == 0u) { if (xb_ld(&bar[XB_TMO])) break; if (sp > XB_SPIN_CAP) { atomicAdd(&bar[XB_TMO], 1u); break; } }
    }
    nloc = mine > 0u ? mine : 1u; nx = cnt > 0u ? cnt : 1u; if (sum != G) reg = 0u;
}

__device__ __forceinline__ void xcd_barrier(const XcdBarrier& b, int mode = 0, unsigned pair = 0u) {
    const bool local = (mode == 1);
    asm volatile("s_waitcnt vmcnt(0)" ::: "memory");
    __syncthreads();
    if (xb_thread0(b)) {
        unsigned* bar = b.bar;
        __builtin_amdgcn_s_waitcnt(0);
        unsigned nloc = b.st[0], nx = b.st[1];
        if (nloc == 0u) { unsigned reg = 0u; xcd_barrier_complete(bar, b.x, nloc, nx, reg); b.st[0] = nloc; b.st[1] = nx; b.st[2] = reg; }
        const unsigned old = xb_add(&bar[XB_XSUB(b.x)], 1u);
        const unsigned gen = old / nloc;
        if (old + 1u == (gen + 1u) * nloc && local) {
            __builtin_amdgcn_fence(__ATOMIC_ACQUIRE, "agent");
            xb_add(&bar[XB_XGEN(b.x)], 1u);
            asm volatile("s_waitcnt vmcnt(0)" ::: "memory");
        } else if (old + 1u == (gen + 1u) * nloc) {
            __builtin_amdgcn_fence(__ATOMIC_RELEASE, "agent");
            asm volatile("s_waitcnt vmcnt(0)" ::: "memory");
            if (mode == 2) {
                const unsigned og = xb_add(&bar[XB_PTOP(pair)], 1u);
                const unsigned tg = og / 2u;
                if (og + 1u == (tg + 1u) * 2u) xb_add(&bar[XB_PGEN(pair)], 1u);
                else XB_SPIN(xb_ld(&bar[XB_PGEN(pair)]) == tg, bar);
            } else {
            const unsigned og = xb_add(&bar[XB_TOP], 1u);
            const unsigned tg = og / nx;
            if (og + 1u == (tg + 1u) * nx) xb_add(&bar[XB_TOPGEN], 1u);
            else XB_SPIN(xb_ld(&bar[XB_TOPGEN]) == tg, bar);
            }
            __builtin_amdgcn_fence(__ATOMIC_ACQUIRE, "agent");
            xb_add(&bar[XB_XGEN(b.x)], 1u);
            asm volatile("s_waitcnt vmcnt(0)" ::: "memory");
        } else {
            XB_SPIN(xb_ld(&bar[XB_XGEN(b.x)]) == gen, bar);
            __builtin_amdgcn_fence(__ATOMIC_ACQUIRE, "agent");
            asm volatile("s_waitcnt vmcnt(0)" ::: "memory");
        }
    }
    __syncthreads();
}

#ifndef PG8_SP2
#define PG8_SP2 true
#endif
#ifndef PG8_ALIGN
#define PG8_ALIGN true
#endif
#ifndef MK_SPLIT
#define MK_SPLIT 0
#endif

constexpr int DM = 2048, NBATCH = 4, SEQ = 4096, NLAYER = 2, M = NBATCH * SEQ, GW = 512, HD = 128, NH = 4, DFF = 5504, DIN = 6152, NP = 6144;
constexpr int NT = 512, NWAVES = 8;
constexpr float EPS = 1e-6f, KSCALE = 0.08838834764831845f;
constexpr int PH_PER_LAYER = 10, N_PHASES = 1 + NLAYER * PH_PER_LAYER;

constexpr size_t MiB = 1u << 20, KiB = 1024;
constexpr size_t WS_CTL = 0, CTL_ZERO_BYTES = 2 * MiB;
constexpr int CW_BAR = 4096, CW_Q = 8192;
constexpr size_t WS_SSQ = 1 * MiB;
constexpr size_t WS_G = 2 * MiB;
constexpr size_t WS_BLAST = 2560 * KiB, WS_MLOC = WS_BLAST + 4096, WS_MRUN = WS_MLOC + 4096;
constexpr size_t WS_DN = 3 * MiB, WS_NST = 3 * MiB + 512 * KiB;
constexpr size_t WS_LSE = 5 * MiB + 512 * KiB;
constexpr size_t WS_GW8 = 7 * MiB + 512 * KiB;
constexpr size_t WS_LRUW = 7 * MiB;
constexpr size_t WS_WGU1 = 8 * MiB, WS_WD1 = 52 * MiB, WS_WIN = 74 * MiB, WS_WOUT = 98 * MiB, WS_WGU2 = 106 * MiB, WS_WD2 = 149 * MiB;
constexpr size_t WS_XB = 171 * MiB;
constexpr size_t WS_PACT = 235 * MiB;
constexpr size_t WS_MIXED = 427 * MiB;
constexpr size_t WS_DCT = 491 * MiB;
constexpr size_t WS_CST = 555 * MiB;
constexpr size_t WS_CPART = 587 * MiB;
constexpr size_t WS_DOUT = 635 * MiB;
constexpr size_t WS_LAP = 651 * MiB, WS_LHE = 653 * MiB, WS_LCI = 655 * MiB;
constexpr size_t WS_LA = 657 * MiB, WS_LU = 689 * MiB;
constexpr size_t WS_END = 721 * MiB;
constexpr size_t WS_X8 = WS_DCT;
constexpr size_t WS_ROWSC = 4 * MiB, WS_COLSC1 = 4 * MiB + 128 * KiB, WS_COLSC2 = 4 * MiB + 192 * KiB;
static_assert(WS_WGU1 + (size_t)2 * DFF * DM * 2 <= WS_WD1 && WS_WD1 + (size_t)DM * DFF * 2 <= WS_WIN && WS_WIN + (size_t)NP * DM * 2 <= WS_WOUT && WS_WOUT + (size_t)DM * DM * 2 <= WS_WGU2 &&
              WS_WGU2 + (size_t)2 * DFF * DM * 2 <= WS_WD2 && WS_WD2 + (size_t)DM * DFF * 2 <= WS_XB && WS_PACT + (size_t)M * DFF * 2 <= WS_MIXED && WS_PACT + (size_t)12 * M * 512 * 2 <= WS_MIXED, "ws map");
constexpr size_t SEG_STRIDE = (size_t)M * 512;
enum { SEG_LX = 0, SEG_LG, SEG_MQ, SEG_MK, SEG_MV, SEG_MO, SEG_CQ, SEG_CK, SEG_CV, SEG_SQ, SEG_SK, SEG_SV };

constexpr int LDS_MISC_OFF = 152 * 1024, LDS_BYTES = LDS_MISC_OFF + 64;

typedef unsigned short bf16;
typedef short bf16x8 __attribute__((ext_vector_type(8)));
typedef float f32x4 __attribute__((ext_vector_type(4)));
typedef unsigned v4u __attribute__((ext_vector_type(4)));
typedef unsigned v2u __attribute__((ext_vector_type(2)));
typedef float f32x2 __attribute__((ext_vector_type(2)));
__device__ __forceinline__ int opaque_tid_w(int wid) { unsigned z = 0u; asm volatile("" : "+v"(z)); int t = (wid << 6) | (int)__builtin_amdgcn_mbcnt_hi(~0u, __builtin_amdgcn_mbcnt_lo(~0u, z)); asm volatile("" : "+v"(t)); return t; }
#define opaque_tid() opaque_tid_w(p.wid)
#define LDS_WAIT() asm volatile("s_waitcnt lgkmcnt(0)" ::: "memory")
typedef __bf16 bf16x2_hw __attribute__((ext_vector_type(2)));
__device__ __forceinline__ unsigned pk2(float lo, float hi) { const f32x2 v = {lo, hi}; return __builtin_bit_cast(unsigned, __builtin_convertvector(v, bf16x2_hw)); }
__device__ __forceinline__ unsigned f2bf(float f) { return pk2(f, 0.f) & 0xffffu; }
__device__ __forceinline__ float bf2f(unsigned b) { return __builtin_bit_cast(float, b << 16); }
__device__ __forceinline__ float bflo(unsigned w) { return __builtin_bit_cast(float, w << 16); }
__device__ __forceinline__ float bfhi(unsigned w) { return __builtin_bit_cast(float, w & 0xffff0000u); }
__device__ __forceinline__ float wave_sum(float v) {
#pragma unroll
    for (int o = 1; o < 64; o <<= 1) v += __shfl_xor(v, o);
    return v;
}
__device__ __forceinline__ float wave_max(float v) {
#pragma unroll
    for (int o = 1; o < 64; o <<= 1) v = fmaxf(v, __shfl_xor(v, o));
    return v;
}
__device__ __forceinline__ float softplusf(float x) { return fmaxf(x, 0.f) + __logf(1.0f + __expf(-fabsf(x))); }
__device__ __forceinline__ float sigmoidf(float x) { return __builtin_amdgcn_rcpf(1.0f + __expf(-x)); }
__device__ __forceinline__ float gelu_tanh(float x) { const float y = 0.7978845608028654f * (x + 0.044715f * x * x * x); const float t = 1.0f - 2.0f * __builtin_amdgcn_rcpf(1.0f + __expf(2.0f * y)); return 0.5f * x * (1.0f + t); }
__device__ __forceinline__ float one_minus_expneg(float x) { const float pl = x * (1.0f + x * (-0.5f + x * (0.16666667f + x * (-0.041666668f + x * 0.0083333338f)))); return x < 0.25f ? pl : 1.0f - __expf(-x); }
template <int K> __device__ __forceinline__ void mma_lds(f32x4& acc, const LAS bf16* X, int ldx, const LAS bf16* Y, int ldy, int lane) {
    const LAS bf16* xp = X + (lane & 15) * ldx + (lane >> 4) * 8;
    const LAS bf16* yp = Y + (lane & 15) * ldy + (lane >> 4) * 8;
#pragma unroll
    for (int k = 0; k < K; k += 32) {
        const bf16x8 a = *(const LAS bf16x8*)(xp + k), b = *(const LAS bf16x8*)(yp + k);
        acc = __builtin_amdgcn_mfma_f32_16x16x32_bf16(a, b, acc, 0, 0, 0);
    }
}

typedef short v4i16_t __attribute__((ext_vector_type(4)));
__device__ __forceinline__ bf16x8 tr_frag(const LAS bf16* T, int ks, int c, int lane) {
    const LAS bf16* a0 = T + (32 * ks + 8 * (lane >> 4) + ((lane & 15) >> 2)) * 144 + 16 * c + 4 * (lane & 3);
    const v4i16_t lo = __builtin_amdgcn_ds_read_tr16_b64_v4i16((LAS v4i16_t*)a0), hi = __builtin_amdgcn_ds_read_tr16_b64_v4i16((LAS v4i16_t*)(a0 + 4 * 144));
    return (bf16x8){lo[0], lo[1], lo[2], lo[3], hi[0], hi[1], hi[2], hi[3]};
}

__device__ __forceinline__ void touch_line(const void* ptr) { const unsigned v = *(const volatile unsigned*)ptr; asm volatile("" :: "v"(v)); }
struct Params { const float* in[24]; float* out; unsigned char* ws; int ph_lo, ph_hi; };
typedef __attribute__((address_space(4))) const unsigned char* kptr_t;
template <typename T> __device__ __forceinline__ T karg(kptr_t k, int off) { return *(const __attribute__((address_space(4))) T*)(k + off); }
struct Ctx { kptr_t k; unsigned char* ws; float* out; int wid;
    __device__ __forceinline__ const float* in(int i) const { return karg<const float*>(k, 8 * i); } };
__device__ __forceinline__ Ctx make_ctx(int wid) { Ctx c; c.wid = wid; kptr_t k = (kptr_t)__builtin_amdgcn_kernarg_segment_ptr(); asm volatile("" : "+s"(k)); c.k = k; c.ws = karg<unsigned char*>(k, 200); c.out = karg<float*>(k, 192); return c; }
static_assert(sizeof(Params) == 216, "kernarg layout");

__device__ __forceinline__ int q_next(const Ctx& p, unsigned* ctr, volatile LAS int* slot) {
    __syncthreads();
    if (opaque_tid() == 0) *slot = (int)__hip_atomic_fetch_add(ctr, 1u, __ATOMIC_RELAXED, __HIP_MEMORY_SCOPE_AGENT);
    __syncthreads();
    return *slot;
}
struct TItem { const float* src; const float* gain; bf16* dst; int ldw, K_dst, f8; };
__device__ __forceinline__ TItem titem(const float* W, int ldw, int K_dst, bf16* WT, int dst_row0, int src_col0, int k0, const float* gain, int lane) {
    const int c = lane >> 3, n4 = lane & 7; TItem t;
    t.src = W + (size_t)(k0 + 16 * c) * ldw + src_col0 + 4 * n4; t.gain = gain ? gain + k0 + 16 * c : nullptr; t.dst = WT + (size_t)(dst_row0 + 4 * n4) * K_dst + k0 + 16 * c; t.ldw = ldw; t.K_dst = K_dst; t.f8 = 0; return t;
}
__device__ __forceinline__ TItem decode_item(const Ctx& p, int l, int it, int lane) {
    constexpr int I_D = 43 * 64, I_IN = 16 * 192, I_OUT = 16 * 64;
    unsigned char* ws = p.ws; int r = it;
    if (r < 2 * I_D) {
        const int f = r >= I_D; r -= f * I_D; const int kb = r / 64, nb = r % 64;
        if (!pg8::ffn_f8(l, f)) return titem(p.in(f ? 23 : 4) + (size_t)l * DFF * DM, DM, DFF, (bf16*)(ws + (f ? WS_WD2 : WS_WD1)), 32 * nb, 32 * nb, 128 * kb, nullptr, lane);
        TItem t = titem(p.in(f ? 23 : 4) + (size_t)l * DFF * DM, DM, 0, nullptr, 0, 32 * nb, 128 * kb, nullptr, lane);
        t.dst = (bf16*)(ws + (f ? WS_WD2 : WS_WD1) + (size_t)(32 * nb + 4 * (lane & 7)) * pg8::DFF_P + 128 * kb + 16 * (lane >> 3)); t.K_dst = pg8::DFF_P; t.f8 = 1; return t; }
    r -= 2 * I_D;
    if (r < I_IN) {
        const int kb = r / 192, nb = r % 192, d0 = 32 * nb;
        return titem(p.in(6) + (size_t)l * DM * DIN, DIN, DM, (bf16*)(ws + WS_WIN), d0, d0 + (d0 >= 3072 ? 8 : 0), 128 * kb, p.in(5) + l * DM, lane); }
    r -= I_IN;
    if (r < I_OUT) { const int kb = r / 64, nb = r % 64;
        return titem(p.in(19) + (size_t)l * DM * DM, DM, DM, (bf16*)(ws + WS_WOUT), 32 * nb, 32 * nb, 128 * kb, nullptr, lane); }
    r -= I_OUT;
    const int mat = r >> 4, n = (r >> 2) & 3, nb = r & 3;
    return titem(p.in(mat ? 11 : 9) + (size_t)l * 65536 + n * 16384, 128, 128, (bf16*)(ws + WS_LRUW) + (mat * 4 + n) * 16384, 32 * nb, 32 * nb, 0, nullptr, lane);
}
__device__ __forceinline__ unsigned pack_i8x4(float a, float b, float c, float d) {
    return ((unsigned)(int)__builtin_rintf(a) & 255u) | (((unsigned)(int)__builtin_rintf(b) & 255u) << 8) | (((unsigned)(int)__builtin_rintf(c) & 255u) << 16) | ((unsigned)(int)__builtin_rintf(d) << 24);
}
__device__ __forceinline__ void convert_gu_i8(const Ctx& p, int l, LAS unsigned char* lds) {
    const int tid = opaque_tid(), lane = tid & 63, w = tid >> 6, c = lane >> 3, n4 = lane & 7;
    LAS float* MX = (LAS float*)lds;
    for (int it = (int)blockIdx.x; it < 2 * 344; it += (int)gridDim.x) {
        const int f = it >= 344, nb = it - f * 344, pn = nb >> 3, jj = nb & 7;
        const float* src = p.in((f ? 21 : 2) + (jj >> 2)) + (size_t)l * DM * DFF + (size_t)(256 * w + 16 * c) * DFF + 128 * pn + 32 * (jj & 3) + 4 * n4;
        const float* gain = p.in(f ? 20 : 1) + l * DM + 256 * w + 16 * c;
        f32x4 v[2][16];
#pragma unroll
        for (int s2 = 0; s2 < 2; ++s2)
#pragma unroll
            for (int e = 0; e < 16; ++e) v[s2][e] = __builtin_nontemporal_load((const f32x4*)(src + (size_t)(128 * s2 + e) * DFF));
        f32x4 m = {0.f, 0.f, 0.f, 0.f};
#pragma unroll
        for (int s2 = 0; s2 < 2; ++s2)
#pragma unroll
            for (int q = 0; q < 4; ++q) { const f32x4 g = *(const f32x4*)(gain + 128 * s2 + 4 * q);
#pragma unroll
                for (int e = 0; e < 4; ++e) { v[s2][4 * q + e] = v[s2][4 * q + e] * g[e];
#pragma unroll
                    for (int j = 0; j < 4; ++j) m[j] = fmaxf(m[j], fabsf(v[s2][4 * q + e][j])); } }
#pragma unroll
        for (int j = 0; j < 4; ++j) { m[j] = fmaxf(m[j], __shfl_xor(m[j], 8)); m[j] = fmaxf(m[j], __shfl_xor(m[j], 16)); m[j] = fmaxf(m[j], __shfl_xor(m[j], 32)); }
        if (c == 0) *(LAS f32x4*)(MX + w * 32 + 4 * n4) = m;
        __syncthreads();
        f32x4 mm = *(const LAS f32x4*)(MX + 4 * n4);
#pragma unroll
        for (int ww = 1; ww < 8; ++ww) { const f32x4 o = *(const LAS f32x4*)(MX + ww * 32 + 4 * n4);
#pragma unroll
            for (int j = 0; j < 4; ++j) mm[j] = fmaxf(mm[j], o[j]); }
        __syncthreads();
        unsigned char* dst = p.ws + (f ? WS_WGU2 : WS_WGU1) + (size_t)(32 * nb + 4 * n4) * DM + 256 * w + 16 * c;
#pragma unroll
        for (int j = 0; j < 4; ++j) { mm[j] = fmaxf(mm[j], 1e-30f); const float inv = 127.0f / mm[j];
#pragma unroll
            for (int s2 = 0; s2 < 2; ++s2) { v4u o;
#pragma unroll
                for (int q = 0; q < 4; ++q) o[q] = pack_i8x4(v[s2][4 * q][j] * inv, v[s2][4 * q + 1][j] * inv, v[s2][4 * q + 2][j] * inv, v[s2][4 * q + 3][j] * inv);
                *(v4u*)(dst + (size_t)j * DM + 128 * s2) = o; } }
        if (w == 0 && c == 0) *(f32x4*)((float*)(p.ws + (f ? WS_COLSC2 : WS_COLSC1)) + 32 * nb + 4 * n4) = mm * (1.0f / 127.0f);
    }
}
__device__ __forceinline__ void convert_layer(const Ctx& p, int l, int part) {
    const int tid = opaque_tid(), lane = tid & 63, w = tid >> 6;
    const int gw = blockIdx.x * NWAVES + w, NGW = gridDim.x * NWAVES;
    constexpr int NITEMS_ALL = 2 * 43 * 64 + 16 * 192 + 16 * 64 + 32, THIRD = (NITEMS_ALL + 2) / 3;
    const int it0 = part < 0 ? 0 : part * THIRD, NITEMS = part < 0 ? NITEMS_ALL : (it0 + THIRD < NITEMS_ALL ? it0 + THIRD : NITEMS_ALL);
    for (int it = it0 + gw; it < NITEMS; it += NGW) {
        const TItem t = decode_item(p, l, it, lane);
        f32x4 v[16];
#pragma unroll
        for (int e = 0; e < 16; ++e) v[e] = __builtin_nontemporal_load((const f32x4*)(t.src + (size_t)e * t.ldw));
        if (t.gain) {
#pragma unroll
            for (int q = 0; q < 4; ++q) { const f32x4 g = *(const f32x4*)(t.gain + 4 * q);
#pragma unroll
                for (int e = 0; e < 4; ++e) v[4 * q + e] = v[4 * q + e] * g[e]; } }
        if (t.f8) {
#pragma unroll
            for (int j = 0; j < 4; ++j) { v4u o;
#pragma unroll
                for (int q = 0; q < 4; ++q) o[q] = (unsigned)__builtin_amdgcn_cvt_pk_fp8_f32(v[4 * q + 2][j] * pg8::F8_W_SCALE, v[4 * q + 3][j] * pg8::F8_W_SCALE, __builtin_amdgcn_cvt_pk_fp8_f32(v[4 * q][j] * pg8::F8_W_SCALE, v[4 * q + 1][j] * pg8::F8_W_SCALE, 0, false), true);
                *(v4u*)((unsigned char*)t.dst + (size_t)j * t.K_dst) = o; }
            continue;
        }
#pragma unroll
        for (int j = 0; j < 4; ++j) {
            v4u o0, o1; o0.x = pk2(v[0][j], v[1][j]); o0.y = pk2(v[2][j], v[3][j]); o0.z = pk2(v[4][j], v[5][j]); o0.w = pk2(v[6][j], v[7][j]);
            o1.x = pk2(v[8][j], v[9][j]); o1.y = pk2(v[10][j], v[11][j]); o1.z = pk2(v[12][j], v[13][j]); o1.w = pk2(v[14][j], v[15][j]);
            *(v4u*)(t.dst + (size_t)j * t.K_dst) = o0; *(v4u*)(t.dst + (size_t)j * t.K_dst + 8) = o1;
        }
    }
    if (part <= 0) {
        for (int i = (int)blockIdx.x * NT + tid; i < 2 * DM * 8; i += (int)gridDim.x * NT)
            if (pg8::ffn_f8(l, i >> 14)) *(v4u*)(p.ws + ((i >> 14) ? WS_WD2 : WS_WD1) + (size_t)((i >> 3) & (DM - 1)) * pg8::DFF_P + DFF + 16 * (i & 7)) = (v4u){0u, 0u, 0u, 0u};
    }
    if (part <= 0) {
        const float* win = p.in(6) + (size_t)l * DM * DIN; const float* gain = p.in(5) + l * DM; bf16* g8 = (bf16*)(p.ws + WS_GW8);
        for (int k = (int)blockIdx.x * NT + tid; k < DM; k += (int)gridDim.x * NT) {
            const f32x4 w0 = *(const f32x4*)(win + (size_t)k * DIN + 3072), w1 = *(const f32x4*)(win + (size_t)k * DIN + 3076); const float g = gain[k];
#pragma unroll
            for (int c = 0; c < 4; ++c) { g8[c * DM + k] = (bf16)f2bf(w0[c] * g); g8[(c + 4) * DM + k] = (bf16)f2bf(w1[c] * g); }
        }
    }
}
__device__ __forceinline__ void prologue_x(const Ctx& p) {
    const int tid = opaque_tid(), lane = tid & 63, w = tid >> 6;
    const int gw = blockIdx.x * NWAVES + w, NGW = gridDim.x * NWAVES;
    bf16* xb = (bf16*)(p.ws + WS_XB); unsigned long long* ssq = (unsigned long long*)(p.ws + WS_SSQ); float* rowsc = (float*)(p.ws + WS_ROWSC);
    for (int m = gw; m < M; m += NGW) {
        const f32x4* xr = (const f32x4*)(p.in(0) + (size_t)m * DM) + lane; float s = 0.f, mx = 0.f;
        v2u* o8 = (v2u*)(xb + (size_t)m * DM) + lane;
        f32x4 v[8];
#pragma unroll
        for (int j = 0; j < 8; ++j) v[j] = xr[64 * j];
#pragma unroll
        for (int j = 0; j < 8; ++j) { s += (v[j][0] * v[j][0] + v[j][1] * v[j][1]) + (v[j][2] * v[j][2] + v[j][3] * v[j][3]); v2u o; o.x = pk2(v[j][0], v[j][1]); o.y = pk2(v[j][2], v[j][3]); o8[64 * j] = o;
            mx = fmaxf(mx, fmaxf(fmaxf(fabsf(v[j][0]), fabsf(v[j][1])), fmaxf(fabsf(v[j][2]), fabsf(v[j][3])))); }
        s = wave_sum(s); mx = fmaxf(wave_max(mx), 1e-30f);
        const float inv = 127.0f / mx;
        unsigned* q8 = (unsigned*)(p.ws + WS_X8 + (size_t)m * DM) + lane;
#pragma unroll
        for (int j = 0; j < 8; ++j) q8[64 * j] = pack_i8x4(v[j][0] * inv, v[j][1] * inv, v[j][2] * inv, v[j][3] * inv);
        if (lane == 0) { ssq[m] = (unsigned long long)(s * pg8::SSQ_FX + 0.5f); rowsc[m] = mx * (1.0f / 127.0f); }
    }
}
__device__ __forceinline__ void quant_rows_i8(const Ctx& p, const bf16* src, int nrows, unsigned char* dst, float* scale, int vb = -1) {
    const int tid = opaque_tid(), lane = tid & 63, w = tid >> 6;
    const int gw = blockIdx.x * NWAVES + w, NGW = gridDim.x * NWAVES;
    const int first = vb < 0 ? 2 * gw : 2048 * (vb & 7) + 2 * (NWAVES * (vb >> 3) + w), step = vb < 0 ? 2 * NGW : 512, end = vb < 0 ? nrows : 2048 * (vb & 7) + 2048;
    for (int r0 = first; r0 < end; r0 += step) {
        v4u v[2][4];
#pragma unroll
        for (int rr = 0; rr < 2; ++rr) { const v4u* sp = (const v4u*)(src + (size_t)(r0 + rr) * DM) + lane;
#pragma unroll
            for (int j = 0; j < 4; ++j) v[rr][j] = sp[64 * j]; }
#pragma unroll
        for (int rr = 0; rr < 2; ++rr) {
            float mx = 0.f;
#pragma unroll
            for (int j = 0; j < 4; ++j)
#pragma unroll
                for (int e = 0; e < 4; ++e) mx = fmaxf(mx, fmaxf(fabsf(bflo(v[rr][j][e])), fabsf(bfhi(v[rr][j][e]))));
            mx = fmaxf(wave_max(mx), 1e-30f);
            const float inv = 127.0f / mx;
            v2u* dp = (v2u*)(dst + (size_t)(r0 + rr) * DM) + lane;
#pragma unroll
            for (int j = 0; j < 4; ++j) { v2u o;
#pragma unroll
                for (int h2 = 0; h2 < 2; ++h2) { const unsigned w0 = v[rr][j][2 * h2], w1 = v[rr][j][2 * h2 + 1];
                    o[h2] = ((unsigned)(int)__builtin_rintf(bflo(w0) * inv) & 255u) | (((unsigned)(int)__builtin_rintf(bfhi(w0) * inv) & 255u) << 8) | (((unsigned)(int)__builtin_rintf(bflo(w1) * inv) & 255u) << 16) | ((unsigned)(int)__builtin_rintf(bfhi(w1) * inv) << 24); }
                dp[64 * j] = o; }
            if (lane == 0) scale[r0 + rr] = mx * (1.0f / 127.0f);
        }
    }
}
__device__ __forceinline__ void gates_phase(const Ctx& p, int l, const unsigned long long* ssq, LAS unsigned char* lds, int vb) {
    const int tid = opaque_tid(), lane = tid & 63, w = tid >> 6, fr = lane & 15, fq = lane >> 4, tile = w & 3, kh = w >> 2;
    const bf16* xb = (const bf16*)(p.ws + WS_XB); const bf16* g8 = (const bf16*)(p.ws + WS_GW8); float* G = (float*)(p.ws + WS_G);
    LAS f32x4* XCH = (LAS f32x4*)lds;
    for (int rb = (vb & 7) * 32 + (vb >> 3); rb < M / 64; rb += M / 64) {
        const int row = rb * 64 + tile * 16 + fr;
        const bf16* xp = xb + (size_t)row * DM + kh * 1024 + 8 * fq; const bf16* wp = g8 + (size_t)(fr & 7) * DM + kh * 1024 + 8 * fq;
        f32x4 acc = {0.f, 0.f, 0.f, 0.f};
#pragma unroll
        for (int b0 = 0; b0 < 32; b0 += 8) {
            bf16x8 xf[8], wf[8];
#pragma unroll
            for (int i = 0; i < 8; ++i) { xf[i] = *(const bf16x8*)(xp + 32 * (b0 + i)); wf[i] = *(const bf16x8*)(wp + 32 * (b0 + i)); }
#pragma unroll
            for (int i = 0; i < 8; ++i) { const bf16x8 wz = fr < 8 ? wf[i] : (bf16x8){0, 0, 0, 0, 0, 0, 0, 0}; acc = __builtin_amdgcn_mfma_f32_16x16x32_bf16(wz, xf[i], acc, 0, 0, 0); }
        }
        __syncthreads();
        if (kh == 1) XCH[tile * 64 + lane] = acc;
        __syncthreads();
        if (kh == 0 && fq < 2) {
            const f32x4 o = (acc + XCH[tile * 64 + lane]) * __builtin_amdgcn_rsqf((float)ssq[row] * (1.0f / (DM * pg8::SSQ_FX)) + EPS);
            *(f32x4*)(G + (size_t)row * 8 + 4 * fq) = o;
        }
    }
    __syncthreads();
}

constexpr int LRU_T = 16, LRU_NC = SEQ / LRU_T;
struct LruC { f32x2 w0, w1, w2, w3, cbv; float bav[4], bxv[4], spl[4], ga[8]; };
__device__ __forceinline__ void lru_cload(const Ctx& p, int l, int tid, LruC& C) {
    const int lane = tid & 63, w = tid >> 6, fr = lane & 15, ch = 2 * (tid & 255), n = w >> 1;
    const float* cw = p.in(7) + l * 4 * GW + ch; const float* cb = p.in(8) + l * GW + ch;
    C.w0 = *(const f32x2*)cw; C.w1 = *(const f32x2*)(cw + GW); C.w2 = *(const f32x2*)(cw + 2 * GW); C.w3 = *(const f32x2*)(cw + 3 * GW); C.cbv = *(const f32x2*)cb;
    const float* ba = p.in(10) + l * GW; const float* bx = p.in(12) + l * GW; const float* lam = p.in(13) + l * GW; const float* ga = p.in(18) + l * DM;
#pragma unroll
    for (int ds = 0; ds < 4; ++ds) { const int dg = n * 128 + 16 * (4 * (w & 1) + ds) + fr; C.bav[ds] = ba[dg]; C.bxv[ds] = bx[dg]; C.spl[ds] = 8.0f * softplusf(-lam[dg]); }
#pragma unroll
    for (int e = 0; e < 8; ++e) C.ga[e] = ga[lane * 8 + e];
}
template <int PASS> __device__ __forceinline__ void lru_ld(const Ctx& p, int u, int tid, unsigned (&xv)[11], float& lci) {
    const int b = u >> 8, c = u & 255, row0 = b * SEQ + c * 16, ch = 2 * (tid & 255), th = tid >> 8;
    lci = (PASS == 3) ? ((const float*)(p.ws + WS_LCI))[(size_t)u * GW + tid] : 0.f;
    const bf16* xp = (const bf16*)(p.ws + WS_PACT) + SEG_LX * SEG_STRIDE + (size_t)(row0 + 8 * th - 3) * GW + ch;
#pragma unroll
    for (int i = 0; i < 11; ++i) xv[i] = (c * 16 + 8 * th - 3 + i >= 0) ? *(const unsigned*)(xp + (size_t)i * GW) : 0u;
}
template <int PASS>
__device__ __forceinline__ void lru_unit(const Ctx& p, int l, int u, int un, unsigned (&xv)[11], float& lci, const LruC& C, LAS unsigned char* lds) {
    const int tid = opaque_tid(), lane = tid & 63, w = tid >> 6, fr = lane & 15, fq = lane >> 4;
    const int b = u >> 8, c = u & 255, row0 = b * SEQ + c * LRU_T;
    LAS float* XC = (LAS float*)lds;
    LAS float* AA = (LAS float*)(lds + 32768);
    LAS bf16* XCB = (LAS bf16*)(lds + 65536);
    LAS bf16* Y = (LAS bf16*)(lds + 82176);
    const bf16* xr = (const bf16*)(p.ws + WS_PACT) + SEG_LX * SEG_STRIDE;
    const bf16* gt = (const bf16*)(p.ws + WS_PACT) + SEG_LG * SEG_STRIDE;
    bf16x8 wa[4][4], wx[4][4];
    {
        const bf16* WaT = (const bf16*)(p.ws + WS_LRUW); const bf16* WxT = WaT + 4 * 16384; const int n = w >> 1;
#pragma unroll
        for (int ds = 0; ds < 4; ++ds) {
            const size_t ro = (size_t)(n * 128 + 16 * (4 * (w & 1) + ds) + fr) * 128 + 8 * fq;
#pragma unroll
            for (int k = 0; k < 4; ++k) { wa[ds][k] = *(const bf16x8*)(WaT + ro + 32 * k); wx[ds][k] = *(const bf16x8*)(WxT + ro + 32 * k); }
        }
        asm volatile("" ::: "memory");
    }
    float gate_v[16];
    if (PASS == 3) {
#pragma unroll
        for (int t = 0; t < 16; ++t) gate_v[t] = bf2f(gt[(size_t)(row0 + t) * GW + tid]);
    }
    float lci_keep;
    {
        const int ch = 2 * (tid & 255), th = tid >> 8;
        const f32x2 w0 = C.w0, w1 = C.w1, w2 = C.w2, w3 = C.w3, cbv = C.cbv;
        const float lci_cur = lci;
#pragma unroll
        for (int i = 0; i < 8; ++i) {
            const int t = 8 * th + i;
            const float xa = w0.x * bflo(xv[i]) + w1.x * bflo(xv[i + 1]) + w2.x * bflo(xv[i + 2]) + w3.x * bflo(xv[i + 3]) + cbv.x;
            const float xbv = w0.y * bfhi(xv[i]) + w1.y * bfhi(xv[i + 1]) + w2.y * bfhi(xv[i + 2]) + w3.y * bfhi(xv[i + 3]) + cbv.y;
            *(LAS f32x2*)(XC + t * 512 + ch) = (f32x2){xa, xbv}; *(LAS unsigned*)(XCB + t * 520 + ch) = pk2(xa, xbv);
        }
        lru_ld<PASS>(p, un < NBATCH * LRU_NC ? un : u, tid, xv, lci);
        lci_keep = lci_cur;
    }
    __syncthreads();
    {
        const int n = w >> 1;
        const LAS bf16* xp = XCB + fr * 520 + n * 128 + 8 * fq;
        bf16x8 af[4];
#pragma unroll
        for (int k = 0; k < 4; ++k) af[k] = *(const LAS bf16x8*)(xp + 32 * k);
#pragma unroll
        for (int ds = 0; ds < 4; ++ds) {
            const int d0 = 16 * (4 * (w & 1) + ds);
            f32x4 za = {0.f, 0.f, 0.f, 0.f}, zx = {0.f, 0.f, 0.f, 0.f};
#pragma unroll
            for (int k = 0; k < 4; ++k) { za = __builtin_amdgcn_mfma_f32_16x16x32_bf16(af[k], wa[ds][k], za, 0, 0, 0); zx = __builtin_amdgcn_mfma_f32_16x16x32_bf16(af[k], wx[ds][k], zx, 0, 0, 0); }
            const int dg = n * 128 + d0 + fr; const float bav = C.bav[ds], bxv = C.bxv[ds], spl = C.spl[ds];
#pragma unroll
            for (int j = 0; j < 4; ++j) {
                const int t = 4 * fq + j;
                const float r = sigmoidf(za[j] + bav), ii = sigmoidf(zx[j] + bxv), loga = -spl * r, a = __expf(loga), mult = __builtin_amdgcn_sqrtf(one_minus_expneg(-2.0f * loga));
                const float xc = XC[t * 512 + dg]; AA[t * 512 + dg] = a; XC[t * 512 + dg] = mult * ii * xc;
            }
        }
    }
    __syncthreads();
    {
        const int dg = tid; const size_t ci = (size_t)(b * LRU_NC + c) * GW + dg;
        float h = (PASS == 3) ? lci_keep : 0.f, ap = 1.f;
#pragma unroll
        for (int t = 0; t < 16; ++t) { const float a = AA[t * 512 + dg], uu = XC[t * 512 + dg]; h = a * h + uu; ap *= a; if (PASS == 3) Y[t * 520 + dg] = (bf16)f2bf(h * gelu_tanh(gate_v[t]));
            if (PASS == 1) { ((float*)(p.ws + WS_LA))[(size_t)(row0 + t) * GW + dg] = a; ((float*)(p.ws + WS_LU))[(size_t)(row0 + t) * GW + dg] = uu; } }
        if (PASS == 1) { ((float*)(p.ws + WS_LAP))[ci] = ap; ((float*)(p.ws + WS_LHE))[ci] = h; }
    }
    if (PASS == 3) {
        __syncthreads();
        bf16* mixed = (bf16*)(p.ws + WS_MIXED);
        float gv[8];
#pragma unroll
        for (int e = 0; e < 8; ++e) gv[e] = C.ga[e];
#pragma unroll
        for (int tt = 0; tt < 2; ++tt) {
            const int t = w * 2 + tt; const v4u v = *(const LAS v4u*)(Y + t * 520 + lane * 8);
            float f[8] = {bflo(v.x), bfhi(v.x), bflo(v.y), bfhi(v.y), bflo(v.z), bfhi(v.z), bflo(v.w), bfhi(v.w)}; float ss = 0.f;
#pragma unroll
            for (int e = 0; e < 8; ++e) ss += f[e] * f[e];
            ss = wave_sum(ss); const float rs = __builtin_amdgcn_rsqf(ss * (1.0f / GW) + EPS);
            v4u o; o.x = pk2(f[0] * rs * gv[0], f[1] * rs * gv[1]); o.y = pk2(f[2] * rs * gv[2], f[3] * rs * gv[3]); o.z = pk2(f[4] * rs * gv[4], f[5] * rs * gv[5]); o.w = pk2(f[6] * rs * gv[6], f[7] * rs * gv[7]);
            *(v4u*)(mixed + (size_t)(row0 + t) * DM + lane * 8) = o;
        }
    }
}
__device__ __forceinline__ void lru3_ld(const Ctx& p, int u, int tid, float (&pa)[16], float (&pu)[16], float (&pg)[16], float& lci) {
    const int row0 = (u >> 8) * SEQ + (u & 255) * LRU_T;
    const float* AG = (const float*)(p.ws + WS_LA) + (size_t)row0 * GW + tid; const float* UG = (const float*)(p.ws + WS_LU) + (size_t)row0 * GW + tid;
    const bf16* gt = (const bf16*)(p.ws + WS_PACT) + SEG_LG * SEG_STRIDE + (size_t)row0 * GW + tid;
    lci = ((const float*)(p.ws + WS_LCI))[(size_t)u * GW + tid];
#pragma unroll
    for (int t = 0; t < 16; ++t) { pa[t] = AG[t * GW]; pu[t] = UG[t * GW]; pg[t] = bf2f(gt[t * GW]); }
}
__device__ __forceinline__ void lru3_unit(const Ctx& p, int u, int un, float (&pa)[16], float (&pu)[16], float (&pg)[16], float& lci, const LruC& C, LAS unsigned char* lds) {
    const int tid = opaque_tid(), lane = tid & 63, w = tid >> 6;
    const int row0 = (u >> 8) * SEQ + (u & 255) * LRU_T;
    LAS bf16* Y = (LAS bf16*)lds;
    float h = lci;
#pragma unroll
    for (int t = 0; t < 16; ++t) { h = pa[t] * h + pu[t]; Y[t * 520 + tid] = (bf16)f2bf(h * gelu_tanh(pg[t])); }
    lru3_ld(p, un < NBATCH * LRU_NC ? un : u, tid, pa, pu, pg, lci);
    __syncthreads();
    bf16* mixed = (bf16*)(p.ws + WS_MIXED);
    float gv[8];
#pragma unroll
    for (int e = 0; e < 8; ++e) gv[e] = C.ga[e];
#pragma unroll
    for (int tt = 0; tt < 2; ++tt) {
        const int t = w * 2 + tt; const v4u v = *(const LAS v4u*)(Y + t * 520 + lane * 8);
        float f[8] = {bflo(v.x), bfhi(v.x), bflo(v.y), bfhi(v.y), bflo(v.z), bfhi(v.z), bflo(v.w), bfhi(v.w)}; float ss = 0.f;
#pragma unroll
        for (int e = 0; e < 8; ++e) ss += f[e] * f[e];
        ss = wave_sum(ss); const float rs = __builtin_amdgcn_rsqf(ss * (1.0f / GW) + EPS);
        v4u o; o.x = pk2(f[0] * rs * gv[0], f[1] * rs * gv[1]); o.y = pk2(f[2] * rs * gv[2], f[3] * rs * gv[3]); o.z = pk2(f[4] * rs * gv[4], f[5] * rs * gv[5]); o.w = pk2(f[6] * rs * gv[6], f[7] * rs * gv[7]);
        *(v4u*)(mixed + (size_t)(row0 + t) * DM + lane * 8) = o;
    }
}
__device__ __forceinline__ void lru_carry_unit(const Ctx& p, int u, LAS unsigned char* lds) {
    const int tid = opaque_tid(), ch = tid & 63, seg = tid >> 6, b = u >> 3, chg = (u & 7) * 64 + ch;
    const float* LAP = (const float*)(p.ws + WS_LAP); const float* LHE = (const float*)(p.ws + WS_LHE); float* LCI = (float*)(p.ws + WS_LCI);
    LAS float* TA = (LAS float*)lds; LAS float* TH = TA + 512;
    float ap[32], he[32];
#pragma unroll
    for (int j = 0; j < 32; ++j) { const size_t o = (size_t)(b * LRU_NC + 32 * seg + j) * GW + chg; ap[j] = LAP[o]; he[j] = LHE[o]; }
    float at = 1.f, ht = 0.f;
#pragma unroll
    for (int j = 0; j < 32; ++j) { ht = ap[j] * ht + he[j]; at *= ap[j]; }
    TA[seg * 64 + ch] = at; TH[seg * 64 + ch] = ht;
    __syncthreads();
    float carry = 0.f;
    for (int s2 = 0; s2 < seg; ++s2) carry = TA[s2 * 64 + ch] * carry + TH[s2 * 64 + ch];
#pragma unroll
    for (int j = 0; j < 32; ++j) { LCI[(size_t)(b * LRU_NC + 32 * seg + j) * GW + chg] = carry; carry = ap[j] * carry + he[j]; }
}

__device__ __forceinline__ void mlstm_ld_g(const Ctx& p, int u, int tid, float& gi, float& gf) {
    const int bh = u >> 6, row0 = (bh >> 2) * SEQ + (u & 63) * 64, h = bh & 3; const float* G = (const float*)(p.ws + WS_G);
    gi = G[(size_t)(row0 + (tid & 63)) * 8 + h]; gf = G[(size_t)(row0 + (tid & 63)) * 8 + 4 + h];
}
__device__ __forceinline__ void mlstm_ld_kv(const Ctx& p, int u, int tid, v4u (&kvr)[2], v4u (&vvr)[2]) {
    const int bh = u >> 6, row0 = (bh >> 2) * SEQ + (u & 63) * 64, h = bh & 3;
    const bf16* Kg = (const bf16*)(p.ws + WS_PACT) + SEG_MK * SEG_STRIDE + h * HD; const bf16* Vg = (const bf16*)(p.ws + WS_PACT) + SEG_MV * SEG_STRIDE + h * HD;
#pragma unroll
    for (int i = 0; i < 2; ++i) { const int q = tid + NT * i, s = q >> 4, kc = (q & 15) * 8; kvr[i] = *(const v4u*)(Kg + (size_t)(row0 + s) * GW + kc); vvr[i] = *(const v4u*)(Vg + (size_t)(row0 + s) * GW + kc); }
}
__device__ __forceinline__ void mlstm1_unit(const Ctx& p, int l, int u, int un, v4u (&kvr)[2], v4u (&vvr)[2], float& gi, float& gf, LAS unsigned char* lds) {
    const int tid = opaque_tid(), lane = tid & 63, w = tid >> 6, fr = lane & 15, fq = lane >> 4;
    const int bh = u >> 6, c = u & 63, b = bh >> 2, h = bh & 3, row0 = b * SEQ + c * 64;
    LAS bf16* VH = (LAS bf16*)lds;
    LAS bf16* KW = (LAS bf16*)(lds + 18432);
    LAS float* WS = (LAS float*)(lds + 36864);
    if (w == 0) {
        const int s = lane;
        const float ip = gi + p.in(14)[l * NH + h], fp = gf + p.in(15)[l * NH + h];
        float bc = -softplusf(-fp);
#pragma unroll
        for (int o = 1; o < 64; o <<= 1) { const float t = __shfl_up(bc, o); if (lane >= o) bc += t; }
        const float blast = __shfl(bc, 63), logw = blast - bc + ip, mloc = wave_max(logw);
        WS[s] = __expf(logw - mloc);
        if (lane == 0) { ((float*)(p.ws + WS_BLAST))[u] = blast; ((float*)(p.ws + WS_MLOC))[u] = mloc; }
    }
    __syncthreads();
#pragma unroll
    for (int i = 0; i < 2; ++i) {
        const int q = tid + NT * i, s = q >> 4, kc = (q & 15) * 8;
        const v4u kv = kvr[i]; const float ws = WS[s] * KSCALE;
        v4u ko; ko.x = pk2(bflo(kv.x) * ws, bfhi(kv.x) * ws); ko.y = pk2(bflo(kv.y) * ws, bfhi(kv.y) * ws); ko.z = pk2(bflo(kv.z) * ws, bfhi(kv.z) * ws); ko.w = pk2(bflo(kv.w) * ws, bfhi(kv.w) * ws);
        *(LAS v4u*)(KW + s * 144 + kc) = ko; *(LAS v4u*)(VH + s * 144 + kc) = vvr[i];
    }
    mlstm_ld_kv(p, un < 1024 ? un : u, tid, kvr, vvr); mlstm_ld_g(p, un < 1024 ? un : u, tid, gi, gf);
    __syncthreads();
    float* DCT = (float*)(p.ws + WS_DCT) + (size_t)u * 16384;
    const bf16x8 vb0 = tr_frag(VH, 0, w, lane), vb1 = tr_frag(VH, 1, w, lane);
#pragma unroll
    for (int ki = 0; ki < 8; ++ki) {
        f32x4 acc = {0.f, 0.f, 0.f, 0.f};
        acc = __builtin_amdgcn_mfma_f32_16x16x32_bf16(tr_frag(KW, 0, ki, lane), vb0, acc, 0, 0, 0);
        acc = __builtin_amdgcn_mfma_f32_16x16x32_bf16(tr_frag(KW, 1, ki, lane), vb1, acc, 0, 0, 0);
        *(f32x4*)(DCT + (16 * w + fr) * 128 + 16 * ki + 4 * fq) = acc;
    }
    if (tid < 128) { float s = 0.f;
#pragma unroll 8
        for (int t = 0; t < 64; ++t) s += bf2f(KW[t * 144 + tid]);
        ((float*)(p.ws + WS_DN))[(size_t)u * 128 + tid] = s; }
}
__device__ __forceinline__ void mlstm_scan_unit(const Ctx& p, int su, LAS unsigned char* lds) {
    const int tid = opaque_tid(), lane = tid & 63, bh = su >> 5, slice = su & 31, seg = tid >> 7, grp = tid & 127, e0 = slice * 512 + grp * 4;
    const float* DCT = (const float*)(p.ws + WS_DCT); bf16* CST = (bf16*)(p.ws + WS_CST);
    const float* DN = (const float*)(p.ws + WS_DN); float* NST = (float*)(p.ws + WS_NST);
    LAS float* DEC = (LAS float*)lds; LAS float* SC = DEC + 64; LAS float* PFX = DEC + 128;
    LAS f32x4* TOT = (LAS f32x4*)(lds + 1024);
    LAS f32x4* TOTN = (LAS f32x4*)(lds + 1024 + 8192);
    LAS float* PT = (LAS float*)(lds + 1024 + 8192 + 2048);
    f32x4 d4[16];
#pragma unroll
    for (int j = 0; j < 16; ++j) { const int ui = bh * 64 + 16 * seg + j; d4[j] = *(const f32x4*)(DCT + (size_t)ui * 16384 + e0); }
    if (tid < 64) {
        const int c = lane; const float bl = ((const float*)(p.ws + WS_BLAST))[bh * 64 + c], ml = ((const float*)(p.ws + WS_MLOC))[bh * 64 + c];
        float mrun = 0.f, mine_run = 0.f, mine_next = 0.f;
        for (int i = 0; i < 64; ++i) { const float bli = __shfl(bl, i), mli = __shfl(ml, i), mnext = fmaxf(bli + mrun, mli); if (c == i) { mine_run = mrun; mine_next = mnext; } mrun = mnext; }
        const float dec = __expf(bl + mine_run - mine_next), sc = __expf(ml - mine_next);
        DEC[c] = dec; SC[c] = sc;
        float pf = dec;
#pragma unroll
        for (int o = 1; o < 16; o <<= 1) { const float t = __shfl_up(pf, o); if ((c & 15) >= o) pf *= t; }
        const float ex = __shfl_up(pf, 1); PFX[c] = (c & 15) ? ex : 1.f;
        if ((c & 15) == 15) PT[c >> 4] = pf;
        if (slice == 0) ((float*)(p.ws + WS_MRUN))[bh * 64 + c] = mine_run;
    }
    __syncthreads();
    {
        f32x4 L = {0.f, 0.f, 0.f, 0.f};
#pragma unroll
        for (int j = 0; j < 16; ++j) { const float dec = DEC[16 * seg + j], sc = SC[16 * seg + j]; const f32x4 d = d4[j]; d4[j] = L; L = L * dec + d * sc; }
        TOT[seg * 128 + grp] = L;
    }
    __syncthreads();
    {
        f32x4 I = {0.f, 0.f, 0.f, 0.f};
        for (int s2 = 0; s2 < 3; ++s2) if (s2 < seg) I = I * PT[s2] + TOT[s2 * 128 + grp];
#pragma unroll
        for (int j = 0; j < 16; ++j) {
            const int ui = bh * 64 + 16 * seg + j; const f32x4 C = d4[j] + I * PFX[16 * seg + j];
            v2u o; o.x = pk2(C[0], C[1]); o.y = pk2(C[2], C[3]); *(v2u*)(CST + (size_t)ui * 16384 + e0) = o;
        }
    }
    if (slice == 0 && tid < 128) {
        const int sg = tid >> 5, g4 = tid & 31; f32x4 n4[16];
#pragma unroll
        for (int j = 0; j < 16; ++j) n4[j] = *(const f32x4*)(DN + (size_t)(bh * 64 + 16 * sg + j) * 128 + g4 * 4);
        f32x4 L = {0.f, 0.f, 0.f, 0.f};
#pragma unroll
        for (int j = 0; j < 16; ++j) { const float dec = DEC[16 * sg + j], sc = SC[16 * sg + j]; const f32x4 d = n4[j]; n4[j] = L; L = L * dec + d * sc; }
        TOTN[sg * 32 + g4] = L;
        __builtin_amdgcn_s_waitcnt(0xC07F); __builtin_amdgcn_wave_barrier();
    }
    __syncthreads();
    if (slice == 0 && tid < 128) {
        const int sg = tid >> 5, g4 = tid & 31; f32x4 In = {0.f, 0.f, 0.f, 0.f};
        for (int s2 = 0; s2 < 3; ++s2) if (s2 < sg) In = In * PT[s2] + TOTN[s2 * 32 + g4];
        f32x4 L = {0.f, 0.f, 0.f, 0.f};
#pragma unroll
        for (int j = 0; j < 16; ++j) { const int ui = bh * 64 + 16 * sg + j; const float dec = DEC[16 * sg + j], sc = SC[16 * sg + j];
            *(f32x4*)(NST + (size_t)ui * 128 + g4 * 4) = L + In * PFX[16 * sg + j];
            const f32x4 d = *(const f32x4*)(DN + (size_t)ui * 128 + g4 * 4); L = L * dec + d * sc; }
    }
}
__device__ __forceinline__ void mlstm3_ld(const Ctx& p, int u, int tid, v4u (&pre)[10]) {
    const int bh = u >> 6, row0 = (bh >> 2) * SEQ + (u & 63) * 64, h = bh & 3;
    const bf16* Qg = (const bf16*)(p.ws + WS_PACT) + SEG_MQ * SEG_STRIDE + h * HD; const bf16* Kg = (const bf16*)(p.ws + WS_PACT) + SEG_MK * SEG_STRIDE + h * HD;
    const bf16* Vg = (const bf16*)(p.ws + WS_PACT) + SEG_MV * SEG_STRIDE + h * HD; const bf16* Cg = (const bf16*)(p.ws + WS_CST) + (size_t)u * 16384;
#pragma unroll
    for (int i = 0; i < 2; ++i) { const int q = tid + NT * i, s = q >> 4, kc = (q & 15) * 8;
        pre[i] = *(const v4u*)(Qg + (size_t)(row0 + s) * GW + kc); pre[2 + i] = *(const v4u*)(Kg + (size_t)(row0 + s) * GW + kc); pre[4 + i] = *(const v4u*)(Vg + (size_t)(row0 + s) * GW + kc); }
#pragma unroll
    for (int i = 0; i < 4; ++i) { const int q = tid + NT * i, r = q >> 4, kc = (q & 15) * 8; pre[6 + i] = *(const v4u*)(Cg + r * 128 + kc); }
}
__device__ __forceinline__ void mlstm3_unit(const Ctx& p, int l, int u, int un, v4u (&pre)[10], float& gi, float& gf, float& mrun_pf, float& nv_pf, LAS unsigned char* lds) {
    const int tid = opaque_tid(), lane = tid & 63, w = tid >> 6, fr = lane & 15, fq = lane >> 4;
    const int bh = u >> 6, c = u & 63, b = bh >> 2, h = bh & 3, row0 = b * SEQ + c * 64;
    LAS bf16* Q = (LAS bf16*)lds;
    LAS bf16* KS = (LAS bf16*)(lds + 17408);
    LAS bf16* VH = (LAS bf16*)(lds + 34816);
    LAS bf16* CT = (LAS bf16*)(lds + 53248);
    LAS bf16* SB = (LAS bf16*)(lds + 88064);
    LAS float* HF = (LAS float*)(lds + 97280);
    LAS float* BV = (LAS float*)(lds + 130304);
    LAS float* CV = BV + 64;
    LAS float* MT = BV + 128;
    LAS float* WI = BV + 192;
    LAS float* QN = BV + 256;
    LAS float* NV = BV + 320;
    LAS float* RSP = BV + 448;
    const float* G = (const float*)(p.ws + WS_G);
    const bf16* Og = (const bf16*)(p.ws + WS_PACT) + SEG_MO * SEG_STRIDE + h * HD;
    {
        if (w == 0) {
            const int s = lane;
            const float ip = gi + p.in(14)[l * NH + h], fp = gf + p.in(15)[l * NH + h];
            float bc = -softplusf(-fp);
#pragma unroll
            for (int o = 1; o < 64; o <<= 1) { const float t = __shfl_up(bc, o); if (lane >= o) bc += t; }
            const float cv = ip - bc; float g = cv;
#pragma unroll
            for (int o = 1; o < 64; o <<= 1) { const float t = __shfl_up(g, o); if (lane >= o) g = fmaxf(g, t); }
            const float mrun = mrun_pf, mt = bc + fmaxf(mrun, g);
            BV[s] = bc; CV[s] = cv; MT[s] = mt; WI[s] = __expf(bc + mrun - mt);
        }
        if (tid >= 64 && tid < 192) NV[tid - 64] = nv_pf;
#pragma unroll
        for (int i = 0; i < 2; ++i) { const int q = tid + NT * i, s = q >> 4, kc = (q & 15) * 8; const v4u kv = pre[2 + i];
            *(LAS v4u*)(Q + s * 136 + kc) = pre[i];
            v4u ko; ko.x = pk2(bflo(kv.x) * KSCALE, bfhi(kv.x) * KSCALE); ko.y = pk2(bflo(kv.y) * KSCALE, bfhi(kv.y) * KSCALE); ko.z = pk2(bflo(kv.z) * KSCALE, bfhi(kv.z) * KSCALE); ko.w = pk2(bflo(kv.w) * KSCALE, bfhi(kv.w) * KSCALE);
            *(LAS v4u*)(KS + s * 136 + kc) = ko; *(LAS v4u*)(VH + s * 144 + kc) = pre[4 + i]; }
#pragma unroll
        for (int i = 0; i < 4; ++i) { const int q = tid + NT * i, r = q >> 4, kc = (q & 15) * 8; *(LAS v4u*)(CT + r * 136 + kc) = pre[6 + i]; }
        { const int uq = un < 1024 ? un : u;
          mlstm3_ld(p, uq, tid, pre); mlstm_ld_g(p, uq, tid, gi, gf); mrun_pf = ((const float*)(p.ws + WS_MRUN))[uq]; nv_pf = ((const float*)(p.ws + WS_NST))[(size_t)uq * 128 + ((tid - 64) & 127)]; }
    }
    float op0[8], op1[8];
#pragma unroll
    for (int tt = 0; tt < 8; ++tt) { op0[tt] = bf2f(Og[(size_t)(row0 + w * 8 + tt) * GW + lane]); op1[tt] = bf2f(Og[(size_t)(row0 + w * 8 + tt) * GW + lane + 64]); }
    __syncthreads();
    const int ti = w >> 1;
    {
#pragma unroll
        for (int x = 0; x < 2; ++x) {
            const int si = 2 * (w & 1) + x;
            f32x4 acc = {0.f, 0.f, 0.f, 0.f};
            if (si <= ti) mma_lds<128>(acc, Q + 16 * ti * 136, 136, KS + 16 * si * 136, 136, lane);
            const int s = 16 * si + fr; const float cvs = CV[s];
#pragma unroll
            for (int j = 0; j < 4; ++j) { const int t = 16 * ti + 4 * fq + j; const float sd = (s <= t) ? acc[j] * __expf(BV[t] + cvs - MT[t]) : 0.f;
                SB[t * 72 + s] = (bf16)f2bf(sd);
                float r = sd; r += __shfl_xor(r, 1); r += __shfl_xor(r, 2); r += __shfl_xor(r, 4); r += __shfl_xor(r, 8);
                if (fr == 0) RSP[t * 4 + si] = r; }
        }
        if (w == 7) { const int t = lane; float qn = 0.f;
#pragma unroll 8
            for (int k = 0; k < 128; ++k) qn += bf2f(Q[t * 136 + k]) * NV[k];
            QN[t] = qn; }
    }
    __syncthreads();
    {
        const bf16x8 sa0 = *(const LAS bf16x8*)(SB + (16 * ti + fr) * 72 + 8 * fq), sa1 = *(const LAS bf16x8*)(SB + (16 * ti + fr) * 72 + 32 + 8 * fq);
        float wi[4], dinv[4];
#pragma unroll
        for (int j = 0; j < 4; ++j) { const int t = 16 * ti + 4 * fq + j; wi[j] = WI[t];
            const float den = (RSP[t * 4] + RSP[t * 4 + 1]) + (RSP[t * 4 + 2] + RSP[t * 4 + 3]) + wi[j] * QN[t];
            dinv[j] = 1.0f / fmaxf(fabsf(den), __expf(-MT[t])); }
#pragma unroll
        for (int x = 0; x < 4; ++x) {
            const int vi = 4 * (w & 1) + x;
            f32x4 a1 = {0.f, 0.f, 0.f, 0.f}, a2 = {0.f, 0.f, 0.f, 0.f};
            a1 = __builtin_amdgcn_mfma_f32_16x16x32_bf16(sa0, tr_frag(VH, 0, vi, lane), a1, 0, 0, 0);
            a1 = __builtin_amdgcn_mfma_f32_16x16x32_bf16(sa1, tr_frag(VH, 1, vi, lane), a1, 0, 0, 0);
            mma_lds<128>(a2, Q + 16 * ti * 136, 136, CT + 16 * vi * 136, 136, lane);
#pragma unroll
            for (int j = 0; j < 4; ++j) HF[(16 * ti + 4 * fq + j) * 129 + 16 * vi + fr] = (a1[j] + wi[j] * a2[j]) * dinv[j];
        }
    }
    __syncthreads();
    {
        const float* gb = p.in(18) + l * DM + GW + h * HD; bf16* mixed = (bf16*)(p.ws + WS_MIXED);
        const float g0 = gb[lane], g1 = gb[lane + 64];
#pragma unroll
        for (int tt = 0; tt < 8; ++tt) {
            const int t = w * 8 + tt; const float h0 = HF[t * 129 + lane], h1 = HF[t * 129 + lane + 64];
            const float ss = wave_sum(h0 * h0 + h1 * h1), rs = __builtin_amdgcn_rsqf(ss * (1.0f / HD) + EPS);
            bf16* mo = mixed + (size_t)(row0 + t) * DM + GW + h * HD;
            mo[lane] = (bf16)f2bf(h0 * rs * g0 * sigmoidf(op0[tt])); mo[lane + 64] = (bf16)f2bf(h1 * rs * g1 * sigmoidf(op1[tt]));
        }
    }
}

template <int NCH> __device__ __forceinline__ void ld_rows(v4u (&r)[NCH], const bf16* src, int gbase, int gstride, int tid) {
#pragma unroll
    for (int i = 0; i < NCH; ++i) { const int q = tid + NT * i, row = q >> 4, kc = (q & 15) * 8; r[i] = *(const v4u*)(src + (size_t)(gbase + row * gstride) * GW + kc); }
}
template <bool NORM, int NCH, int PITCH> __device__ __forceinline__ void st_rows(LAS bf16* dst, const v4u (&r)[NCH], const float (&gain)[8], int tid) {
#pragma unroll
    for (int i = 0; i < NCH; ++i) {
        const int q = tid + NT * i, row = q >> 4, kc = (q & 15) * 8; v4u v = r[i];
        if (NORM) {
            float f[8] = {bflo(v.x), bfhi(v.x), bflo(v.y), bfhi(v.y), bflo(v.z), bfhi(v.z), bflo(v.w), bfhi(v.w)}; float ss = 0.f;
#pragma unroll
            for (int e = 0; e < 8; ++e) ss += f[e] * f[e];
            ss += __shfl_xor(ss, 1); ss += __shfl_xor(ss, 2); ss += __shfl_xor(ss, 4); ss += __shfl_xor(ss, 8);
            const float rs = __builtin_amdgcn_rsqf(ss * (1.0f / HD) + EPS);
            v.x = pk2(f[0] * rs * gain[0], f[1] * rs * gain[1]); v.y = pk2(f[2] * rs * gain[2], f[3] * rs * gain[3]);
            v.z = pk2(f[4] * rs * gain[4], f[5] * rs * gain[5]); v.w = pk2(f[6] * rs * gain[6], f[7] * rs * gain[7]);
        }
        *(LAS v4u*)(dst + row * PITCH + kc) = v;
    }
}
constexpr int ATT_K = 0, ATT_V = 17408, ATT_PL = 35840, ATT_VOTE = 72704, ATT_Q = 73728;
__device__ __forceinline__ void load_qfrags(bf16x8 (&qf)[2][4], const LAS bf16* QH, int w, int lane) {
#pragma unroll
    for (int rt = 0; rt < 2; ++rt)
#pragma unroll
        for (int k = 0; k < 4; ++k) qf[rt][k] = *(const LAS bf16x8*)(QH + (32 * w + 16 * rt + (lane & 15)) * 136 + 32 * k + 8 * (lane >> 4));
}

__device__ __forceinline__ void dilated_unit(const Ctx& p, int l, int u, LAS unsigned char* lds) {
    const int tid = opaque_tid(), lane = tid & 63, w = tid >> 6, fr = lane & 15, fq = lane >> 4;
    const int pat = u >> 8, rem = u & 255, bh = rem >> 4, x = rem & 15, b = bh >> 2, h = bh & 3;
    const int d = pat == 0 ? 1 : (pat == 1 ? 4 : 16);
    const int r = pat == 0 ? 0 : (pat == 1 ? (x >> 2) : x), nbk = pat == 0 ? x : (pat == 1 ? (x & 3) : 0);
    LAS bf16* QH = (LAS bf16*)(lds + ATT_Q); LAS bf16* KH = (LAS bf16*)(lds + ATT_K); LAS bf16* VH = (LAS bf16*)(lds + ATT_V); LAS bf16* PL = (LAS bf16*)(lds + ATT_PL) + w * 32 * 72;
    const bf16* Qg = (const bf16*)(p.ws + WS_PACT) + SEG_CQ * SEG_STRIDE + h * HD; const bf16* Kg = (const bf16*)(p.ws + WS_PACT) + SEG_CK * SEG_STRIDE + h * HD;
    const bf16* Vg = (const bf16*)(p.ws + WS_PACT) + SEG_CV * SEG_STRIDE + h * HD;
    float qgain[8], kgain[8];
#pragma unroll
    for (int e = 0; e < 8; ++e) { qgain[e] = p.in(16)[l * HD + (tid & 15) * 8 + e]; kgain[e] = p.in(17)[l * HD + (tid & 15) * 8 + e]; }
    const float slope2 = exp2f(-2.0f * (float)(h + 1)) * (float)d * 1.4426950408889634f; constexpr float QK2 = KSCALE * 1.4426950408889634f;
    const int kt0 = (nbk == 0 ? 2 : 0), gk0 = b * SEQ + (nbk * 256 - 128) * d + r;
    v4u kr[2], vr[2];
    { v4u qr[8]; ld_rows<8>(qr, Qg, b * SEQ + (nbk * 256) * d + r, d, tid); ld_rows<2>(kr, Kg, gk0 + kt0 * 64 * d, d, tid); ld_rows<2>(vr, Vg, gk0 + kt0 * 64 * d, d, tid);
      st_rows<true, 8, 136>(QH, qr, qgain, tid); }
    __syncthreads();
    bf16x8 qf[2][4]; load_qfrags(qf, QH, w, lane);
    float m_i[2] = {-1e30f, -1e30f}, l_i[2] = {0.f, 0.f}; f32x4 o[2][8];
#pragma unroll
    for (int rt = 0; rt < 2; ++rt)
#pragma unroll
        for (int ds = 0; ds < 8; ++ds) o[rt][ds] = (f32x4){0.f, 0.f, 0.f, 0.f};
    for (int kt = kt0; kt < 6; ++kt) {
        __syncthreads();
        st_rows<true, 2, 136>(KH, kr, kgain, tid); st_rows<false, 2, 144>(VH, vr, kgain, tid);
        __syncthreads();
        if (kt < 5) { ld_rows<2>(kr, Kg, gk0 + (kt + 1) * 64 * d, d, tid); ld_rows<2>(vr, Vg, gk0 + (kt + 1) * 64 * d, d, tid); }
        if ((64 * kt + 63 >= 32 * w) && (64 * kt <= 32 * w + 31 + 128)) {
            f32x4 s[2][4];
#pragma unroll
            for (int rt = 0; rt < 2; ++rt)
#pragma unroll
                for (int n = 0; n < 4; ++n) s[rt][n] = (f32x4){0.f, 0.f, 0.f, 0.f};
#pragma unroll
            for (int k = 0; k < 4; ++k)
#pragma unroll
                for (int n = 0; n < 4; ++n) { const bf16x8 kf = *(const LAS bf16x8*)(KH + (16 * n + fr) * 136 + 32 * k + 8 * fq);
                    s[0][n] = __builtin_amdgcn_mfma_f32_16x16x32_bf16(kf, qf[0][k], s[0][n], 0, 0, 0); s[1][n] = __builtin_amdgcn_mfma_f32_16x16x32_bf16(kf, qf[1][k], s[1][n], 0, 0, 0); }
            float alpha[2];
#pragma unroll
            for (int rt = 0; rt < 2; ++rt) {
                const int D0 = 128 + (32 * w + 16 * rt + fr) - 64 * kt - 4 * fq; const float b0 = -slope2 * (float)D0; float mx = -1e30f;
#pragma unroll
                for (int n = 0; n < 4; ++n)
#pragma unroll
                    for (int j = 0; j < 4; ++j) { const bool valid = (unsigned)(D0 - (16 * n + j)) <= 128u;
                        const float sc = valid ? __builtin_fmaf(s[rt][n][j], QK2, __builtin_fmaf(slope2, (float)(16 * n + j), b0)) : -__builtin_inff(); s[rt][n][j] = sc; mx = fmaxf(mx, sc); }
                mx = fmaxf(mx, __shfl_xor(mx, 16)); mx = fmaxf(mx, __shfl_xor(mx, 32));
                const float m_new = fmaxf(m_i[rt], mx); alpha[rt] = __builtin_amdgcn_exp2f(m_i[rt] - m_new); float ls = 0.f;
#pragma unroll
                for (int n = 0; n < 4; ++n) {
#pragma unroll
                    for (int j = 0; j < 4; ++j) { const float pv = __builtin_amdgcn_exp2f(s[rt][n][j] - m_new); ls += pv; s[rt][n][j] = pv; }
                    v2u pw; pw.x = pk2(s[rt][n][0], s[rt][n][1]); pw.y = pk2(s[rt][n][2], s[rt][n][3]);
                    *(LAS v2u*)(PL + (16 * rt + fr) * 72 + 16 * n + 4 * fq) = pw;
                }
                ls += __shfl_xor(ls, 16); ls += __shfl_xor(ls, 32);
                l_i[rt] = l_i[rt] * alpha[rt] + ls; m_i[rt] = m_new;
            }
            asm volatile("" ::: "memory");
            bf16x8 pf[2][2];
#pragma unroll
            for (int rt = 0; rt < 2; ++rt) { pf[rt][0] = *(const LAS bf16x8*)(PL + (16 * rt + fr) * 72 + 8 * fq); pf[rt][1] = *(const LAS bf16x8*)(PL + (16 * rt + fr) * 72 + 32 + 8 * fq); }
#pragma unroll
            for (int ds = 0; ds < 8; ++ds) { const bf16x8 v0 = tr_frag(VH, 0, ds, lane), v1 = tr_frag(VH, 1, ds, lane);
#pragma unroll
                for (int rt = 0; rt < 2; ++rt) { o[rt][ds] = o[rt][ds] * alpha[rt];
                    o[rt][ds] = __builtin_amdgcn_mfma_f32_16x16x32_bf16(v0, pf[rt][0], o[rt][ds], 0, 0, 0); o[rt][ds] = __builtin_amdgcn_mfma_f32_16x16x32_bf16(v1, pf[rt][1], o[rt][ds], 0, 0, 0); } }
        }
    }
#pragma unroll
    for (int rt = 0; rt < 2; ++rt) {
        const int qi = 32 * w + 16 * rt + fr; const float inv = 1.0f / l_i[rt]; const int grow = b * SEQ + (nbk * 256 + qi) * d + r;
        bf16* og = (bf16*)(p.ws + WS_CPART) + (size_t)pat * SEG_STRIDE + (size_t)grow * GW + h * HD;
#pragma unroll
        for (int ds = 0; ds < 8; ++ds) { v2u ov; ov.x = pk2(o[rt][ds][0] * inv, o[rt][ds][1] * inv); ov.y = pk2(o[rt][ds][2] * inv, o[rt][ds][3] * inv); *(v2u*)(og + 16 * ds + 4 * fq) = ov; }
        if (fq == 0) ((float*)(p.ws + WS_LSE))[((size_t)pat * M + grow) * 4 + h] = m_i[rt] * 0.6931471805599453f + __logf(l_i[rt]);
    }
}

__device__ __forceinline__ void stick_unit(const Ctx& p, int u, LAS unsigned char* lds) {
    const int tid = opaque_tid(), lane = tid & 63, w = tid >> 6, fr = lane & 15, fq = lane >> 4;
    const int qb = 15 - (u >> 4), bh = u & 15, b = bh >> 2, h = bh & 3;
    LAS bf16* QH = (LAS bf16*)(lds + ATT_Q); LAS bf16* KH = (LAS bf16*)(lds + ATT_K); LAS bf16* VH = (LAS bf16*)(lds + ATT_V); LAS bf16* PL = (LAS bf16*)(lds + ATT_PL) + w * 32 * 72;
    volatile LAS int* vote = (volatile LAS int*)(lds + ATT_VOTE);
    const bf16* Qg = (const bf16*)(p.ws + WS_PACT) + SEG_SQ * SEG_STRIDE + h * HD; const bf16* Kg = (const bf16*)(p.ws + WS_PACT) + SEG_SK * SEG_STRIDE + h * HD;
    const bf16* Vg = (const bf16*)(p.ws + WS_PACT) + SEG_SV * SEG_STRIDE + h * HD;
    const float nogain[8] = {1.f, 1.f, 1.f, 1.f, 1.f, 1.f, 1.f, 1.f};
    const int ktop = 4 * qb + 3;
    v4u kr[2], vr[2];
    { v4u qr[8]; ld_rows<8>(qr, Qg, b * SEQ + qb * 256, 1, tid); ld_rows<2>(kr, Kg, b * SEQ + ktop * 64, 1, tid); ld_rows<2>(vr, Vg, b * SEQ + ktop * 64, 1, tid);
      st_rows<false, 8, 136>(QH, qr, nogain, tid); }
    if (tid < 8) vote[tid] = 0;
    __syncthreads();
    bf16x8 qf[2][4]; load_qfrags(qf, QH, w, lane);
    float R[2] = {0.f, 0.f}; f32x4 o[2][8];
#pragma unroll
    for (int rt = 0; rt < 2; ++rt)
#pragma unroll
        for (int ds = 0; ds < 8; ++ds) o[rt][ds] = (f32x4){0.f, 0.f, 0.f, 0.f};
    for (int kt = ktop; kt >= 0; --kt) {
        __syncthreads();
        { int all = 1;
#pragma unroll
          for (int i = 0; i < 8; ++i) all &= vote[i];
          if (all) break; }
        st_rows<false, 2, 136>(KH, kr, nogain, tid); st_rows<false, 2, 144>(VH, vr, nogain, tid);
        __syncthreads();
        if (kt > 0) { ld_rows<2>(kr, Kg, b * SEQ + (kt - 1) * 64, 1, tid); ld_rows<2>(vr, Vg, b * SEQ + (kt - 1) * 64, 1, tid); }
        if (64 * kt < 256 * qb + 32 * w + 31) {
            f32x4 s[2][4];
#pragma unroll
            for (int rt = 0; rt < 2; ++rt)
#pragma unroll
                for (int n = 0; n < 4; ++n) s[rt][n] = (f32x4){0.f, 0.f, 0.f, 0.f};
#pragma unroll
            for (int k = 0; k < 4; ++k)
#pragma unroll
                for (int n = 0; n < 4; ++n) { const bf16x8 kf = *(const LAS bf16x8*)(KH + (16 * n + fr) * 136 + 32 * k + 8 * fq);
                    s[0][n] = __builtin_amdgcn_mfma_f32_16x16x32_bf16(kf, qf[0][k], s[0][n], 0, 0, 0); s[1][n] = __builtin_amdgcn_mfma_f32_16x16x32_bf16(kf, qf[1][k], s[1][n], 0, 0, 0); }
#pragma unroll
            for (int rt = 0; rt < 2; ++rt) {
                const int Q0 = (256 * qb + 32 * w + 16 * rt + fr) - 64 * kt - 4 * fq; float carry = 0.f;
#pragma unroll
                for (int n = 3; n >= 0; --n) {
                    float lk[4], lsg[4];
#pragma unroll
                    for (int j = 0; j < 4; ++j) { const bool live = (16 * n + j) < Q0; const float z2 = s[rt][n][j] * (KSCALE * 1.4426950408889634f);
                        const float sp2 = fmaxf(z2, 0.f) + __builtin_amdgcn_logf(1.0f + __builtin_amdgcn_exp2f(-fabsf(z2)));
                        lk[j] = live ? -sp2 : 0.f; lsg[j] = live ? z2 - sp2 : -__builtin_inff(); }
                    const float s2 = lk[3], s1 = s2 + lk[2], s0 = s1 + lk[1], T = s0 + lk[0];
                    const float t1 = __shfl(T, (lane + 16) & 63), t2 = __shfl(T, (lane + 32) & 63), t3 = __shfl(T, (lane + 48) & 63);
                    const float base = (fq < 3 ? t1 : 0.f) + (fq < 2 ? t2 : 0.f) + (fq < 1 ? t3 : 0.f) + carry + R[rt];
                    const float w0 = __builtin_amdgcn_exp2f(lsg[0] + (s0 + base)), w1 = __builtin_amdgcn_exp2f(lsg[1] + (s1 + base)), w2 = __builtin_amdgcn_exp2f(lsg[2] + (s2 + base)), w3 = __builtin_amdgcn_exp2f(lsg[3] + base);
                    v2u pw; pw.x = pk2(w0, w1); pw.y = pk2(w2, w3);
                    *(LAS v2u*)(PL + (16 * rt + fr) * 72 + 16 * n + 4 * fq) = pw;
                    carry += (T + t1) + (t2 + t3);
                }
                R[rt] += carry;
            }
            asm volatile("" ::: "memory");
            bf16x8 pf[2][2];
#pragma unroll
            for (int rt = 0; rt < 2; ++rt) { pf[rt][0] = *(const LAS bf16x8*)(PL + (16 * rt + fr) * 72 + 8 * fq); pf[rt][1] = *(const LAS bf16x8*)(PL + (16 * rt + fr) * 72 + 32 + 8 * fq); }
#pragma unroll
            for (int ds = 0; ds < 8; ++ds) { const bf16x8 v0 = tr_frag(VH, 0, ds, lane), v1 = tr_frag(VH, 1, ds, lane);
#pragma unroll
                for (int rt = 0; rt < 2; ++rt) { o[rt][ds] = __builtin_amdgcn_mfma_f32_16x16x32_bf16(v0, pf[rt][0], o[rt][ds], 0, 0, 0); o[rt][ds] = __builtin_amdgcn_mfma_f32_16x16x32_bf16(v1, pf[rt][1], o[rt][ds], 0, 0, 0); } }
        }
        { const int done = __all(R[0] <= -150.5f && R[1] <= -150.5f); if (lane == 0) vote[w] = done; }
    }
#pragma unroll
    for (int rt = 0; rt < 2; ++rt) {
        bf16* og = (bf16*)(p.ws + WS_DOUT) + (size_t)(b * SEQ + 256 * qb + 32 * w + 16 * rt + fr) * GW + h * HD;
#pragma unroll
        for (int ds = 0; ds < 8; ++ds) { v2u ov; ov.x = pk2(o[rt][ds][0], o[rt][ds][1]); ov.y = pk2(o[rt][ds][2], o[rt][ds][3]); *(v2u*)(og + 16 * ds + 4 * fq) = ov; }
    }
}

__device__ __forceinline__ void finalize_unit(const Ctx& p, int l, int u) {
    const int tid = opaque_tid(), lane = tid & 63, w = tid >> 6, hd = lane >> 4;
    const bf16* CP = (const bf16*)(p.ws + WS_CPART); const float* LSE = (const float*)(p.ws + WS_LSE); const bf16* DO = (const bf16*)(p.ws + WS_DOUT); bf16* mixed = (bf16*)(p.ws + WS_MIXED);
    const float* gc = p.in(18) + l * DM + 2 * GW + lane * 8; const float* gd = p.in(18) + l * DM + 3 * GW + lane * 8;
    float gcv[8], gdv[8];
#pragma unroll
    for (int e = 0; e < 8; ++e) { gcv[e] = gc[e]; gdv[e] = gd[e]; }
    for (int tb = 0; tb < 8; tb += 4) {
        v4u a[4], bq[4], cq[4], dv[4]; float l0[4], l1[4], l2[4];
#pragma unroll
        for (int tt = 0; tt < 4; ++tt) {
            const int grow = u * 64 + w * 8 + tb + tt;
            l0[tt] = LSE[((size_t)0 * M + grow) * 4 + hd]; l1[tt] = LSE[((size_t)1 * M + grow) * 4 + hd]; l2[tt] = LSE[((size_t)2 * M + grow) * 4 + hd];
            a[tt] = *(const v4u*)(CP + (size_t)grow * GW + lane * 8); bq[tt] = *(const v4u*)(CP + SEG_STRIDE + (size_t)grow * GW + lane * 8); cq[tt] = *(const v4u*)(CP + 2 * SEG_STRIDE + (size_t)grow * GW + lane * 8);
            dv[tt] = *(const v4u*)(DO + (size_t)grow * GW + lane * 8);
        }
#pragma unroll
        for (int tt = 0; tt < 4; ++tt) {
            const int grow = u * 64 + w * 8 + tb + tt;
            const float L = fmaxf(l0[tt], fmaxf(l1[tt], l2[tt])); float w0 = __expf(l0[tt] - L), w1 = __expf(l1[tt] - L), w2 = __expf(l2[tt] - L); const float inv = 1.0f / (w0 + w1 + w2); w0 *= inv; w1 *= inv; w2 *= inv;
            const unsigned aw[4] = {a[tt].x, a[tt].y, a[tt].z, a[tt].w}, bw[4] = {bq[tt].x, bq[tt].y, bq[tt].z, bq[tt].w}, cw[4] = {cq[tt].x, cq[tt].y, cq[tt].z, cq[tt].w};
            float f[8]; float ss = 0.f;
#pragma unroll
            for (int e = 0; e < 4; ++e) { f[2 * e] = w0 * bflo(aw[e]) + w1 * bflo(bw[e]) + w2 * bflo(cw[e]); f[2 * e + 1] = w0 * bfhi(aw[e]) + w1 * bfhi(bw[e]) + w2 * bfhi(cw[e]); ss += f[2 * e] * f[2 * e] + f[2 * e + 1] * f[2 * e + 1]; }
            ss = wave_sum(ss); float rs = __builtin_amdgcn_rsqf(ss * (1.0f / GW) + EPS);
            v4u ov; ov.x = pk2(f[0] * rs * gcv[0], f[1] * rs * gcv[1]); ov.y = pk2(f[2] * rs * gcv[2], f[3] * rs * gcv[3]); ov.z = pk2(f[4] * rs * gcv[4], f[5] * rs * gcv[5]); ov.w = pk2(f[6] * rs * gcv[6], f[7] * rs * gcv[7]);
            *(v4u*)(mixed + (size_t)grow * DM + 2 * GW + lane * 8) = ov;
            const unsigned dw[4] = {dv[tt].x, dv[tt].y, dv[tt].z, dv[tt].w};
            ss = 0.f;
#pragma unroll
            for (int e = 0; e < 4; ++e) { f[2 * e] = bflo(dw[e]); f[2 * e + 1] = bfhi(dw[e]); ss += f[2 * e] * f[2 * e] + f[2 * e + 1] * f[2 * e + 1]; }
            ss = wave_sum(ss); rs = __builtin_amdgcn_rsqf(ss * (1.0f / GW) + EPS);
            ov.x = pk2(f[0] * rs * gdv[0], f[1] * rs * gdv[1]); ov.y = pk2(f[2] * rs * gdv[2], f[3] * rs * gdv[3]); ov.z = pk2(f[4] * rs * gdv[4], f[5] * rs * gdv[5]); ov.w = pk2(f[6] * rs * gdv[6], f[7] * rs * gdv[7]);
            *(v4u*)(mixed + (size_t)grow * DM + 3 * GW + lane * 8) = ov;
        }
    }
}

#ifndef PROBE_REPEAT
#define PROBE_REPEAT 0
#endif
#ifndef K_ROTATE
#define K_ROTATE 0
#endif
#define KROT(K_) (K_ROTATE ? ((((int)blockIdx.x & 7) * ((K_) / 64 / 8)) & ~1) : 0)
#ifndef PROBE_STAMP
#define PROBE_STAMP_DIV 10000.0f
#define PROBE_STAMP 0
#endif
#define REP(k) for (int rep_ = 0; rep_ < (((PROBE_REPEAT) >> (k)) & 1) + 1; ++rep_)
__global__ void __launch_bounds__(NT, 2) fwd_kernel(Params kp) {
    extern __shared__ __attribute__((aligned(16))) unsigned char lds_raw[];
    LAS unsigned char* lds = (LAS unsigned char*)lds_raw;
    volatile LAS unsigned* MISC = (volatile LAS unsigned*)(lds + LDS_MISC_OFF);
    volatile LAS int* qslot = (volatile LAS int*)(MISC + 4);
    const int wid0 = __builtin_amdgcn_readfirstlane((int)threadIdx.x >> 6);
    if (threadIdx.x < 16) MISC[threadIdx.x] = 0u;
    __syncthreads();
    XcdBarrier bar; bar.bar = (unsigned*)(kp.ws + WS_CTL) + CW_BAR; bar.x = 0; bar.st = nullptr;
    if (!MK_SPLIT) bar = xcd_barrier_post((unsigned*)(kp.ws + WS_CTL) + CW_BAR, MISC);
    bar.wid = wid0;
    const int lo = kp.ph_lo, hi = kp.ph_hi;
    unsigned long long stamp_acc = 0ull, stamp_t0 = 0ull;
#define ST_BEGIN(bit) do { if ((PROBE_STAMP >> (bit)) & 1) { __syncthreads(); stamp_t0 = wall_clock64(); } } while (0)
#define ST_END(bit) do { if ((PROBE_STAMP >> (bit)) & 1) { __syncthreads(); stamp_acc += wall_clock64() - stamp_t0; } } while (0)
#define IN(k) (lo <= (k) && (k) < hi)
#define SEAM(k) do { if (IN(k) && IN((k) + 1)) { if (!MK_SPLIT) xcd_barrier(bar); } } while (0)
#define SEAML(k) do { if (IN(k) && IN((k) + 1)) { if (!MK_SPLIT) xcd_barrier(bar, MISC[2] != 0u ? 1 : 0); } } while (0)
#define SEAMP(k) do { if (IN(k) && IN((k) + 1)) { if (!MK_SPLIT) xcd_barrier(bar, MISC[2] != 0u ? 2 : 0, (unsigned)PAIRQ()); } } while (0)
#define PAIRQ() ((VB() & 7) >> 1)
#define PAIRJ() ((VB() & 1) * 32 + (VB() >> 3))
#define VB() (MISC[2] != 0u ? (int)(MISC[5] * 8u + MISC[2] - 1u) : (int)blockIdx.x)
#define CTX() const Ctx p = make_ctx(wid0); unsigned* ctl = (unsigned*)(p.ws + WS_CTL); unsigned long long* ssq = (unsigned long long*)(p.ws + WS_SSQ); bf16* xb = (bf16*)(p.ws + WS_XB); bf16* act = (bf16*)(p.ws + WS_PACT); bf16* mixed = (bf16*)(p.ws + WS_MIXED); \
    unsigned long long* ssqA = ssq + (size_t)(3 * l) * M; unsigned long long* ssqB = ssq + (size_t)(3 * l + 1) * M; unsigned long long* ssqC = ssq + (size_t)(3 * l + 2) * M; unsigned long long* ssqN = ssq + (size_t)(3 * l + 3) * M; \
    (void)ctl; (void)xb; (void)act; (void)mixed; (void)ssqA; (void)ssqB; (void)ssqC; (void)ssqN

    ST_BEGIN(2);
    if (IN(0)) { const Ctx p = make_ctx(wid0); prologue_x(p); }
    for (int l = 0; l < NLAYER; ++l) {
        const int pb = 1 + l * PH_PER_LAYER;
        if (l > 0) ST_BEGIN(2);
        if (IN(pb + 0)) REP(0) { const Ctx p = make_ctx(wid0); convert_gu_i8(p, l, lds); __syncthreads(); convert_layer(p, l, -1);
            if (l > 0) quant_rows_i8(p, (const bf16*)(p.ws + WS_XB), M, p.ws + WS_X8, (float*)(p.ws + WS_ROWSC)); }
        SEAM(pb + 0);
        ST_END(2);
        ST_BEGIN(0);
        if (IN(pb + 1)) REP(4) { CTX(); if (rep_) xcd_barrier(bar);
            float* rowsc = (float*)(p.ws + WS_ROWSC); float* colsc = (float*)(p.ws + WS_COLSC1);
            pg8::Gemm g{(const bf16*)(p.ws + WS_X8), (const bf16*)(p.ws + WS_WGU1), M, 2 * DFF, DM / 2, 0}; pg8::StaticOrder S; S.init(M, 2 * DFF, (int)gridDim.x, VB());
            if (pg8::ffn_f8(l, 0)) { pg8::EpiSwigluF8I8 E{act, pg8::DFF_P, ssqA, 1.0f / (DM * pg8::SSQ_FX), 1.0f, rowsc, colsc};
                pg8::gemm_phase<pg8::EpiSwigluF8I8, pg8::StaticOrder, PG8_ALIGN, PG8_SP2, false, true>(lds, g, S, E, wid0); }
            else { pg8::EpiSwigluI8 E{act, DFF, ssqA, 1.0f / (DM * pg8::SSQ_FX), 1.0f, rowsc, colsc};
                pg8::gemm_phase<pg8::EpiSwigluI8, pg8::StaticOrder, PG8_ALIGN, PG8_SP2, false, true>(lds, g, S, E, wid0); }
        }
        SEAML(pb + 1);
        if (IN(pb + 2)) { CTX();
            pg8::StaticOrder S; S.init(M, DM, (int)gridDim.x, VB());
            if (pg8::ffn_f8(l, 0)) { pg8::Gemm g{act, (const bf16*)(p.ws + WS_WD1), M, DM, pg8::DFF_P / 2, 0};
                pg8::EpiResid E{xb, nullptr, xb, ssqB, DM, 0.5f / (pg8::F8_ACT_SCALE * pg8::F8_W_SCALE), nullptr};
                pg8::gemm_phase<pg8::EpiResid, pg8::StaticOrder, PG8_ALIGN, PG8_SP2, true>(lds, g, S, E, wid0); }
            else { pg8::Gemm g{act, (const bf16*)(p.ws + WS_WD1), M, DM, DFF, 0};
                pg8::EpiResid E{xb, nullptr, xb, ssqB, DM, 0.5f, nullptr};
                pg8::gemm_phase<pg8::EpiResid, pg8::StaticOrder, PG8_ALIGN, PG8_SP2>(lds, g, S, E, wid0); }
        }
        SEAM(pb + 2);
        if (IN(pb + 3)) REP(5) { CTX(); if (rep_) xcd_barrier(bar);
            pg8::Gemm g{xb, (const bf16*)(p.ws + WS_WIN), M, NP, DM, KROT(DM)}; pg8::StaticOrder S; S.init(M, NP, (int)gridDim.x, VB());
            pg8::EpiSplit E{act, SEG_STRIDE, ssqB, 1.0f / (DM * pg8::SSQ_FX)};
            pg8::gemm_phase<pg8::EpiSplit, pg8::StaticOrder, PG8_ALIGN, PG8_SP2>(lds, g, S, E, wid0);
            gates_phase(p, l, ssqB, lds, VB());
        }
        SEAMP(pb + 3);
        ST_END(0);
        ST_BEGIN(1);
        if (IN(pb + 4)) REP(1) { CTX(); if (rep_) xcd_barrier(bar);
            const int pq = PAIRQ(), pj = PAIRJ();
            for (int k = 0; k < 3; ++k) { __syncthreads(); dilated_unit(p, l, 256 * k + 64 * pq + pj, lds); }
            {
                const int tid_ = opaque_tid(), u0 = 256 * pq + pj; v4u kvr[2], vvr[2]; float gi, gf; mlstm_ld_kv(p, u0, tid_, kvr, vvr); mlstm_ld_g(p, u0, tid_, gi, gf);
                for (int u = u0; u < 256 * pq + 256; u += 64) { __syncthreads(); mlstm1_unit(p, l, u, u + 64, kvr, vvr, gi, gf, lds); }
            }
            {
                const int tid_ = opaque_tid(), u0 = 256 * pq + pj; unsigned xv[11]; float lci; lru_ld<1>(p, u0, tid_, xv, lci); LruC C; lru_cload(p, l, tid_, C);
                for (int u = u0; u < 256 * pq + 256; u += 64) { __syncthreads(); lru_unit<1>(p, l, u, u + 64, xv, lci, C, lds); }
            }
        }
        SEAMP(pb + 4);
        if (IN(pb + 5)) REP(2) { CTX(); if (rep_) xcd_barrier(bar);
            const int pq = PAIRQ();
            unsigned* ctr = ctl + CW_Q + 64 * (pb + 5 + 32 * rep_) + 16 * pq;
            for (int s = q_next(p, ctr, qslot); s < 64 + 8 + 128; s = q_next(p, ctr, qslot)) {
                if (s < 64) stick_unit(p, 16 * (s >> 2) + 4 * pq + (s & 3), lds);
                else if (s < 64 + 8) lru_carry_unit(p, 8 * pq + s - 64, lds);
                else mlstm_scan_unit(p, 128 * pq + s - 72, lds);
            }
        }
        SEAMP(pb + 5);
        if (IN(pb + 6)) REP(3) { CTX(); if (rep_) xcd_barrier(bar);
            {
                const int tid_ = opaque_tid(), u0 = 256 * PAIRQ() + PAIRJ(); v4u pre[10]; float gi, gf, mrun_pf, nv_pf; mlstm3_ld(p, u0, tid_, pre); mlstm_ld_g(p, u0, tid_, gi, gf);
                mrun_pf = ((const float*)(p.ws + WS_MRUN))[u0]; nv_pf = ((const float*)(p.ws + WS_NST))[(size_t)u0 * 128 + ((tid_ - 64) & 127)];
                for (int u = u0; u < (u0 | 255) + 1; u += 64) { __syncthreads(); mlstm3_unit(p, l, u, u + 64, pre, gi, gf, mrun_pf, nv_pf, lds); }
            }
            {
                const int tid_ = opaque_tid(), u0 = 256 * PAIRQ() + PAIRJ(); float pa[16], pu[16], pg[16]; float lci; lru3_ld(p, u0, tid_, pa, pu, pg, lci); LruC C; lru_cload(p, l, tid_, C);
                for (int u = u0; u < (u0 | 255) + 1; u += 64) { __syncthreads(); lru3_unit(p, u, u + 64, pa, pu, pg, lci, C, lds); }
            }
            { __syncthreads(); finalize_unit(p, l, 64 * PAIRQ() + PAIRJ()); }
        }
        SEAM(pb + 6);
        ST_END(1);
        ST_BEGIN(0);
#if (PROBE_REPEAT >> 7) & 1
        for (int xb_ = 0; xb_ < 20; ++xb_) xcd_barrier(bar);
#endif
        if (IN(pb + 7)) { CTX();
            pg8::Gemm g{mixed, (const bf16*)(p.ws + WS_WOUT), M, DM, DM, KROT(DM)}; pg8::StaticOrder S; S.init(M, DM, (int)gridDim.x, VB());
            pg8::EpiResid E{xb, nullptr, xb, ssqC, DM, 1.0f, pg8::ffn_gu_f8(l, 1) ? p.ws + WS_X8 : nullptr};
            pg8::gemm_phase<pg8::EpiResid, pg8::StaticOrder, PG8_ALIGN, PG8_SP2>(lds, g, S, E, wid0);
        }
        SEAML(pb + 7);
        if (IN(pb + 8)) { CTX();
            float* rowsc = (float*)(p.ws + WS_ROWSC); float* colsc = (float*)(p.ws + WS_COLSC2);
            quant_rows_i8(p, xb, M, p.ws + WS_X8, rowsc, VB());
            xcd_barrier(bar, MISC[2] != 0u ? 1 : 0);
            pg8::Gemm g{(const bf16*)(p.ws + WS_X8), (const bf16*)(p.ws + WS_WGU2), M, 2 * DFF, DM / 2, 0}; pg8::StaticOrder S; S.init(M, 2 * DFF, (int)gridDim.x, VB());
            if (pg8::ffn_f8(l, 1)) { pg8::EpiSwigluF8I8 E{act, pg8::DFF_P, ssqC, 1.0f / (DM * pg8::SSQ_FX), 1.0f, rowsc, colsc};
                pg8::gemm_phase<pg8::EpiSwigluF8I8, pg8::StaticOrder, PG8_ALIGN, PG8_SP2, false, true>(lds, g, S, E, wid0); }
            else { pg8::EpiSwigluI8 E{act, DFF, ssqC, 1.0f / (DM * pg8::SSQ_FX), 1.0f, rowsc, colsc};
                pg8::gemm_phase<pg8::EpiSwigluI8, pg8::StaticOrder, PG8_ALIGN, PG8_SP2, false, true>(lds, g, S, E, wid0); }
        }
        SEAML(pb + 8);
        if (IN(pb + 9)) { CTX();
            pg8::StaticOrder S; S.init(M, DM, (int)gridDim.x, VB());
            const bool lastl = (l == NLAYER - 1);
            if (pg8::ffn_f8(l, 1)) { pg8::Gemm g{act, (const bf16*)(p.ws + WS_WD2), M, DM, pg8::DFF_P / 2, 0};
                pg8::EpiResid E{xb, lastl ? p.out : nullptr, lastl ? nullptr : xb, lastl ? nullptr : ssqN, DM, 0.5f / (pg8::F8_ACT_SCALE * pg8::F8_W_SCALE), nullptr};
                pg8::gemm_phase<pg8::EpiResid, pg8::StaticOrder, PG8_ALIGN, PG8_SP2, true>(lds, g, S, E, wid0); }
            else { pg8::Gemm g{act, (const bf16*)(p.ws + WS_WD2), M, DM, DFF, 0};
                pg8::EpiResid E{xb, lastl ? p.out : nullptr, lastl ? nullptr : xb, lastl ? nullptr : ssqN, DM, 0.5f, nullptr};
                pg8::gemm_phase<pg8::EpiResid, pg8::StaticOrder, PG8_ALIGN, PG8_SP2>(lds, g, S, E, wid0); }
        }
        SEAM(pb + 9);
        ST_END(0);
    }
#if PROBE_STAMP
    {
        const Ctx p = make_ctx(wid0); float* tw = (float*)(p.ws + WS_G);
        xcd_barrier(bar);
        if (blockIdx.x == 0 && threadIdx.x == 0) { __hip_atomic_store(tw, (float)stamp_acc * 0.01f, __ATOMIC_RELAXED, __HIP_MEMORY_SCOPE_AGENT); }
        xcd_barrier(bar);
        const float sc = 1.0f + __hip_atomic_load(tw, __ATOMIC_RELAXED, __HIP_MEMORY_SCOPE_AGENT) * (1.0f / PROBE_STAMP_DIV);
        for (size_t i = (size_t)blockIdx.x * NT + threadIdx.x; i < (size_t)M * DM; i += (size_t)gridDim.x * NT) p.out[i] *= sc;
    }
#endif
#undef IN
#undef SEAM
#undef CTX
}

extern "C" void kernel_launch(void* const* d_in, const int* in_sizes, int n_in, void* d_out, int out_size, void* d_ws, size_t ws_size, hipStream_t stream) {
    static int grid = 0;
    if (grid == 0) {
        if (n_in != 24 || in_sizes[0] != M * DM || out_size != M * DM || ws_size < WS_END) { fprintf(stderr, "kernel_launch: unexpected shapes (n_in %d, in0 %d, out %d, ws %zu < %zu)\n", n_in, n_in > 0 ? in_sizes[0] : -1, out_size, ws_size, (size_t)WS_END); grid = -1; return; }
        int dev = 0, cus = 0, per_cu = 0;
        if (hipGetDevice(&dev) != hipSuccess || hipDeviceGetAttribute(&cus, hipDeviceAttributeMultiprocessorCount, dev) != hipSuccess) { grid = -1; return; }
        if (hipFuncSetAttribute((const void*)fwd_kernel, hipFuncAttributeMaxDynamicSharedMemorySize, LDS_BYTES) != hipSuccess) { fprintf(stderr, "kernel_launch: hipFuncSetAttribute failed\n"); grid = -1; return; }
        if (hipOccupancyMaxActiveBlocksPerMultiprocessor(&per_cu, (const void*)fwd_kernel, NT, LDS_BYTES) != hipSuccess || per_cu < 1) { fprintf(stderr, "kernel_launch: occupancy query says %d\n", per_cu); (void)hipGetLastError(); }
        grid = cus;
    }
    if (grid < 0) return;
    (void)hipMemsetAsync((char*)d_ws + WS_CTL, 0, CTL_ZERO_BYTES, stream);
    Params a{};
    for (int i = 0; i < 24; ++i) a.in[i] = (const float*)d_in[i];
    a.out = (float*)d_out; a.ws = (unsigned char*)d_ws;
#if MK_SPLIT
    for (int ph = 0; ph < N_PHASES; ++ph) { a.ph_lo = ph; a.ph_hi = ph + 1; hipLaunchKernelGGL(fwd_kernel, dim3(grid), dim3(NT), LDS_BYTES, stream, a); }
#else
    a.ph_lo = 0; a.ph_hi = N_PHASES;
    hipLaunchKernelGGL(fwd_kernel, dim3(grid), dim3(NT), LDS_BYTES, stream, a);
#endif
}
```
